# Optimizing an MI355X kernel written in HIP

```python
import math, functools
import jax, jax.numpy as jnp
from jax import lax
import numpy as np

D_MODEL = 4096
BATCH = 4
SEQ = 4096
DEPTH = 1

N_META = 16
Q_BLOCK = 128
FOX_HEADS = 16
FOX_HEAD_DIM = 128
DIFF_HEADS = 8
DIFF_HEAD_DIM = 128
D_FF = 11008
RMS_EPS = 1e-6
ALIBI_MAX_BIAS = 8.0

FOX_WIDTH = FOX_HEADS * FOX_HEAD_DIM
DIFF_QK_WIDTH = DIFF_HEADS * 2 * DIFF_HEAD_DIM
DIFF_V_WIDTH = DIFF_HEADS * 2 * DIFF_HEAD_DIM
IN_SPLITS = [FOX_WIDTH, 2 * FOX_WIDTH, 3 * FOX_WIDTH, 3 * FOX_WIDTH + FOX_HEADS,
             3 * FOX_WIDTH + FOX_HEADS + DIFF_QK_WIDTH,
             3 * FOX_WIDTH + FOX_HEADS + 2 * DIFF_QK_WIDTH,
             3 * FOX_WIDTH + FOX_HEADS + 2 * DIFF_QK_WIDTH + DIFF_V_WIDTH,
             3 * FOX_WIDTH + FOX_HEADS + 2 * DIFF_QK_WIDTH + DIFF_V_WIDTH + D_MODEL]
IN_COLS = IN_SPLITS[-1] + D_MODEL

kernel_name = "fox_diffattn_gated_macaron_block"


def rms_norm(x, g):
    xf = x.astype(jnp.float32)
    y = xf * lax.rsqrt(jnp.mean(xf * xf, axis=-1, keepdims=True) + RMS_EPS)
    return (y * g.astype(jnp.float32)).astype(x.dtype)


def swiglu(x, w_gate, w_up, w_down):
    return (jax.nn.silu(x @ w_gate) * (x @ w_up)) @ w_down


def sweep_query_blocks(block_fn, q_args):
    L = q_args[0].shape[1]
    n_blocks = (L - N_META) // Q_BLOCK
    meta_out = block_fn(tuple(a[:, :N_META] for a in q_args), jnp.arange(N_META, dtype=jnp.int32))

    def to_blocks(a):
        a = a[:, N_META:]
        a = a.reshape(a.shape[0], n_blocks, Q_BLOCK, *a.shape[2:])
        return jnp.moveaxis(a, 1, 0)

    t_real = N_META + jnp.arange(n_blocks * Q_BLOCK, dtype=jnp.int32).reshape(n_blocks, Q_BLOCK)
    real_out = lax.map(lambda xs: block_fn(xs[0], xs[1]),
                       (tuple(to_blocks(a) for a in q_args), t_real))
    real_out = jnp.moveaxis(real_out, 0, 1)
    real_out = real_out.reshape(real_out.shape[0], n_blocks * Q_BLOCK, *real_out.shape[3:])
    return jnp.concatenate([meta_out, real_out], axis=1)


def fox_block(q_args, t_q, k, v, c_k):
    q, c_q = q_args
    k_pos = jnp.arange(k.shape[1], dtype=jnp.int32)
    s = jnp.einsum('bqhd,bkhd->bhqk', q, k, preferred_element_type=jnp.float32) * (FOX_HEAD_DIM ** -0.5)
    s = s + jnp.swapaxes(c_q, 1, 2)[..., None] - jnp.swapaxes(c_k, 1, 2)[:, :, None, :]
    causal = t_q[:, None] >= k_pos[None, :]
    s = jnp.where(causal, s, -jnp.inf)
    p = jax.nn.softmax(s, axis=-1).astype(v.dtype)
    return jnp.einsum('bhqk,bkhd->bqhd', p, v)


def diff_block(q_args, t_q, k, v, lam, slopes):
    (q,) = q_args
    k_pos = jnp.arange(k.shape[1], dtype=jnp.int32)
    s = jnp.einsum('bqhcd,bkhcd->bhcqk', q, k, preferred_element_type=jnp.float32) * (DIFF_HEAD_DIM ** -0.5)
    dist = (t_q[:, None] - k_pos[None, :]).astype(jnp.float32)
    s = s - slopes[None, :, None, None, None] * dist[None, None, None]
    causal = t_q[:, None] >= k_pos[None, :]
    s = jnp.where(causal, s, -jnp.inf)
    p = jax.nn.softmax(s, axis=-1)
    a = p[:, :, 0] - lam * p[:, :, 1]
    return jnp.einsum('bhqk,bkhd->bqhd', a.astype(v.dtype), v)


def hybrid_mixer(u, w_in, b_forget, lambda_q1, lambda_k1, lambda_q2, lambda_k2, diff_subln_g,
                 w_o_fox, w_o_diff, w_out, lambda_init):
    B, L, _ = u.shape
    proj = u @ w_in
    fq, fk, fv, f_logit, dq, dk, dv, g_fox, g_diff = jnp.split(proj, IN_SPLITS, axis=-1)

    fq = fq.reshape(B, L, FOX_HEADS, FOX_HEAD_DIM)
    fk = fk.reshape(B, L, FOX_HEADS, FOX_HEAD_DIM)
    fv = fv.reshape(B, L, FOX_HEADS, FOX_HEAD_DIM)
    log_f = jax.nn.log_sigmoid(f_logit.astype(jnp.float32) + b_forget.astype(jnp.float32))
    c = jnp.cumsum(log_f, axis=1)
    fox_out = sweep_query_blocks(functools.partial(fox_block, k=fk, v=fv, c_k=c), (fq, c))

    dq = dq.reshape(B, L, DIFF_HEADS, 2, DIFF_HEAD_DIM)
    dk = dk.reshape(B, L, DIFF_HEADS, 2, DIFF_HEAD_DIM)
    dv = dv.reshape(B, L, DIFF_HEADS, 2 * DIFF_HEAD_DIM)
    f32 = jnp.float32
    lam = (jnp.exp(jnp.sum(lambda_q1.astype(f32) * lambda_k1.astype(f32)))
           - jnp.exp(jnp.sum(lambda_q2.astype(f32) * lambda_k2.astype(f32))) + lambda_init)
    slopes = jnp.exp2(-ALIBI_MAX_BIAS * jnp.arange(1, DIFF_HEADS + 1, dtype=f32) / DIFF_HEADS)
    diff_out = sweep_query_blocks(functools.partial(diff_block, k=dk, v=dv, lam=lam, slopes=slopes), (dq,))
    diff_out = rms_norm(diff_out, diff_subln_g) * (1.0 - lambda_init)

    y_fox = fox_out.reshape(B, L, FOX_WIDTH) @ w_o_fox
    y_diff = diff_out.reshape(B, L, DIFF_V_WIDTH) @ w_o_diff
    merged = jax.nn.sigmoid(g_fox) * y_fox + jax.nn.sigmoid(g_diff) * y_diff
    return merged @ w_out


def setup_inputs(seed: int = 0) -> dict:
    key = jax.random.key(seed)
    ks = jax.random.split(key, 24)
    f32 = jnp.float32

    def dense(k, shape):
        return jax.random.normal(k, shape, f32) * (shape[-2] ** -0.5)

    def gain(k, n):
        return 1.0 + 0.01 * jax.random.normal(k, (DEPTH, n), f32)

    return {
        "x": jax.random.normal(ks[0], (BATCH, SEQ, D_MODEL), f32),
        "meta_tokens": jax.random.normal(ks[1], (N_META, D_MODEL), f32),
        "ff1_pre_g": gain(ks[2], D_MODEL),
        "ff1_w_gate": dense(ks[3], (DEPTH, D_MODEL, D_FF)),
        "ff1_w_up": dense(ks[4], (DEPTH, D_MODEL, D_FF)),
        "ff1_w_down": dense(ks[5], (DEPTH, D_FF, D_MODEL)),
        "ff1_post_g": gain(ks[6], D_MODEL),
        "mix_pre_g": gain(ks[7], D_MODEL),
        "w_in": dense(ks[8], (DEPTH, D_MODEL, IN_COLS)),
        "b_forget": jax.random.uniform(ks[9], (DEPTH, FOX_HEADS), f32, 1.0, 3.0),
        "lambda_q1": 0.1 * jax.random.normal(ks[10], (DEPTH, DIFF_HEAD_DIM), f32),
        "lambda_k1": 0.1 * jax.random.normal(ks[11], (DEPTH, DIFF_HEAD_DIM), f32),
        "lambda_q2": 0.1 * jax.random.normal(ks[12], (DEPTH, DIFF_HEAD_DIM), f32),
        "lambda_k2": 0.1 * jax.random.normal(ks[13], (DEPTH, DIFF_HEAD_DIM), f32),
        "diff_subln_g": gain(ks[14], 2 * DIFF_HEAD_DIM),
        "w_o_fox": dense(ks[15], (DEPTH, FOX_WIDTH, D_MODEL)),
        "w_o_diff": dense(ks[16], (DEPTH, DIFF_V_WIDTH, D_MODEL)),
        "w_out": dense(ks[17], (DEPTH, D_MODEL, D_MODEL)),
        "mix_post_g": gain(ks[18], D_MODEL),
        "ff2_pre_g": gain(ks[19], D_MODEL),
        "ff2_w_gate": dense(ks[20], (DEPTH, D_MODEL, D_FF)),
        "ff2_w_up": dense(ks[21], (DEPTH, D_MODEL, D_FF)),
        "ff2_w_down": dense(ks[22], (DEPTH, D_FF, D_MODEL)),
        "ff2_post_g": gain(ks[23], D_MODEL),
    }


def reference(x, meta_tokens, ff1_pre_g, ff1_w_gate, ff1_w_up, ff1_w_down, ff1_post_g,
              mix_pre_g, w_in, b_forget, lambda_q1, lambda_k1, lambda_q2, lambda_k2, diff_subln_g,
              w_o_fox, w_o_diff, w_out, mix_post_g,
              ff2_pre_g, ff2_w_gate, ff2_w_up, ff2_w_down, ff2_post_g):
    B = x.shape[0]
    meta = jnp.broadcast_to(meta_tokens.astype(x.dtype)[None], (B, N_META, x.shape[-1]))
    h = jnp.concatenate([meta, x], axis=1)
    for layer in range(DEPTH):
        lambda_init = 0.8 - 0.6 * math.exp(-0.3 * layer)
        h = h + 0.5 * rms_norm(swiglu(rms_norm(h, ff1_pre_g[layer]), ff1_w_gate[layer],
                                      ff1_w_up[layer], ff1_w_down[layer]), ff1_post_g[layer])
        mix = hybrid_mixer(rms_norm(h, mix_pre_g[layer]), w_in[layer], b_forget[layer],
                           lambda_q1[layer], lambda_k1[layer], lambda_q2[layer], lambda_k2[layer],
                           diff_subln_g[layer], w_o_fox[layer], w_o_diff[layer], w_out[layer],
                           lambda_init)
        h = h + rms_norm(mix, mix_post_g[layer])
        h = h + 0.5 * rms_norm(swiglu(rms_norm(h, ff2_pre_g[layer]), ff2_w_gate[layer],
                                      ff2_w_up[layer], ff2_w_down[layer]), ff2_post_g[layer])
    return h[:, N_META:]
```

```cpp
#include <hip/hip_runtime.h>
#include <cstdio>
#include <cstdint>
#ifndef EPI_NT
#define EPI_NT 1
#endif
#ifndef PG8_PRIO
#define PG8_PRIO 3
#endif
namespace pg8 {
#define PG8_LAS __attribute__((address_space(3)))
typedef unsigned short bf16_t;
typedef short bf16x8 __attribute__((ext_vector_type(8)));
typedef float f32x4 __attribute__((ext_vector_type(4)));
typedef unsigned u32x4 __attribute__((ext_vector_type(4)));
constexpr int BM = 256, BK = 64, HALF = 128, HTB = HALF * BK * 2  , STAGE_BYTES = 8 * HTB, NXCD = 8, WGM = 8;

__host__ __device__ __forceinline__ int lds_byte(int r, int c) { const int st = (r >> 4) * 2 + (c >> 5), rr = r & 15, cc = c & 31, ob = rr * 64 + cc * 2; return st * 1024 + (ob ^ (((ob >> 9) & 1) << 5)); }
__host__ __device__ __forceinline__ void stage_rc(int b, int& R, int& C) { const int st = b / 1024, sb = b % 1024, swz = sb ^ (((sb >> 9) & 1) << 5); R = (st >> 1) * 16 + swz / 64; C = (st & 1) * 32 + (swz % 64) / 2; }
__host__ __device__ __forceinline__ int perm32(int rho) { const int n = rho >> 4, i = rho & 15; return 8 * (i >> 2) + 4 * n + (i & 3); }

struct Unit { int pm, pn; };
struct Gemm { const bf16_t* A; const bf16_t* Bt; int M, N, K, lda, ldb; int pshA = 30, pshB = 30; size_t pstrA = 0, pstrB = 0; };

struct StaticOrder {
    int nM, nN, nwg, G, c, wgm, tr;
    __host__ __device__ void init(int M, int N, int G_, int c_, int wgm_ = WGM, int tr_ = 0) { nM = M / BM; nN = N / BM; nwg = nM * nN; G = G_; c = c_; wgm = wgm_; tr = tr_; }
    __host__ __device__ bool next(int i, Unit& u) const {
        const long L = (long)i * G + c; if (L >= nwg) return false;
        int wgid = (int)L; { const int q = nwg / NXCD, r = nwg % NXCD, xcd = wgid % NXCD, off = wgid / NXCD; wgid = (xcd < r ? xcd * (q + 1) : r * (q + 1) + (xcd - r) * q) + off; }
        const int nA = tr ? nN : nM, nB = tr ? nM : nN;
        const int nig = wgm * nB, gid = wgid / nig, fm = gid * wgm, gsz = (nA - fm) < wgm ? (nA - fm) : wgm;
        const int a = fm + ((wgid % nig) % gsz), b = (wgid % nig) / gsz;
        u.pm = tr ? b : a; u.pn = tr ? a : b; return true;
    }
    __device__ __forceinline__ void a_ready(const Unit&) const {}
    __device__ __forceinline__ void done(const Unit&) const {}
};

__device__ __forceinline__ unsigned cvt_pk_bf16(float lo, float hi) { unsigned r; asm volatile("v_cvt_pk_bf16_f32 %0, %1, %2" : "=v"(r) : "v"(lo), "v"(hi)); return r; }
__device__ __forceinline__ float sigm(float x) { return __builtin_amdgcn_rcpf(1.0f + __builtin_amdgcn_exp2f(-1.4426950408889634f * x)); }
__device__ __forceinline__ float bf_lo(unsigned w) { return __uint_as_float(w << 16); }
__device__ __forceinline__ float bf_hi(unsigned w) { return __uint_as_float(w & 0xffff0000u); }

struct EpiPlain {
    static constexpr bool PERM = true, AFTER_DRAIN = false, ROWSCALE = false;
    bf16_t* O; int ldc; float scale = 1.0f;
    __device__ __forceinline__ void operator()(const f32x4 (&acc)[2][2][4][2], const Unit& u, int wr, int wc, int fr, int fq, const PG8_LAS float*) const {
        const int row0 = u.pm * BM + wr * 64 + fr; const int col0 = u.pn * BM + wc * 32 + 8 * fq;
#pragma unroll
        for (int ai = 0; ai < 2; ++ai)
#pragma unroll
            for (int m = 0; m < 4; ++m) { bf16_t* rowp = O + (size_t)(row0 + ai * HALF + m * 16) * ldc + col0;
#pragma unroll
                for (int bj = 0; bj < 2; ++bj) { const f32x4 v0 = acc[ai][bj][m][0] * scale, v1 = acc[ai][bj][m][1] * scale;
                    u32x4 w; w.x = cvt_pk_bf16(v0[0], v0[1]); w.y = cvt_pk_bf16(v0[2], v0[3]); w.z = cvt_pk_bf16(v1[0], v1[1]); w.w = cvt_pk_bf16(v1[2], v1[3]);
                    *(u32x4*)(rowp + bj * HALF) = w; } }
    }
};
struct EpiPlainRS {
    static constexpr bool PERM = true, AFTER_DRAIN = false, ROWSCALE = true;
    bf16_t* O; int ldc; float scale; const float* rs;
    __device__ __forceinline__ void operator()(const f32x4 (&acc)[2][2][4][2], const Unit& u, int wr, int wc, int fr, int fq, const PG8_LAS float* rsl) const {
        const int row0 = u.pm * BM + wr * 64 + fr; const int col0 = u.pn * BM + wc * 32 + 8 * fq;
#pragma unroll
        for (int ai = 0; ai < 2; ++ai)
#pragma unroll
            for (int m = 0; m < 4; ++m) { bf16_t* rowp = O + (size_t)(row0 + ai * HALF + m * 16) * ldc + col0; const float r = rsl[wr * 64 + ai * HALF + m * 16 + fr] * scale;
#pragma unroll
                for (int bj = 0; bj < 2; ++bj) { const f32x4 v0 = acc[ai][bj][m][0] * r, v1 = acc[ai][bj][m][1] * r;
                    u32x4 w; w.x = cvt_pk_bf16(v0[0], v0[1]); w.y = cvt_pk_bf16(v0[2], v0[3]); w.z = cvt_pk_bf16(v1[0], v1[1]); w.w = cvt_pk_bf16(v1[2], v1[3]);
                    *(u32x4*)(rowp + bj * HALF) = w; } }
    }
};
struct EpiSwiGLU {
    static constexpr bool PERM = true, AFTER_DRAIN = false, ROWSCALE = true;
    bf16_t* O; size_t pstr; const float* rs;
    __device__ __forceinline__ void operator()(const f32x4 (&acc)[2][2][4][2], const Unit& u, int wr, int wc, int fr, int fq, const PG8_LAS float* rsl) const {
        const int row0 = u.pm * BM + wr * 64 + fr; const int col0 = ((u.pn * HALF) & 4095) + wc * 32 + 8 * fq; bf16_t* Op = O + (size_t)(u.pn >> 5) * pstr;
#pragma unroll
        for (int ai = 0; ai < 2; ++ai)
#pragma unroll
            for (int m = 0; m < 4; ++m) { bf16_t* rowp = Op + (size_t)(row0 + ai * HALF + m * 16) * 4096 + col0; const float r = rsl[wr * 64 + ai * HALF + m * 16 + fr];
                const f32x4 g0 = acc[ai][0][m][0] * r, g1 = acc[ai][0][m][1] * r, u0 = acc[ai][1][m][0] * r, u1 = acc[ai][1][m][1] * r;
                f32x4 h0, h1;
#pragma unroll
                for (int i = 0; i < 4; ++i) { h0[i] = g0[i] * sigm(g0[i]) * u0[i]; h1[i] = g1[i] * sigm(g1[i]) * u1[i]; }
                u32x4 w; w.x = cvt_pk_bf16(h0[0], h0[1]); w.y = cvt_pk_bf16(h0[2], h0[3]); w.z = cvt_pk_bf16(h1[0], h1[1]); w.w = cvt_pk_bf16(h1[2], h1[3]);
                if (EPI_NT) __builtin_nontemporal_store(w, (u32x4*)rowp); else *(u32x4*)rowp = w; }
    }
};
constexpr float F8_HSCALE = 8.0f, F8_WSCALE = 1024.0f, F8_MAX = 416.0f, F8_USCALE = 16.0f, F8_WINSCALE = 512.0f;
__device__ __forceinline__ unsigned pack_fp8x4(float a, float b, float c, float d) {
    a = __builtin_fminf(__builtin_fmaxf(a, -F8_MAX), F8_MAX); b = __builtin_fminf(__builtin_fmaxf(b, -F8_MAX), F8_MAX); c = __builtin_fminf(__builtin_fmaxf(c, -F8_MAX), F8_MAX); d = __builtin_fminf(__builtin_fmaxf(d, -F8_MAX), F8_MAX);
    int w = 0; w = __builtin_amdgcn_cvt_pk_fp8_f32(a, b, w, false); w = __builtin_amdgcn_cvt_pk_fp8_f32(c, d, w, true); return (unsigned)w; }
struct EpiSwiGLU8 {
    static constexpr bool PERM = true, AFTER_DRAIN = false, ROWSCALE = true;
    unsigned char* O; size_t pstr; const float* rs; int pn_off = 0; float ascale = 1.0f;
    __device__ __forceinline__ void operator()(const f32x4 (&acc)[2][2][4][2], const Unit& u, int wr, int wc, int fr, int fq, const PG8_LAS float* rsl) const {
        const int pn = u.pn + pn_off;
        const int row0 = u.pm * BM + wr * 64 + fr; const int col0 = ((pn * HALF) & 4095) + wc * 32 + 8 * fq; unsigned char* Op = O + (size_t)(pn >> 5) * pstr;
#pragma unroll
        for (int ai = 0; ai < 2; ++ai)
#pragma unroll
            for (int m = 0; m < 4; ++m) { unsigned char* rowp = Op + (size_t)(row0 + ai * HALF + m * 16) * 4096 + col0; const float r = rsl[wr * 64 + ai * HALF + m * 16 + fr] * ascale;
                const f32x4 g0 = acc[ai][0][m][0] * r, g1 = acc[ai][0][m][1] * r, u0 = acc[ai][1][m][0] * r, u1 = acc[ai][1][m][1] * r;
                f32x4 h0, h1;
#pragma unroll
                for (int i = 0; i < 4; ++i) { h0[i] = g0[i] * sigm(g0[i]) * u0[i] * F8_HSCALE; h1[i] = g1[i] * sigm(g1[i]) * u1[i] * F8_HSCALE; }
                typedef unsigned u32x2 __attribute__((ext_vector_type(2)));
                u32x2 w; w.x = pack_fp8x4(h0[0], h0[1], h0[2], h0[3]); w.y = pack_fp8x4(h1[0], h1[1], h1[2], h1[3]);
                *(u32x2*)rowp = w; }
    }
};
struct EpiWin {
    static constexpr bool PERM = true, AFTER_DRAIN = false, ROWSCALE = true;
    bf16_t* QKV; bf16_t* GATES; const float* rs;
    __device__ __forceinline__ void operator()(const f32x4 (&acc)[2][2][4][2], const Unit& u, int wr, int wc, int fr, int fq, const PG8_LAS float* rsl) const {
        const int row0 = u.pm * BM + wr * 64 + fr;
        bf16_t* base; int ldc, colt;
        if (u.pn < 48) { base = QKV; ldc = 12288; colt = u.pn * BM; } else { base = GATES; ldc = 8192; colt = (u.pn - 48) * BM; }
        const int col0 = colt + wc * 32 + 8 * fq;
#pragma unroll
        for (int ai = 0; ai < 2; ++ai)
#pragma unroll
            for (int m = 0; m < 4; ++m) { bf16_t* rowp = base + (size_t)(row0 + ai * HALF + m * 16) * ldc + col0; const float r = rsl[wr * 64 + ai * HALF + m * 16 + fr];
#pragma unroll
                for (int bj = 0; bj < 2; ++bj) { const f32x4 v0 = acc[ai][bj][m][0] * r, v1 = acc[ai][bj][m][1] * r;
                    u32x4 w; w.x = cvt_pk_bf16(v0[0], v0[1]); w.y = cvt_pk_bf16(v0[2], v0[3]); w.z = cvt_pk_bf16(v1[0], v1[1]); w.w = cvt_pk_bf16(v1[2], v1[3]);
                    if (EPI_NT) __builtin_nontemporal_store(w, (u32x4*)(rowp + bj * HALF)); else *(u32x4*)(rowp + bj * HALF) = w; } }
    }
};
struct MidNone { static constexpr bool ON = false; int tmid; __device__ __forceinline__ void operator()(f32x4 (&)[2][2][4][2], const Unit&, int, int, int, int) const {} };
struct MidGate {
    static constexpr bool ON = true;
    int tmid; const bf16_t* G;
    __device__ __forceinline__ void operator()(f32x4 (&acc)[2][2][4][2], const Unit& u, int wr, int wc, int fr, int fq) const {
        asm volatile("" : "+v"(fr), "+v"(fq));
        const int row0 = u.pm * BM + wr * 64 + fr; const int col0 = u.pn * BM + wc * 32 + 8 * fq;
#pragma unroll
        for (int ai = 0; ai < 2; ++ai)
#pragma unroll
            for (int m = 0; m < 4; ++m) { const bf16_t* grow = G + (size_t)(row0 + ai * HALF + m * 16) * 8192 + col0;
#pragma unroll
                for (int bj = 0; bj < 2; ++bj) {
                    const u32x4 gf = *(const u32x4*)(grow + bj * HALF), gd = *(const u32x4*)(grow + 4096 + bj * HALF);
                    const unsigned fw[4] = {gf.x, gf.y, gf.z, gf.w}, dw[4] = {gd.x, gd.y, gd.z, gd.w};
#pragma unroll
                    for (int q = 0; q < 4; ++q) {
                        const float r0 = (1.0f + __builtin_amdgcn_exp2f(-1.4426950408889634f * bf_lo(dw[q]))) * __builtin_amdgcn_rcpf(1.0f + __builtin_amdgcn_exp2f(-1.4426950408889634f * bf_lo(fw[q])));
                        const float r1 = (1.0f + __builtin_amdgcn_exp2f(-1.4426950408889634f * bf_hi(dw[q]))) * __builtin_amdgcn_rcpf(1.0f + __builtin_amdgcn_exp2f(-1.4426950408889634f * bf_hi(fw[q])));
                        acc[ai][bj][m][q >> 1][2 * (q & 1)] *= r0; acc[ai][bj][m][q >> 1][2 * (q & 1) + 1] *= r1; } }
                asm volatile("" : "+v"(acc[ai][0][m][0]), "+v"(acc[ai][0][m][1]), "+v"(acc[ai][1][m][0]), "+v"(acc[ai][1][m][1]) :: "memory"); }
    }
};
struct EpiGateOut {
    static constexpr bool PERM = true, AFTER_DRAIN = false, ROWSCALE = false;
    bf16_t* O; const bf16_t* G;
    __device__ __forceinline__ void operator()(const f32x4 (&acc)[2][2][4][2], const Unit& u, int wr, int wc, int fr, int fq, const PG8_LAS float*) const {
        const int row0 = u.pm * BM + wr * 64 + fr; const int col0 = u.pn * BM + wc * 32 + 8 * fq;
#pragma unroll
        for (int ai = 0; ai < 2; ++ai)
#pragma unroll
            for (int m = 0; m < 4; ++m) { const size_t row = (size_t)(row0 + ai * HALF + m * 16);
#pragma unroll
                for (int bj = 0; bj < 2; ++bj) { const int col = col0 + bj * HALF;
                    const u32x4 gw = *(const u32x4*)(G + row * 8192 + 4096 + col);
                    f32x4 v0 = acc[ai][bj][m][0], v1 = acc[ai][bj][m][1];
                    v0[0] *= sigm(bf_lo(gw.x)); v0[1] *= sigm(bf_hi(gw.x)); v0[2] *= sigm(bf_lo(gw.y)); v0[3] *= sigm(bf_hi(gw.y));
                    v1[0] *= sigm(bf_lo(gw.z)); v1[1] *= sigm(bf_hi(gw.z)); v1[2] *= sigm(bf_lo(gw.w)); v1[3] *= sigm(bf_hi(gw.w));
                    u32x4 w; w.x = cvt_pk_bf16(v0[0], v0[1]); w.y = cvt_pk_bf16(v0[2], v0[3]); w.z = cvt_pk_bf16(v1[0], v1[1]); w.w = cvt_pk_bf16(v1[2], v1[3]);
                    *(u32x4*)(O + row * 4096 + col) = w; } }
    }
};

typedef int i32x4 __attribute__((ext_vector_type(4)));
typedef int i32x8 __attribute__((ext_vector_type(8)));
__device__ __forceinline__ i32x8 cat8(bf16x8 a, bf16x8 b) { const i32x4 x = __builtin_bit_cast(i32x4, a), y = __builtin_bit_cast(i32x4, b); return __builtin_shufflevector(x, y, 0, 1, 2, 3, 4, 5, 6, 7); }
template <class Epi, class Sched, bool ALIGN_EPI, class Mid = MidNone, bool F8 = false>
__device__ __forceinline__ void gemm_phase(PG8_LAS unsigned char* lds, const int tid, const Gemm g, const Sched& S, const Epi& E, const Mid MH = Mid{}) {
    const int wid = __builtin_amdgcn_readfirstlane(tid >> 6), lane = tid & 63, wr = wid >> 2, wc = wid & 3, fr = lane & 15, fq = lane >> 4;
    const int K = g.K, nt = K / BK;
    unsigned voffA[2], voffB[2];
#pragma unroll
    for (int i = 0; i < 2; ++i) { int R, C; stage_rc(tid * 16 + i * 8192, R, C); const int Rb = Epi::PERM ? ((R & ~31) + perm32(R & 31)) : R;
        voffA[i] = (unsigned)(R * g.lda + C) * 2u; voffB[i] = (unsigned)(Rb * g.ldb + C) * 2u; }
    const size_t kstep = (size_t)(BK * 2);
    const size_t hstepA = (size_t)HALF * g.lda * 2, hstepB = (size_t)HALF * g.ldb * 2;
    const size_t tstepA = 2 * hstepA, tstepB = 2 * hstepB;
    const unsigned ldsw = (unsigned)wid * 1024u;
    const int aoff = lds_byte(wr * 64 + fr, fq * 8), boff = lds_byte(wc * 32 + fr, fq * 8);
#define PG8_SA(b, h) (((b) * 2 + (h)) * HTB)
#define PG8_SB(b, h) ((4 + (b) * 2 + (h)) * HTB)
#define PG8_STAGE(bufoff, gbase, voff) do { _Pragma("unroll") for (int _i = 0; _i < 2; ++_i) \
        __builtin_amdgcn_global_load_lds((const unsigned*)((const char*)(gbase) + (voff)[_i]), (PG8_LAS unsigned*)(lds + (bufoff) + ldsw + _i * 8192), 16, 0, 0); } while (0)
#define PG8_LDA(dst, b, h) do { _Pragma("unroll") for (int m = 0; m < 4; ++m) _Pragma("unroll") for (int k = 0; k < 2; ++k) dst[m][k] = *(const PG8_LAS bf16x8*)(lds + PG8_SA(b, h) + aoff + m * 2048 + k * 1024); } while (0)
#define PG8_LDB(dst, b, h) do { _Pragma("unroll") for (int n = 0; n < 2; ++n) _Pragma("unroll") for (int k = 0; k < 2; ++k) dst[n][k] = *(const PG8_LAS bf16x8*)(lds + PG8_SB(b, h) + boff + n * 2048 + k * 1024); } while (0)
#define PG8_MMA(ai, bj, At, Bt) do { if (PG8_PRIO) __builtin_amdgcn_s_setprio(PG8_PRIO); _Pragma("unroll") for (int m = 0; m < 4; ++m) _Pragma("unroll") for (int n = 0; n < 2; ++n) { \
        if constexpr (F8) { asm volatile("v_mfma_scale_f32_16x16x128_f8f6f4 %0, %1, %2, %0, %3, %3 op_sel_hi:[0,0,0]" : "+v"(acc[ai][bj][m][n]) : "v"(cat8(Bt[n][0], Bt[n][1])), "v"(cat8(At[m][0], At[m][1])), "v"(f8one)); }   \
        else { _Pragma("unroll") for (int k = 0; k < 2; ++k) acc[ai][bj][m][n] = __builtin_amdgcn_mfma_f32_16x16x32_bf16(Bt[n][k], At[m][k], acc[ai][bj][m][n], 0, 0, 0); } } \
        if (PG8_PRIO) __builtin_amdgcn_s_setprio(0); } while (0)
#define PG8_WAIT_V(n) asm volatile("s_waitcnt vmcnt(" #n ")" ::: "memory")
#define PG8_WAIT_L(n) asm volatile("s_waitcnt lgkmcnt(" #n ")" ::: "memory")
#define PG8_BAR __builtin_amdgcn_s_barrier()
#define PG8_SCHED __builtin_amdgcn_sched_barrier(0)
    Unit cur, nxt; int ui = 0;
    if (!S.next(0, cur)) return;
    constexpr int RSL_OFF = STAGE_BYTES; int rpar = 0;
#define PG8_RSPF(uu, par) do { if constexpr (Epi::ROWSCALE) { if (wid == 0) __builtin_amdgcn_global_load_lds((const unsigned*)(E.rs + (size_t)(uu).pm * BM + lane * 4), (PG8_LAS unsigned*)(lds + RSL_OFF + (par) * 1024), 16, 0, 0); } } while (0)
    PG8_RSPF(cur, 0);
    f32x4 acc[2][2][4][2];
#pragma unroll
    for (int a = 0; a < 2; ++a)
#pragma unroll
        for (int b = 0; b < 2; ++b)
#pragma unroll
            for (int m = 0; m < 4; ++m)
#pragma unroll
                for (int n = 0; n < 2; ++n) acc[a][b][m][n] = (f32x4){0.f, 0.f, 0.f, 0.f};
    bf16x8 At[4][2], B0[2][2], B1[2][2];
    int f8one = 0x7F7F7F7F; if constexpr (F8) asm volatile("" : "+v"(f8one));
    const char* cA = (const char*)g.A + (size_t)cur.pm * tstepA; const char* cB = (const char*)g.Bt + (size_t)cur.pn * tstepB;
    S.a_ready(cur);
    PG8_STAGE(PG8_SB(0, 0), cB, voffB); PG8_STAGE(PG8_SB(0, 1), cB + hstepB, voffB); PG8_STAGE(PG8_SA(0, 0), cA, voffA); PG8_STAGE(PG8_SA(0, 1), cA + hstepA, voffA);
    if (wr == 1) PG8_BAR;
    PG8_WAIT_V(2); PG8_BAR;
    PG8_STAGE(PG8_SB(1, 0), cB + kstep, voffB); PG8_STAGE(PG8_SA(1, 0), cA + kstep, voffA); PG8_STAGE(PG8_SB(1, 1), cB + hstepB + kstep, voffB);
    PG8_WAIT_V(6); PG8_BAR;
    for (;;) {
        const bool has_next = S.next(ui + 1, nxt);
        const char* nA = has_next ? (const char*)g.A + (size_t)nxt.pm * tstepA : cA; const char* nB = has_next ? (const char*)g.Bt + (size_t)nxt.pn * tstepB : cB;
        for (int t = 0; t < nt; t += 2) {
            const bool last = (t == nt - 2);
            const char* a1 = cA + (size_t)(t >> g.pshA) * g.pstrA + (size_t)((t & ((1 << g.pshA) - 1)) + 1) * kstep;
            const int t2 = t + 2;
            const char* a2 = last ? nA : cA + (size_t)(t2 >> g.pshA) * g.pstrA + (size_t)(t2 & ((1 << g.pshA) - 1)) * kstep;
            const char* b2 = last ? nB : cB + (size_t)(t2 >> g.pshB) * g.pstrB + (size_t)(t2 & ((1 << g.pshB) - 1)) * kstep;
            const char* a3 = a2 + kstep; const char* b3 = b2 + kstep;
            if (last && has_next) S.a_ready(nxt);
            if constexpr (Mid::ON) { if (t == MH.tmid) MH(acc, cur, wr, wc, fr, fq); }
            PG8_LDB(B0, 0, 0); PG8_LDB(B1, 0, 1); PG8_SCHED; PG8_LDA(At, 0, 0); PG8_STAGE(PG8_SA(1, 1), a1 + hstepA, voffA);
            PG8_WAIT_V(8); PG8_WAIT_L(0); PG8_BAR; PG8_MMA(0, 0, At, B0); PG8_MMA(0, 1, At, B1); PG8_BAR; PG8_SCHED;
            PG8_LDA(At, 0, 1); PG8_STAGE(PG8_SB(0, 0), b2, voffB); PG8_STAGE(PG8_SB(0, 1), b2 + hstepB, voffB); PG8_STAGE(PG8_SA(0, 0), a2, voffA);
            PG8_WAIT_V(8); PG8_WAIT_L(0); PG8_BAR; PG8_MMA(1, 0, At, B0); PG8_MMA(1, 1, At, B1); PG8_BAR; PG8_SCHED;
            PG8_LDB(B0, 1, 0); PG8_LDB(B1, 1, 1); PG8_SCHED; PG8_LDA(At, 1, 0); PG8_STAGE(PG8_SA(0, 1), a2 + hstepA, voffA);
            PG8_WAIT_V(8); PG8_WAIT_L(0); PG8_BAR; PG8_MMA(0, 0, At, B0); PG8_MMA(0, 1, At, B1); PG8_BAR; PG8_SCHED;
            PG8_LDA(At, 1, 1); PG8_STAGE(PG8_SB(1, 0), b3, voffB); PG8_STAGE(PG8_SB(1, 1), b3 + hstepB, voffB); PG8_STAGE(PG8_SA(1, 0), a3, voffA);
            PG8_WAIT_V(8); PG8_WAIT_L(0); PG8_BAR; PG8_MMA(1, 0, At, B0); PG8_MMA(1, 1, At, B1); PG8_BAR; PG8_SCHED;
        }
        if constexpr (ALIGN_EPI) { if (wr == 0) PG8_BAR; }
        if constexpr (F8) {
            asm volatile("s_nop 15\n\ts_nop 15" : "+v"(acc[0][0][0][0]), "+v"(acc[0][0][0][1]), "+v"(acc[0][0][1][0]), "+v"(acc[0][0][1][1]), "+v"(acc[0][0][2][0]), "+v"(acc[0][0][2][1]), "+v"(acc[0][0][3][0]), "+v"(acc[0][0][3][1]),
                                                   "+v"(acc[0][1][0][0]), "+v"(acc[0][1][0][1]), "+v"(acc[0][1][1][0]), "+v"(acc[0][1][1][1]), "+v"(acc[0][1][2][0]), "+v"(acc[0][1][2][1]), "+v"(acc[0][1][3][0]), "+v"(acc[0][1][3][1]) :: "memory");
            asm volatile("" : "+v"(acc[1][0][0][0]), "+v"(acc[1][0][0][1]), "+v"(acc[1][0][1][0]), "+v"(acc[1][0][1][1]), "+v"(acc[1][0][2][0]), "+v"(acc[1][0][2][1]), "+v"(acc[1][0][3][0]), "+v"(acc[1][0][3][1]),
                              "+v"(acc[1][1][0][0]), "+v"(acc[1][1][0][1]), "+v"(acc[1][1][1][0]), "+v"(acc[1][1][1][1]), "+v"(acc[1][1][2][0]), "+v"(acc[1][1][2][1]), "+v"(acc[1][1][3][0]), "+v"(acc[1][1][3][1]) :: "memory"); }
        E(acc, cur, wr, wc, fr, fq, (const PG8_LAS float*)(lds + RSL_OFF + rpar * 1024)); S.done(cur); rpar ^= 1;
        if (!has_next) break;
#pragma unroll
        for (int a = 0; a < 2; ++a)
#pragma unroll
            for (int b = 0; b < 2; ++b)
#pragma unroll
                for (int m = 0; m < 4; ++m)
#pragma unroll
                    for (int n = 0; n < 2; ++n) acc[a][b][m][n] = (f32x4){0.f, 0.f, 0.f, 0.f};
        cur = nxt; cA = nA; cB = nB; ++ui;
        PG8_RSPF(cur, rpar);
        if constexpr (ALIGN_EPI) { if (wr == 1) PG8_BAR; }
    }
    PG8_WAIT_V(0);
    if constexpr (!ALIGN_EPI) { if (wr == 0) PG8_BAR; }
    PG8_BAR;
#undef PG8_SA
#undef PG8_SB
#undef PG8_STAGE
#undef PG8_LDA
#undef PG8_LDB
#undef PG8_MMA
#undef PG8_WAIT_V
#undef PG8_WAIT_L
#undef PG8_BAR
#undef PG8_SCHED
#undef PG8_RSPF
}
}
#ifndef ATT_PRIO
#define ATT_PRIO 2
#endif
#ifndef ATT_STAGGER
#define ATT_STAGGER 0
#endif
namespace att {
typedef unsigned short bf16_t;
typedef short bf16x8 __attribute__((ext_vector_type(8)));
typedef short s16x4 __attribute__((ext_vector_type(4)));
typedef float f32x16 __attribute__((ext_vector_type(16)));
typedef float f32x4 __attribute__((ext_vector_type(4)));
typedef unsigned u32x4 __attribute__((ext_vector_type(4)));
constexpr int D = 128, NW = 8, QBLK = 32, KVBLK = 64, QB = NW * QBLK;
constexpr int SHM_V = KVBLK * D * 2, SHM_K = KVBLK * D * 2;
constexpr int OFF_WS = 2 * SHM_V + 2 * SHM_K;
constexpr int OFF_BIAS = OFF_WS + NW * 64 * 4;
constexpr int OFF_Q = OFF_BIAS + 2 * 64 * 4;
constexpr int OFF_OST = 69632;
constexpr int OST_PITCH = 136, OST_WAVE = 32 * OST_PITCH * 2;
constexpr int LDS_BYTES = OFF_OST + NW * OST_WAVE;
static_assert(OFF_Q + 16 <= OFF_OST, "attention LDS map");
constexpr int PKV = 12288;
constexpr int PO = 6144;
constexpr int META_ROW0 = 16384;
constexpr float SCALE = 0.08838834764831845f;
constexpr float C2 = 1.4426950408889634f * SCALE;
constexpr float THR = 8.f;
constexpr unsigned WBIG = 0x40000000u;

#define KSWZ(row, colB) ((row) * 256 + ((colB) ^ (((row) & 7) << 4)))
#define SBAR() __builtin_amdgcn_sched_barrier(0)
__device__ __forceinline__ int v_st(int k, int c) { const int kk = (k & ~0xC) | ((k & 4) << 1) | ((k & 8) >> 1); return ((kk >> 3) * 4 + (c >> 5)) * 512 + ((kk & 7) * 32 + (c & 31)) * 2; }
__device__ __forceinline__ int v_rd_base(int lane) { return ((lane & 3) << 3) | (((lane >> 2) & 3) << 6) | (((lane >> 4) & 1) << 5) | (((lane >> 5) & 1) << 8); }
constexpr int v_rd_off(int d0, int ks, int half) { return d0 * 512 + ks * 4096 + half * 2048; }
__device__ __forceinline__ int crow(int r, int hi) { return (r & 3) + 8 * (r >> 2) + 4 * hi; }
__device__ __forceinline__ unsigned cvtpk(float lo, float hi) { unsigned r; asm volatile("v_cvt_pk_bf16_f32 %0, %1, %2" : "=v"(r) : "v"(lo), "v"(hi)); return r; }
__device__ __forceinline__ bf16x8 load8(const bf16_t* p) { return *reinterpret_cast<const bf16x8*>(p); }

__device__ __forceinline__ void mask_tile(f32x16& p0, f32x16& p1, int dq) {
    const float NEG = -__builtin_inff();
#pragma unroll
    for (int r = 0; r < 16; ++r) {
        const int c = (r & 3) + 8 * (r >> 2);
        if ((unsigned)(dq - c) >= WBIG) p0[r] = NEG;
        if ((unsigned)(dq - c - 32) >= WBIG) p1[r] = NEG;
    }
}
__device__ __forceinline__ void mask_tile0(f32x16& p0, f32x16& p1) {
    const float NEG = -__builtin_inff();
#pragma unroll
    for (int r = 0; r < 16; ++r) { p0[r] = NEG; if (r < 8) p1[r] = NEG; }
}
__device__ __forceinline__ void partialSM(f32x16& p0, f32x16& p1, float& m_reg, float& mn, float& alpha) {
    float pmax = p0[0]; for (int r = 1; r < 16; ++r) pmax = fmaxf(pmax, p0[r]); for (int r = 0; r < 16; ++r) pmax = fmaxf(pmax, p1[r]);
    { auto rr = __builtin_amdgcn_permlane32_swap(__float_as_uint(pmax), __float_as_uint(pmax), false, false);
      pmax = fmaxf(__uint_as_float(rr[0]), __uint_as_float(rr[1])); }
    if (__builtin_expect(__all((pmax - m_reg) * SCALE <= THR), 1)) { mn = m_reg; alpha = 1.f; }
    else { mn = fmaxf(m_reg, pmax); alpha = __builtin_amdgcn_exp2f((m_reg - mn) * C2); m_reg = mn; }
    const float mnL = -mn * C2;
    for (int r = 0; r < 16; ++r) p0[r] = fmaf(p0[r], C2, mnL); for (int r = 0; r < 16; ++r) p1[r] = fmaf(p1[r], C2, mnL);
    for (int r = 0; r < 16; ++r) p0[r] = __builtin_amdgcn_exp2f(p0[r]);
}
__device__ __forceinline__ void finishSM(f32x16& p0, f32x16& p1, float alpha, float& l_reg, bf16x8& pa0, bf16x8& pa1, bf16x8& pa2, bf16x8& pa3) {
    for (int r = 0; r < 16; ++r) p1[r] = __builtin_amdgcn_exp2f(p1[r]);
    float ps = 0; for (int r = 0; r < 16; ++r) ps += p0[r]; for (int r = 0; r < 16; ++r) ps += p1[r];
    { auto rr = __builtin_amdgcn_permlane32_swap(__float_as_uint(ps), __float_as_uint(ps), false, false);
      ps = __uint_as_float(rr[0]) + __uint_as_float(rr[1]); }
    l_reg = l_reg * alpha + ps;
#define PK4(P, B_, OUT) do { unsigned a0 = cvtpk(P[B_+0], P[B_+1]), a1 = cvtpk(P[B_+2], P[B_+3]);                          \
        unsigned b0 = cvtpk(P[B_+4], P[B_+5]), b1 = cvtpk(P[B_+6], P[B_+7]);                                             \
        auto r0 = __builtin_amdgcn_permlane32_swap(a0, b0, false, false); auto r1 = __builtin_amdgcn_permlane32_swap(a1, b1, false, false); \
        u32x4 w = {r0[0], r1[0], r0[1], r1[1]}; OUT = *reinterpret_cast<bf16x8*>(&w); } while (0)
    PK4(p0, 0, pa0); PK4(p0, 8, pa1); PK4(p1, 0, pa2); PK4(p1, 8, pa3);
#undef PK4
}
template <int KB>
__device__ __forceinline__ void qkt(f32x16& p0, f32x16& p1, const char* K_lds, int r32, int hi, const bf16x8* qr, const float* bias_l) {
    { const f32x4* bb = (const f32x4*)(bias_l + KB * 64 + 4 * hi);
#pragma unroll
      for (int g = 0; g < 4; ++g) { const f32x4 b0 = bb[2 * g], b1 = bb[8 + 2 * g];
#pragma unroll
          for (int i = 0; i < 4; ++i) { p0[4 * g + i] = b0[i]; p1[4 * g + i] = b1[i]; } } }
    const char* kb[4];
#pragma unroll
    for (int dd = 0; dd < 4; ++dd) kb[dd] = K_lds + KB * SHM_K + KSWZ(r32, (dd * 16 + hi * 8) * 2);
    if (ATT_PRIO & 1) __builtin_amdgcn_s_setprio(1);
#pragma unroll
    for (int d0 = 0; d0 < 8; ++d0) { const char* a = kb[d0 & 3] + (d0 >> 2) * 128;
        bf16x8 b0 = *reinterpret_cast<const bf16x8*>(a);
        bf16x8 b1 = *reinterpret_cast<const bf16x8*>(a + 32 * 256);
        p0 = __builtin_amdgcn_mfma_f32_32x32x16_bf16(b0, qr[d0], p0, 0, 0, 0);
        p1 = __builtin_amdgcn_mfma_f32_32x32x16_bf16(b1, qr[d0], p1, 0, 0, 0); }
    if (ATT_PRIO & 1) __builtin_amdgcn_s_setprio(0);
}
template <int VB>
__device__ __forceinline__ void pv_tile(f32x16* o, int vb0, bf16x8 pa0, bf16x8 pa1, bf16x8 pa2, bf16x8 pa3) {
#define TRRD(dst, off) asm volatile("ds_read_b64_tr_b16 %0, %1 offset:%2" : "=&v"(dst) : "v"(vb0), "i"(off) : "memory")
#define PV_D0(d0) do { s16x4 l0, l1, l2, l3, h0, h1, h2, h3; constexpr int b_ = VB * SHM_V + v_rd_off(d0, 0, 0);     \
        TRRD(l0, b_); TRRD(h0, b_ + 2048); TRRD(l1, b_ + 4096); TRRD(h1, b_ + 6144); TRRD(l2, b_ + 8192); TRRD(h2, b_ + 10240); TRRD(l3, b_ + 12288); TRRD(h3, b_ + 14336); \
        asm volatile("s_waitcnt lgkmcnt(0)" ::: "memory"); SBAR();   \
        o[d0] = __builtin_amdgcn_mfma_f32_32x32x16_bf16(pa0, (bf16x8){l0[0], l0[1], l0[2], l0[3], h0[0], h0[1], h0[2], h0[3]}, o[d0], 0, 0, 0);   \
        o[d0] = __builtin_amdgcn_mfma_f32_32x32x16_bf16(pa1, (bf16x8){l1[0], l1[1], l1[2], l1[3], h1[0], h1[1], h1[2], h1[3]}, o[d0], 0, 0, 0);   \
        o[d0] = __builtin_amdgcn_mfma_f32_32x32x16_bf16(pa2, (bf16x8){l2[0], l2[1], l2[2], l2[3], h2[0], h2[1], h2[2], h2[3]}, o[d0], 0, 0, 0);   \
        o[d0] = __builtin_amdgcn_mfma_f32_32x32x16_bf16(pa3, (bf16x8){l3[0], l3[1], l3[2], l3[3], h3[0], h3[1], h3[2], h3[3]}, o[d0], 0, 0, 0); } while (0)
    if (ATT_PRIO & 2) __builtin_amdgcn_s_setprio(1);
    PV_D0(0); PV_D0(1); PV_D0(2); PV_D0(3);
    if (ATT_PRIO & 2) __builtin_amdgcn_s_setprio(0);
#undef PV_D0
#undef TRRD
}

struct BlockRef { const bf16_t* Q; const bf16_t* K; const bf16_t* V; bf16_t* O; const float* kb; float sl2; int rowb; int P0; int jlo; int probe; };
struct Seam { bf16x8 qr[8]; bf16x8 st_v0, st_v1, st_k0, st_k1; float st_b; };

#define VMW() asm volatile("s_waitcnt vmcnt(0)" ::: "memory")
#define VMWN(n) asm volatile("s_waitcnt vmcnt(%0)" :: "i"(n) : "memory")
__device__ __forceinline__ bf16x8 load8o(const bf16_t* base, unsigned byteoff) { return *reinterpret_cast<const bf16x8*>((const char*)base + byteoff); }
__device__ __forceinline__ void sload(Seam& S, const BlockRef& R, int j, int sr, int sc, int wid, int lane) {
    if (R.probe) j = R.jlo;
    const int rb = (j == 0) ? (META_ROW0 - 48) : (R.rowb + 64 * (j - 1));
    const unsigned o0 = (unsigned)((rb + sr) * PKV + sc) * 2u, o1 = (unsigned)((rb + 32 + sr) * PKV + sc) * 2u;
    S.st_v0 = load8o(R.V, o0); S.st_v1 = load8o(R.V, o1);
    S.st_k0 = load8o(R.K, o0); S.st_k1 = load8o(R.K, o1);
    if (wid == 0) { const int e = 64 * j + lane; S.st_b = R.kb ? R.kb[e] : R.sl2 * (float)(e - (R.P0 + QB)); }
}
__device__ __forceinline__ float row_bias(const BlockRef& R, int wid, int r32) { const int rr = wid * QBLK + r32; return R.kb ? R.kb[R.P0 + rr] : R.sl2 * (float)(rr - QB); }
#define SWRITE_K(bf) do { *(bf16x8*)(K_lds + (bf) * SHM_K + kws) = S.st_k0; *(bf16x8*)(K_lds + (bf) * SHM_K + kws + 32 * 256) = S.st_k1; \
                          if (wid == 0) bias_l[(bf) * 64 + lane] = S.st_b; } while (0)
#define SWRITE_V(bf) do { *(bf16x8*)(V_lds + (bf) * SHM_V + vst0) = S.st_v0; *(bf16x8*)(V_lds + (bf) * SHM_V + vst0 + 8192) = S.st_v1; } while (0)

__device__ __forceinline__ void attn_prime(const int tid, const BlockRef& cur, char* lds, Seam& S) {
    const int wid = __builtin_amdgcn_readfirstlane(tid >> 6), lane = tid & 63, r32 = lane & 31, hi = lane >> 5;
    const int sr = tid >> 4, sc = (tid & 15) * 8, kws = KSWZ(sr, sc * 2); char* K_lds = lds + 2 * SHM_V; float* bias_l = (float*)(lds + OFF_BIAS);
#pragma unroll
    for (int d0 = 0; d0 < 8; ++d0) S.qr[d0] = load8o(cur.Q, (unsigned)((wid * QBLK + r32) * PKV + d0 * 16 + hi * 8) * 2u);
    sload(S, cur, cur.jlo, sr, sc, wid, lane); VMW(); SWRITE_K(0);
    __syncthreads();
}
__device__ __forceinline__ void attn_block(const int tid, const BlockRef& cur, const BlockRef& nxt, char* lds, Seam& S) {
    const int wid = __builtin_amdgcn_readfirstlane(tid >> 6), lane = tid & 63, r32 = lane & 31, hi = lane >> 5;
    const int j0 = cur.jlo, NT = (cur.P0 + QB - 1) / KVBLK + 1 - j0;
    const int qlo = cur.P0 + wid * QBLK, qm = qlo + r32 - 4 * hi;
    char* V_lds = lds; char* K_lds = lds + 2 * SHM_V;
    float* ws = (float*)(lds + OFF_WS) + wid * 64; float* li_l = ws, * al_l = ws + 32;
    float* bias_l = (float*)(lds + OFF_BIAS);
    float m_reg = -1e30f, l_reg = 0; f32x16 o[4] = {};
    const int sr = tid >> 4, sc = (tid & 15) * 8, vst0 = v_st(sr, sc), kws = KSWZ(sr, sc * 2);
    const int vb0 = (int)(uintptr_t)V_lds + v_rd_base(lane);
#define RESC(a) do { if (__any((a) < 1.f)) { if (hi == 0) al_l[r32] = (a); asm volatile("s_waitcnt lgkmcnt(0)" ::: "memory");              \
                     for (int d_ = 0; d_ < 4; ++d_) for (int r = 0; r < 16; ++r) o[d_][r] *= al_l[crow(r, hi)]; } } while (0)
#define MASKT(P0_, P1_, t) do { const int kb_ = (j0 + (t)) * KVBLK; if (kb_ + KVBLK - 1 > qlo) mask_tile(P0_, P1_, qm - kb_); } while (0)
    f32x16 pA0, pA1, pB0, pB1; float mnA, mnB, alA, alB; bf16x8 pa0, pa1, pa2, pa3;
    SWRITE_V(0); SBAR();
    if (NT > 1) sload(S, cur, j0 + 1, sr, sc, wid, lane);
    SBAR(); qkt<0>(pA0, pA1, K_lds, r32, hi, S.qr, bias_l);
    if (j0 == 0) mask_tile0(pA0, pA1);
    partialSM(pA0, pA1, m_reg, mnA, alA);
    if (NT > 1) { VMW(); SWRITE_V(1); SWRITE_K(1); }
    __syncthreads();
#define HALF_STEP(PX0, PX1, mnX, alX, PY0, PY1, alY, t, KB, VB, SB) do {                                                      \
        SBAR(); if (ATT_STAGGER && wid >= 4) __builtin_amdgcn_s_sleep(ATT_STAGGER); SBAR(); if ((t) + 1 < NT) { sload(S, cur, j0 + (t) + 1, sr, sc, wid, lane); SBAR(); }     \
        qkt<KB>(PX0, PX1, K_lds, r32, hi, S.qr, bias_l);                                                                      \
        finishSM(PY0, PY1, alY, l_reg, pa0, pa1, pa2, pa3); SBAR();                                                           \
        pv_tile<VB>(o, vb0, pa0, pa1, pa2, pa3); MASKT(PX0, PX1, (t)); partialSM(PX0, PX1, m_reg, mnX, alX);       \
        __syncthreads();                                                                                                      \
        if ((t) + 1 < NT) { VMW(); SWRITE_V(SB); SWRITE_K(SB); }                                                              \
        RESC(alX); __syncthreads(); } while (0)
    for (int t = 1; t + 1 < NT; t += 2) {
        HALF_STEP(pB0, pB1, mnB, alB, pA0, pA1, alA, t, 1, 0, 0);
        HALF_STEP(pA0, pA1, mnA, alA, pB0, pB1, alB, t + 1, 0, 1, 1);
    }
    constexpr bool even = false;
    if (even) { SBAR(); qkt<1>(pB0, pB1, K_lds, r32, hi, S.qr, bias_l); SBAR(); }
    sload(S, nxt, nxt.jlo, sr, sc, wid, lane); SBAR();
#pragma unroll
    for (int d0 = 0; d0 < 8; ++d0) S.qr[d0] = load8o(nxt.Q, (unsigned)((wid * QBLK + r32) * PKV + d0 * 16 + hi * 8) * 2u);
    SBAR();
    finishSM(pA0, pA1, alA, l_reg, pa0, pa1, pa2, pa3); SBAR();
    pv_tile<0>(o, vb0, pa0, pa1, pa2, pa3);
    if (even) { MASKT(pB0, pB1, NT - 1); partialSM(pB0, pB1, m_reg, mnB, alB); __syncthreads(); RESC(alB);
        finishSM(pB0, pB1, alB, l_reg, pa0, pa1, pa2, pa3); SBAR(); pv_tile<1>(o, vb0, pa0, pa1, pa2, pa3); }
    SBAR(); VMWN(8); SWRITE_K(0); SBAR();
    if (hi == 0) li_l[r32] = l_reg; asm volatile("s_waitcnt lgkmcnt(0)" ::: "memory");
    float rli[16];
#pragma unroll
    for (int r = 0; r < 16; ++r) rli[r] = __builtin_amdgcn_rcpf(li_l[crow(r, hi)]);
    bf16_t* Ow = cur.O + (size_t)(wid * QBLK) * PO;
    bf16_t* stg = (bf16_t*)(lds + OFF_OST + wid * OST_WAVE);
#pragma unroll
    for (int r = 0; r < 16; ++r) { const int orow = crow(r, hi);
#pragma unroll
        for (int d0 = 0; d0 < 4; ++d0) { const float v = o[d0][r] * rli[r];
            const float vn = __int_as_float(__builtin_amdgcn_mov_dpp(__float_as_int(v), 0xB1, 0xF, 0xF, true));
            if ((r32 & 1) == 0) *(unsigned*)(stg + orow * OST_PITCH + d0 * 32 + r32) = cvtpk(v, vn); } }
    asm volatile("s_waitcnt lgkmcnt(0)" ::: "memory");
#pragma unroll
    for (int i = 0; i < 8; ++i) { const int row = i * 4 + (lane >> 4), ch = lane & 15;
        const u32x4 v = *(const u32x4*)(stg + row * OST_PITCH + ch * 8);
        *(u32x4*)(Ow + (size_t)row * PO + ch * 8) = v; }
    __syncthreads();
#undef RESC
#undef MASKT
#undef HALF_STEP
}
#undef VMW
#undef VMWN
#undef SWRITE_K
#undef SWRITE_V
#undef KSWZ
#undef SBAR
}
constexpr int NWAVES = 8;
constexpr int DM = 4096, NB = 4, SEQ = 4096, NMETA = 16, DFF = 11008;
constexpr int MR = NB * SEQ;
constexpr int MT = MR + 256;
constexpr int NGU = 2 * DFF;
constexpr int NIN = 20736;
constexpr int PQKV = 12288, PGATE = 8192, PAO = 6144;
#ifndef GU_F8
#define GU_F8 1
#endif
#ifndef GATES_F8
#define GATES_F8 1
#endif
#ifndef PU_PAD
#define PU_PAD 0
#endif
constexpr int PU = DM + PU_PAD;
constexpr size_t WD_PSTR = (size_t)4096 * 4096;
constexpr int EKV = 4160;
constexpr float RMS_EPS = 1e-6f;
constexpr float LOG2E = 1.4426950408889634f;
constexpr float ISCALE = 11.313708498984761f;
constexpr float LAMBDA_INIT = 0.2f;

constexpr size_t MiB = 1u << 20;
constexpr size_t WS_CTL = 0, CTL_ZERO_BYTES = 1 * MiB;
constexpr size_t WS_KB = 1 * MiB;
constexpr size_t WS_FLOG = 3 * MiB;
constexpr size_t WS_JLO = 5 * MiB;
constexpr size_t WS_RS0 = 6 * MiB, WS_RS1 = WS_RS0 + 128 * 1024, WS_RS2 = WS_RS1 + 128 * 1024;
constexpr size_t WS_WGU = 8 * MiB;
constexpr size_t WS_WD = 180 * MiB;
constexpr size_t WS_P = WS_WGU;
constexpr size_t WS_WIN = 276 * MiB;
constexpr size_t WS_WGU8 = WS_WIN;
constexpr int GU8_TILES = 0, GU8_ROW0 = (86 - GU8_TILES) * 256;
constexpr size_t WS_WIN8 = WS_WIN + 96 * MiB;
constexpr size_t WS_U8 = 1412 * MiB;
constexpr size_t WS_WO = 438 * MiB;
constexpr size_t WS_WOUT = 470 * MiB;
constexpr size_t WS_U = 502 * MiB;
constexpr size_t WS_Y = 632 * MiB;
constexpr size_t WS_BIG = 762 * MiB;
constexpr size_t WS_GATES = WS_BIG + 390 * MiB;
constexpr size_t WS_AO = 1412 * MiB;
constexpr size_t WS_MG = 1604 * MiB;
constexpr size_t WS_END = 1732 * MiB;
static_assert((size_t)NGU * DM * 2 <= 172 * MiB && (size_t)3 * DM * 4096 * 2 <= 96 * MiB && (size_t)NIN * DM * 2 <= 162 * MiB && (size_t)MT * DM * 2 <= 130 * MiB && (size_t)MT * PU * 2 <= 130 * MiB, "ws map");
static_assert((size_t)MT * DFF * 2 <= 650 * MiB && (size_t)MT * PQKV * 2 <= 390 * MiB && (size_t)MT * PGATE * 2 <= 260 * MiB && (size_t)MR * DM * 4 <= 258 * MiB, "ws map");
static_assert((size_t)NB * 16 * EKV * 4 <= 2 * MiB && (size_t)MT * 16 * 4 <= 2 * MiB, "ws map");
constexpr int CW_BAR = 4096;
constexpr int CW_CQ2 = 8448;
constexpr int CW_CQ = 8320;
constexpr int CW_Q = 8192;
constexpr float SKIP_TH = 44.0f;

constexpr int RING_OFF = 0, RING_BYTES = 131072;
constexpr int LDSCTL_OFF = 139264, MISC_OFF = LDSCTL_OFF + 320;
constexpr int LDS_BYTES = 147456;
static_assert(MISC_OFF + 128 <= LDS_BYTES && att::LDS_BYTES <= LDSCTL_OFF && RING_BYTES <= LDSCTL_OFF, "LDS map");

#define GAS __attribute__((address_space(1)))
#define LAS __attribute__((address_space(3)))
typedef unsigned short bf16;
typedef unsigned v4u __attribute__((ext_vector_type(4)));
typedef unsigned v2u __attribute__((ext_vector_type(2)));
typedef float f32x4 __attribute__((ext_vector_type(4)));
typedef GAS unsigned gu32;
#define RLX_AGENT __ATOMIC_RELAXED, __HIP_MEMORY_SCOPE_AGENT
#define LDS_WAIT() asm volatile("s_waitcnt lgkmcnt(0)" ::: "memory")
#define VM_WAIT() asm volatile("s_waitcnt vmcnt(0)" ::: "memory")
__device__ __forceinline__ unsigned f2bf(float f) { unsigned u = __builtin_bit_cast(unsigned, f); return (u + 0x7fffu + ((u >> 16) & 1u)) >> 16; }
__device__ __forceinline__ unsigned pk2(float lo, float hi) { return f2bf(lo) | (f2bf(hi) << 16); }
__device__ __forceinline__ float bflo(unsigned w) { return __uint_as_float(w << 16); }
__device__ __forceinline__ float bfhi(unsigned w) { return __uint_as_float(w & 0xffff0000u); }

#define XB_TMO      128
#define XB_XCNT(j)  (256  + 64 * (j))
#define XB_XSUB(j)  (1280 + 64 * (j))
#define XB_XGEN(j)  (2304 + 64 * (j))
#define XB_TOP      3328
#define XB_TOPGEN   3392
#define XCD_BAR_WORDS 3456
#define XB_SPIN_CAP (1u << 22)

__device__ __forceinline__ unsigned xb_ld(unsigned* p)              { return __hip_atomic_load(p, __ATOMIC_RELAXED, __HIP_MEMORY_SCOPE_AGENT); }
__device__ __forceinline__ unsigned xb_add(unsigned* p, unsigned v) { return __hip_atomic_fetch_add(p, v, __ATOMIC_RELAXED, __HIP_MEMORY_SCOPE_AGENT); }
__device__ __forceinline__ unsigned xb_xcc_id() { return (unsigned)__builtin_amdgcn_s_getreg((3 << 11) | 20) & 0xFu; }
#define XB_SPIN(cond, bar) do { unsigned _sp = 0; while (cond) { __builtin_amdgcn_s_sleep(1); \
    if ((++_sp & 255u) == 0u) { if (xb_ld(&(bar)[XB_TMO])) break; if (_sp > XB_SPIN_CAP) { atomicAdd(&(bar)[XB_TMO], 1u); break; } } } } while (0)

struct XcdBarrier {
    unsigned* bar; unsigned x;
    volatile LAS unsigned* st;
};
__device__ __forceinline__ XcdBarrier xcd_barrier_post(unsigned* bar, volatile LAS unsigned* st, int tid) {
    XcdBarrier b; b.bar = bar; b.x = xb_xcc_id(); b.st = st;
    if (tid == 0) (void)xb_add(&bar[XB_XCNT(b.x)], 1u);
    return b;
}
__device__ __forceinline__ void xcd_barrier_complete(unsigned* bar, unsigned x, unsigned& nloc, unsigned& nx) {
    const unsigned G = gridDim.x * gridDim.y * gridDim.z;
    unsigned sum, cnt, mine, sp = 0u;
    for (;;) {
        sum = 0u; cnt = 0u; mine = 0u;
#pragma unroll
        for (unsigned j = 0; j < 16; ++j) { const unsigned c = xb_ld(&bar[XB_XCNT(j)]); sum += c; cnt += (c > 0u) ? 1u : 0u; mine = (j == x) ? c : mine; }
        if (sum == G) break;
        __builtin_amdgcn_s_sleep(1);
        if ((++sp & 255u) == 0u) { if (xb_ld(&bar[XB_TMO])) break; if (sp > XB_SPIN_CAP) { atomicAdd(&bar[XB_TMO], 1u); break; } }
    }
    nloc = mine > 0u ? mine : 1u; nx = cnt > 0u ? cnt : 1u;
}
__device__ __forceinline__ void xcd_barrier(const XcdBarrier& b, int tid) {
    asm volatile("s_waitcnt vmcnt(0)" ::: "memory");
    __syncthreads();
    if (tid == 0) {
        unsigned* bar = b.bar;
        __builtin_amdgcn_s_waitcnt(0);
        unsigned nloc = b.st[0], nx = b.st[1];
        if (nloc == 0u) { xcd_barrier_complete(bar, b.x, nloc, nx); b.st[0] = nloc; b.st[1] = nx; }
        const unsigned old = xb_add(&bar[XB_XSUB(b.x)], 1u);
        const unsigned gen = old / nloc;
        if (old + 1u == (gen + 1u) * nloc) {
            __builtin_amdgcn_fence(__ATOMIC_RELEASE, "agent");
            asm volatile("s_waitcnt vmcnt(0)" ::: "memory");
            const unsigned og = xb_add(&bar[XB_TOP], 1u);
            const unsigned tg = og / nx;
            if (og + 1u == (tg + 1u) * nx) xb_add(&bar[XB_TOPGEN], 1u);
            else XB_SPIN(xb_ld(&bar[XB_TOPGEN]) == tg, bar);
            __builtin_amdgcn_fence(__ATOMIC_ACQUIRE, "agent");
            xb_add(&bar[XB_XGEN(b.x)], 1u);
            asm volatile("s_waitcnt vmcnt(0)" ::: "memory");
        } else {
            XB_SPIN(xb_ld(&bar[XB_XGEN(b.x)]) == gen, bar);
            __builtin_amdgcn_fence(__ATOMIC_ACQUIRE, "agent");
            asm volatile("s_waitcnt vmcnt(0)" ::: "memory");
        }
    }
    __syncthreads();
}

typedef const __attribute__((address_space(4))) char* KP;
__device__ __forceinline__ KP kargs() { KP p = (KP)__builtin_amdgcn_kernarg_segment_ptr(); asm volatile("" : "+s"(p)); return p; }
template <class T> __device__ __forceinline__ T* karg(KP kp, int i) { return *(T* const __attribute__((address_space(4)))*)(kp + 8 * i); }
enum { A_X = 0, A_META, A_G_FF1_PRE, A_W_GATE1, A_W_UP1, A_W_DOWN1, A_G_FF1_POST, A_G_MIX_PRE, A_W_IN, A_B_FORGET, A_LQ1, A_LK1, A_LQ2, A_LK2, A_G_SUBLN, A_W_O_FOX, A_W_O_DIFF, A_W_OUT,
       A_G_MIX_POST, A_G_FF2_PRE, A_W_GATE2, A_W_UP2, A_W_DOWN2, A_G_FF2_POST, A_OUT, A_WS };
struct Frame {
    LAS unsigned char* lds;
    int tid, lane, wave;
    int vcu, G;
};
__device__ __forceinline__ void frame_refresh(Frame& F) {
    int l; asm volatile("v_mbcnt_lo_u32_b32 %0, -1, 0\n\tv_mbcnt_hi_u32_b32 %0, -1, %0" : "=v"(l));
    F.lane = l; F.tid = F.wave * 64 + l;
}
template <class T> __device__ __forceinline__ T* wsp(KP kp, size_t off) { return (T*)(karg<unsigned char>(kp, A_WS) + off); }

__device__ __forceinline__ float wave_sum(float v) {
#pragma unroll
    for (int o = 1; o < 64; o <<= 1) v += __shfl_xor(v, o);
    return v;
}
struct OnesTab { float v[DFF]; };
constexpr OnesTab make_ones() { OnesTab t{}; for (int i = 0; i < DFF; ++i) t.v[i] = 1.0f; return t; }
__device__ const OnesTab ONES = make_ones();
struct TrDesc { const float* W; unsigned char* WT; const float* gk; int N, k0, ns, nd, kd; unsigned ldt; float sc;
    __device__ __forceinline__ void set(const float* W_, unsigned char* WT_, const float* gk_, int N_, int k0_, int ns_, int nd_, int kd_, unsigned ldt_, float sc_) { W = W_; WT = WT_; gk = gk_; N = N_; k0 = k0_; ns = ns_; nd = nd_; kd = kd_; ldt = ldt_; sc = sc_; } };
__device__ __forceinline__ void tr_load(const TrDesc& d, int lane, float (&r)[32], f32x4 (&g)[2]) {
    g[0] = *(const GAS f32x4*)(d.gk + d.k0 + 8 * (lane & 7)); g[1] = *(const GAS f32x4*)(d.gk + d.k0 + 8 * (lane & 7) + 4);
    const GAS float* p = (const GAS float*)d.W + (size_t)(d.k0 + (lane >> 5)) * d.N + d.ns + (lane & 31);
#pragma unroll
    for (int i = 0; i < 32; ++i) r[i] = p[(size_t)(2 * i) * d.N];
}
__device__ __forceinline__ void tr_finish(const TrDesc& d, LAS float* scr, int lane, const float (&r)[32], const f32x4 (&g)[2]) {
#pragma unroll
    for (int i = 0; i < 32; ++i) scr[(2 * i + (lane >> 5)) * 33 + (lane & 31)] = r[i];
    const int c = lane & 7;
    f32x4 ga = g[0], gb = g[1];
    LDS_WAIT(); asm volatile("" ::: "memory");
    if (d.sc != 0.f) { ga = ga * d.sc; gb = gb * d.sc;
#pragma unroll
        for (int j = 0; j < 4; ++j) { const int n = (lane >> 3) + 8 * j; const LAS float* s = scr + (8 * c) * 33 + n;
            v2u o; o.x = pg8::pack_fp8x4(s[0 * 33] * ga.x, s[1 * 33] * ga.y, s[2 * 33] * ga.z, s[3 * 33] * ga.w); o.y = pg8::pack_fp8x4(s[4 * 33] * gb.x, s[5 * 33] * gb.y, s[6 * 33] * gb.z, s[7 * 33] * gb.w);
            *(GAS v2u*)(d.WT + (size_t)(d.nd + n) * d.ldt + d.kd + 8 * c) = o; } }
    else {
#pragma unroll
        for (int j = 0; j < 4; ++j) { const int n = (lane >> 3) + 8 * j; const LAS float* s = scr + (8 * c) * 33 + n;
            v4u o; o.x = pk2(s[0 * 33] * ga.x, s[1 * 33] * ga.y); o.y = pk2(s[2 * 33] * ga.z, s[3 * 33] * ga.w); o.z = pk2(s[4 * 33] * gb.x, s[5 * 33] * gb.y); o.w = pk2(s[6 * 33] * gb.z, s[7 * 33] * gb.w);
            *(GAS v4u*)(d.WT + (size_t)(d.nd + n) * d.ldt + (size_t)(d.kd + 8 * c) * 2) = o; } }
    LDS_WAIT(); asm volatile("" ::: "memory");
}
struct GenStride { int it, hi, step; __device__ __forceinline__ bool next(int& o) { if (it >= hi) return false; o = it; it += step; return true; } };
struct GenQueue { unsigned* qhead; int total, lane, cur = 0, end = 0;
    __device__ __forceinline__ bool next(int& o) {
        if (cur >= end) { unsigned base = 0u; if (lane == 0) base = __hip_atomic_fetch_add(qhead, 16u, __ATOMIC_RELAXED, __HIP_MEMORY_SCOPE_AGENT);
            base = (unsigned)__builtin_amdgcn_readfirstlane((int)base); if (base >= (unsigned)total) return false;
            cur = (int)base; end = (int)base + 16 < total ? (int)base + 16 : total; }
        o = cur++; return true; } };
template <class Gen, class Dec>
__device__ __forceinline__ void tr_stream(Frame& F, Gen gen, const Dec& dec) {
    LAS float* scr = (LAS float*)(F.lds + RING_OFF + F.wave * 16384);
    float ra[32], rb[32]; f32x4 gA[2], gB[2]; TrDesc da, db; int it;
    if (!gen.next(it)) return;
    dec(it, da); tr_load(da, F.lane, ra, gA);
    bool hb = gen.next(it); if (hb) dec(it, db); else db = da;
    tr_load(db, F.lane, rb, gB); tr_finish(da, scr, F.lane, ra, gA);
    while (hb) {
        const bool ha = gen.next(it); if (ha) dec(it, da); else da = db;
        tr_load(da, F.lane, ra, gA); tr_finish(db, scr, F.lane, rb, gB);
        if (!ha) break;
        hb = gen.next(it); if (hb) dec(it, db); else db = da;
        tr_load(db, F.lane, rb, gB); tr_finish(da, scr, F.lane, ra, gA);
    }
}
template <int WHICH  >
struct DecFfn { const float* wg; const float* wu; const float* wd; const float* gk; unsigned char* WGU; unsigned char* WD; unsigned char* WGU8;
    static constexpr int NBG = NGU / 32, I_GU = (DM / 64) * NBG, I_D = (DFF / 64) * (DM / 32);
    __device__ __forceinline__ void operator()(int it, TrDesc& d) const {
        if (it < I_GU) { const int kb = it / NBG, nb = it % NBG, pn = nb >> 3, w8 = nb & 7; const float* wa = wg; const float* wb = wu; asm volatile("" : "+s"(wa), "+s"(wb));
            const float* W = w8 < 4 ? wa : wb; const int ns = 128 * pn + 32 * (w8 & 3);
            if ((WHICH & 4) && 32 * nb >= GU8_ROW0) { d.set(W, WGU8, gk, DFF, 64 * kb, ns, 32 * nb - GU8_ROW0, 64 * kb, 4096u, pg8::F8_WINSCALE); return; }
            { d.set(W, WGU, gk, DFF, 64 * kb, ns, 32 * nb, 64 * kb, (unsigned)DM * 2u, 0.f); return; } }
        const int r = it - I_GU, kb = r / (DM / 32), nb = r % (DM / 32);
        { d.set(wd, WD + (size_t)(kb >> 6) * WD_PSTR * 2, ONES.v, DM, 64 * kb, 32 * nb, 32 * nb, (64 * kb) & 4095, 8192u, 0.f); return; } } };
template <int WHICH>
__device__ __forceinline__ void convert_ffn(Frame& F, KP kp, int a_gate, int a_up, int a_down, int a_gain) {
    DecFfn<WHICH> D{karg<const float>(kp, a_gate), karg<const float>(kp, a_up), karg<const float>(kp, a_down), karg<const float>(kp, a_gain), wsp<unsigned char>(kp, WS_WGU), wsp<unsigned char>(kp, WS_WD), wsp<unsigned char>(kp, WS_WGU8)};
    const int gw = F.vcu * NWAVES + F.wave, NGW = F.G * NWAVES;
    constexpr int LO = (WHICH & 1) ? 0 : DecFfn<WHICH>::I_GU, HI = (WHICH & 2) ? DecFfn<WHICH>::I_GU + DecFfn<WHICH>::I_D : DecFfn<WHICH>::I_GU;
    tr_stream(F, GenStride{LO + gw, HI, NGW}, D);
}
struct DecDown8 { const float* wd; unsigned char* WD8;
    __device__ __forceinline__ void operator()(int r, TrDesc& d) const { const int kb = r / (DM / 32), nb = r % (DM / 32);
        { d.set(wd, WD8 + (size_t)(kb >> 6) * WD_PSTR, ONES.v, DM, 64 * kb, 32 * nb, 32 * nb, (64 * kb) & 4095, 4096u, pg8::F8_WSCALE); return; } } };
__device__ __forceinline__ void convert_down_queue8(Frame& F, KP kp, int a_down, int cw) {
    DecDown8 D{karg<const float>(kp, a_down), wsp<unsigned char>(kp, WS_WD)};
    tr_stream(F, GenQueue{wsp<unsigned>(kp, WS_CTL) + cw, (DFF / 64) * (DM / 32), F.lane}, D);
}
__device__ __forceinline__ int win_src_col(int nd) {
    if (nd < 2048) return nd;
    if (nd < 4096) return 6160 + (nd - 2048);
    if (nd < 6144) return 2048 + (nd - 4096);
    if (nd < 8192) return 4096 + (nd - 6144);
    if (nd < 10240) return 8208 + (nd - 8192);
    if (nd < 12288) return 10256 + (nd - 10240);
    if (nd < 16384) return 12304 + (nd - 12288);
    if (nd < 20480) return 16400 + (nd - 16384);
    return 6144;
}
struct DecMixer { const float* w_in; const float* w_o_fox; const float* w_o_diff; const float* w_out; const float* gk; unsigned char* WIN; unsigned char* WO; unsigned char* WOUT; unsigned char* WIN8;
    static constexpr int NBI = 641;
    static constexpr int I_IN = (DM / 64) * NBI, I_OF = (2048 / 64) * (DM / 32), I_OUT = (DM / 64) * (DM / 32), TOTAL = I_IN + 2 * I_OF + I_OUT;
    __device__ __forceinline__ void operator()(int it, TrDesc& d) const {
        int r = it;
        if (r < I_IN) { const int kb = r / NBI, nb = r % NBI, nd = 32 * nb;
            if (GATES_F8 && nd >= 12288 && nd < 20480) { d.set(w_in, WIN8, gk, 20496, 64 * kb, win_src_col(nd), nd - 12288, 64 * kb, 4096u, pg8::F8_WINSCALE); return; }
            { d.set(w_in, WIN, gk, 20496, 64 * kb, win_src_col(nd), nd, 64 * kb, (unsigned)DM * 2u, 0.f); return; } }
        r -= I_IN;
        if (r < I_OF) { const int kb = r / (DM / 32), nb = r % (DM / 32); { d.set(w_o_fox, WO, ONES.v, DM, 64 * kb, 32 * nb, 32 * nb, 64 * kb, 8192u, 0.f); return; } }
        r -= I_OF;
        if (r < I_OF) { const int kb = r / (DM / 32), nb = r % (DM / 32); { d.set(w_o_diff, WO, ONES.v, DM, 64 * kb, 32 * nb, 32 * nb, 2048 + 64 * kb, 8192u, 0.f); return; } }
        r -= I_OF;
        const int kb = r / (DM / 32), nb = r % (DM / 32); { d.set(w_out, WOUT, ONES.v, DM, 64 * kb, 32 * nb, 32 * nb, 64 * kb, (unsigned)DM * 2u, 0.f); return; } } };
__device__ __forceinline__ void convert_mixer_queue(Frame& F, KP kp) {
    DecMixer D{karg<const float>(kp, A_W_IN), karg<const float>(kp, A_W_O_FOX), karg<const float>(kp, A_W_O_DIFF), karg<const float>(kp, A_W_OUT), karg<const float>(kp, A_G_MIX_PRE),
               wsp<unsigned char>(kp, WS_WIN), wsp<unsigned char>(kp, WS_WO), wsp<unsigned char>(kp, WS_WOUT), wsp<unsigned char>(kp, WS_WIN8)};
    tr_stream(F, GenQueue{wsp<unsigned>(kp, WS_CTL) + CW_CQ, DecMixer::TOTAL, F.lane}, D);
}
__device__ __forceinline__ void gain_to_lds(Frame& F, const float* g, int off) {
    const GAS f32x4* s = (const GAS f32x4*)g; LAS f32x4* d = (LAS f32x4*)(F.lds + off);
    for (int i = F.tid; i < DM / 4; i += NWAVES * 64) d[i] = s[i];
}
__device__ __forceinline__ void row_load_f32(const float* p, int lane, f32x4 (&v)[16]) {
    const GAS f32x4* r = (const GAS f32x4*)p + lane;
#pragma unroll
    for (int j = 0; j < 16; ++j) v[j] = r[64 * j];
}
__device__ __forceinline__ void row_load_bf16p(const bf16* p, int lane, v2u (&w)[16]) {
    const GAS v2u* r = (const GAS v2u*)p + lane;
#pragma unroll
    for (int j = 0; j < 16; ++j) w[j] = r[64 * j];
}
__device__ __forceinline__ f32x4 unpack4(v2u w) { return (f32x4){bflo(w.x), bfhi(w.x), bflo(w.y), bfhi(w.y)}; }
__device__ __forceinline__ float row_rstd_p(const v2u (&w)[16]) {
    float s = 0.f;
#pragma unroll
    for (int j = 0; j < 16; ++j) { const f32x4 v = unpack4(w[j]); s += (v.x * v.x + v.y * v.y) + (v.z * v.z + v.w * v.w); }
    return 1.0f / sqrtf(wave_sum(s) * (1.0f / DM) + RMS_EPS);
}
__device__ __forceinline__ void row_store_f32(float* p, int lane, const f32x4 (&v)[16]) {
    GAS f32x4* r = (GAS f32x4*)p + lane;
#pragma unroll
    for (int j = 0; j < 16; ++j) r[64 * j] = v[j];
}
__device__ __forceinline__ void row_store_bf16(bf16* p, int lane, const f32x4 (&v)[16]) {
    GAS v2u* o = (GAS v2u*)p + lane;
#pragma unroll
    for (int j = 0; j < 16; ++j) { v2u w; w.x = pk2(v[j].x, v[j].y); w.y = pk2(v[j].z, v[j].w); o[64 * j] = w; }
}
__device__ __forceinline__ float row_rstd(const f32x4 (&v)[16]) {
    float s = 0.f;
#pragma unroll
    for (int j = 0; j < 16; ++j) s += (v[j].x * v[j].x + v[j].y * v[j].y) + (v[j].z * v[j].z + v[j].w * v[j].w);
    return 1.0f / sqrtf(wave_sum(s) * (1.0f / DM) + RMS_EPS);
}
__device__ __forceinline__ void row_norm_store_both(bf16* orow, unsigned char* o8row, int lane, const f32x4 (&v)[16], float rstd, const LAS f32x4* g) {
    GAS v2u* o = (GAS v2u*)orow + lane; GAS unsigned* o8 = (GAS unsigned*)o8row + lane;
#pragma unroll
    for (int j = 0; j < 16; ++j) { const f32x4 gg = g[lane + 64 * j]; const float a = v[j].x * rstd * gg.x, b = v[j].y * rstd * gg.y, c = v[j].z * rstd * gg.z, d = v[j].w * rstd * gg.w;
        v2u w; w.x = pk2(a, b); w.y = pk2(c, d); o[64 * j] = w;
        o8[64 * j] = pg8::pack_fp8x4(a * pg8::F8_USCALE, b * pg8::F8_USCALE, c * pg8::F8_USCALE, d * pg8::F8_USCALE); }
}
__device__ __forceinline__ void row_store_bf16_fp8(bf16* orow, unsigned char* o8row, int lane, const f32x4 (&v)[16]) {
    GAS v2u* o = (GAS v2u*)orow + lane; GAS unsigned* o8 = (GAS unsigned*)o8row + lane;
#pragma unroll
    for (int j = 0; j < 16; ++j) { v2u w; w.x = pk2(v[j].x, v[j].y); w.y = pk2(v[j].z, v[j].w); o[64 * j] = w;
        o8[64 * j] = pg8::pack_fp8x4(v[j].x * pg8::F8_USCALE, v[j].y * pg8::F8_USCALE, v[j].z * pg8::F8_USCALE, v[j].w * pg8::F8_USCALE); }
}
__device__ __forceinline__ void row_norm_store_bf16(bf16* orow, int lane, const f32x4 (&v)[16], float rstd, const LAS f32x4* g) {
    GAS v2u* o = (GAS v2u*)orow + lane;
#pragma unroll
    for (int j = 0; j < 16; ++j) { const f32x4 gg = g[lane + 64 * j]; v2u w; w.x = pk2(v[j].x * rstd * gg.x, v[j].y * rstd * gg.y); w.y = pk2(v[j].z * rstd * gg.z, v[j].w * rstd * gg.w); o[64 * j] = w; }
}

typedef short s_bf16x8 __attribute__((ext_vector_type(8)));
template <int NX, class Task>
__device__ __forceinline__ void skinny16(Frame& F, int K, int ntasks, const Task& T) {
    const int wid = F.wave, lane = F.lane, fr = lane & 15, fq = lane >> 4;
    LAS f32x4* part = (LAS f32x4*)(F.lds + RING_OFF);
    const int spw = K / 256;
    for (int task = blockIdx.x; task < ntasks; task += F.G) {
        const bf16* xp[NX]; const bf16* yp; int ldx, ldy; T.ptrs(task, xp, yp, ldx, ldy);
        f32x4 acc[NX];
#pragma unroll
        for (int n = 0; n < NX; ++n) acc[n] = (f32x4){0.f, 0.f, 0.f, 0.f};
        const unsigned koff = (unsigned)(wid * spw * 32 + 8 * fq);
        const unsigned ylane = (unsigned)(fr * ldy), xlane = (unsigned)(fr * ldx);
        for (int s = 0; s < spw; s += 8) {
            s_bf16x8 yv[8], xv[NX][8];
#pragma unroll
            for (int i = 0; i < 8; ++i) if (s + i < spw) { const unsigned k = koff + 32u * (unsigned)(s + i);
                yv[i] = *(const GAS s_bf16x8*)((const GAS char*)yp + (size_t)((ylane + T.ykoff(k)) * 2u));
#pragma unroll
                for (int n = 0; n < NX; ++n) xv[n][i] = *(const GAS s_bf16x8*)((const GAS char*)xp[n] + (size_t)((xlane + T.xkoff(k)) * 2u)); }
#pragma unroll
            for (int i = 0; i < 8; ++i) if (s + i < spw) {
#pragma unroll
                for (int n = 0; n < NX; ++n) acc[n] = __builtin_amdgcn_mfma_f32_16x16x32_bf16(xv[n][i], yv[i], acc[n], 0, 0, 0); }
        }
#pragma unroll
        for (int n = 0; n < NX; ++n) part[(wid * NX + n) * 64 + lane] = acc[n];
        LDS_WAIT(); __syncthreads();
        if (wid == 0) { f32x4 v[NX];
#pragma unroll
            for (int n = 0; n < NX; ++n) { v[n] = part[n * 64 + lane];
#pragma unroll
                for (int w = 1; w < NWAVES; ++w) v[n] = v[n] + part[(w * NX + n) * 64 + lane]; }
            T.store(task, fr, fq, v); }
        LDS_WAIT(); __syncthreads();
    }
}
__device__ __forceinline__ float sigm_f(float x) { return __builtin_amdgcn_rcpf(1.0f + __builtin_amdgcn_exp2f(-LOG2E * x)); }
constexpr size_t HID_PSTR = (size_t)MT * 4096;
struct SkGateUp {
    const bf16* WGU; const bf16* U; bf16* HID; const float* rs;
    __device__ __forceinline__ unsigned ykoff(unsigned k) const { return k; }
    __device__ __forceinline__ unsigned xkoff(unsigned k) const { return k; }
    __device__ __forceinline__ void ptrs(int t, const bf16* (&xp)[2], const bf16*& yp, int& ldx, int& ldy) const { xp[0] = WGU + (size_t)(256 * (t >> 3) + 16 * (t & 7)) * DM; xp[1] = xp[0] + (size_t)128 * DM; yp = U + (size_t)MR * PU; ldx = DM; ldy = PU; }
    __device__ __forceinline__ void store(int t, int fr, int fq, const f32x4 (&vv)[2]) const {
        const float r = rs[MR + fr]; const f32x4 v[2] = {vv[0] * r, vv[1] * r};
        v2u w; w.x = pk2(v[0][0] * sigm_f(v[0][0]) * v[1][0], v[0][1] * sigm_f(v[0][1]) * v[1][1]); w.y = pk2(v[0][2] * sigm_f(v[0][2]) * v[1][2], v[0][3] * sigm_f(v[0][3]) * v[1][3]);
        const int c = 16 * t + 4 * fq; *(GAS v2u*)(HID + (size_t)(c >> 12) * HID_PSTR + (size_t)(MR + fr) * 4096 + (c & 4095)) = w; }
};
struct SkDown {
    const bf16* WD; const bf16* HID; bf16* Y;
    __device__ __forceinline__ unsigned ykoff(unsigned k) const { return (k >> 12) * (unsigned)HID_PSTR + (k & 4095u); }
    __device__ __forceinline__ unsigned xkoff(unsigned k) const { return (k >> 12) * (unsigned)WD_PSTR + (k & 4095u); }
    __device__ __forceinline__ void ptrs(int t, const bf16* (&xp)[1], const bf16*& yp, int& ldx, int& ldy) const { xp[0] = WD + (size_t)(16 * t) * 4096; yp = HID + (size_t)MR * 4096; ldx = 4096; ldy = 4096; }
    __device__ __forceinline__ void store(int t, int fr, int fq, const f32x4 (&v)[1]) const {
        v2u w; w.x = pk2(v[0][0], v[0][1]); w.y = pk2(v[0][2], v[0][3]); *(GAS v2u*)(Y + (size_t)(MR + fr) * DM + 16 * t + 4 * fq) = w; }
};
struct SkWin {
    const bf16* WIN; const bf16* U; bf16* QKV; float* FLOG; const float* rs;
    __device__ __forceinline__ unsigned ykoff(unsigned k) const { return k; }
    __device__ __forceinline__ unsigned xkoff(unsigned k) const { return k; }
    __device__ __forceinline__ void ptrs(int t, const bf16* (&xp)[1], const bf16*& yp, int& ldx, int& ldy) const { ldx = DM; ldy = PU;
        if (t < 1025) { xp[0] = WIN + (size_t)20480 * DM; yp = U + (size_t)(16 * t) * PU; } else { xp[0] = WIN + (size_t)(4096 + 16 * (t - 1025)) * DM; yp = U + (size_t)MR * PU; } }
    __device__ __forceinline__ void store(int t, int fr, int fq, const f32x4 (&vv)[1]) const {
        const f32x4 v[1] = {vv[0] * rs[t < 1025 ? 16 * t + fr : MR + fr]};
        if (t < 1025) { *(GAS f32x4*)(FLOG + (size_t)(16 * t + fr) * 16 + 4 * fq) = v[0]; }
        else { v2u w; w.x = pk2(v[0][0], v[0][1]); w.y = pk2(v[0][2], v[0][3]); *(GAS v2u*)(QKV + (size_t)(MR + fr) * PQKV + 4096 + 16 * (t - 1025) + 4 * fq) = w; } }
};
constexpr int G0_OFF = 0, G1_OFF = 16384;

__device__ __forceinline__ void norm0_row(bf16* U, float* RS, int m, int lane, const f32x4 (&v)[16]) {
    const float rstd = row_rstd(v);
    row_store_bf16(U + (size_t)m * PU, lane, v);
    if (lane == 0) RS[m] = rstd;
}
__device__ __forceinline__ void phase_norm0(Frame& F, KP kp) {
    const float* x = karg<const float>(kp, A_X); const float* meta = karg<const float>(kp, A_META); bf16* U = wsp<bf16>(kp, WS_U); float* RS = wsp<float>(kp, WS_RS0);
    const int gw = F.vcu * NWAVES + F.wave, NGW = F.G * NWAVES;
    constexpr int M = MR + NMETA;
    int m = gw;
    f32x4 va[16], vb[16];
    if (m < M) row_load_f32(m < MR ? x + (size_t)m * DM : meta + (size_t)(m - MR) * DM, F.lane, va);
    while (m < M) {
        const int m1 = m + NGW;
        if (m1 < M) row_load_f32(m1 < MR ? x + (size_t)m1 * DM : meta + (size_t)(m1 - MR) * DM, F.lane, vb);
        norm0_row(U, RS, m, F.lane, va);
        if (m1 >= M) break;
        const int m2 = m1 + NGW;
        if (m2 < M) row_load_f32(m2 < MR ? x + (size_t)m2 * DM : meta + (size_t)(m2 - MR) * DM, F.lane, va);
        norm0_row(U, RS, m1, F.lane, vb);
        m = m2;
    }
    __syncthreads();
}
template <int STEP>
__device__ __forceinline__ void post_row(float* out, bf16* U, unsigned char* U8, float* RS, const LAS f32x4* g0, int m, int lane, const v2u (&y)[16], const v2u (&hp)[16]) {
    asm volatile("" ::: "memory");
    const float ry = (STEP == 2 ? 1.0f : 0.5f) * row_rstd_p(y);
    GAS f32x4* of = (GAS f32x4*)(out + (size_t)m * DM) + lane; GAS v2u* ob = (GAS v2u*)(U + (size_t)m * PU) + lane; GAS unsigned* o8 = (GAS unsigned*)(U8 + (size_t)m * DM) + lane;
    float ss = 0.f;
#pragma unroll
    for (int j = 0; j < 16; ++j) { const f32x4 gg = g0[lane + 64 * j]; const f32x4 h = unpack4(hp[j]) + unpack4(y[j]) * ry * gg;
        if (STEP == 3) of[64 * j] = h;
        else { ss += (h.x * h.x + h.y * h.y) + (h.z * h.z + h.w * h.w);
            v2u w; w.x = pk2(h.x, h.y); w.y = pk2(h.z, h.w); ob[64 * j] = w;
            if (m < MR) o8[64 * j] = pg8::pack_fp8x4(h.x * pg8::F8_USCALE, h.y * pg8::F8_USCALE, h.z * pg8::F8_USCALE, h.w * pg8::F8_USCALE); } }
    if (STEP != 3) { const float rh = 1.0f / sqrtf(wave_sum(ss) * (1.0f / DM) + RMS_EPS); if (lane == 0) RS[m] = rh; }
}
template <int STEP>
__device__ __forceinline__ void phase_post(Frame& F, KP kp) {
    float* out = karg<float>(kp, A_OUT); bf16* U = wsp<bf16>(kp, WS_U); const bf16* Y = wsp<bf16>(kp, WS_Y); unsigned char* U8 = wsp<unsigned char>(kp, WS_U8);
    float* RS = wsp<float>(kp, STEP == 1 ? WS_RS1 : WS_RS2);
    gain_to_lds(F, karg<const float>(kp, STEP == 1 ? A_G_FF1_POST : STEP == 2 ? A_G_MIX_POST : A_G_FF2_POST), G0_OFF); LDS_WAIT(); __syncthreads();
    const LAS f32x4* g0 = (const LAS f32x4*)(F.lds + G0_OFF);
    const int gw = F.vcu * NWAVES + F.wave, NGW = F.G * NWAVES;
    constexpr int M = (STEP == 1 ? MR + NMETA : MR);
    int m = gw;
    v2u ya[16], ha[16], yb[16], hb[16];
    if (m < M) { row_load_bf16p(Y + (size_t)m * DM, F.lane, ya); row_load_bf16p(U + (size_t)m * PU, F.lane, ha); }
    while (m < M) {
        const int m1 = m + NGW;
        if (m1 < M) { row_load_bf16p(Y + (size_t)m1 * DM, F.lane, yb); row_load_bf16p(U + (size_t)m1 * PU, F.lane, hb); }
        post_row<STEP>(out, U, U8, RS, g0, m, F.lane, ya, ha);
        if (m1 >= M) break;
        const int m2 = m1 + NGW;
        if (m2 < M) { row_load_bf16p(Y + (size_t)m2 * DM, F.lane, ya); row_load_bf16p(U + (size_t)m2 * PU, F.lane, ha); }
        post_row<STEP>(out, U, U8, RS, g0, m1, F.lane, yb, hb);
        m = m2;
    }
    __syncthreads();
}
__device__ __forceinline__ void phase_scan(Frame& F, KP kp) {
    const float* b_forget = karg<const float>(kp, A_B_FORGET); const float* FLOG = wsp<float>(kp, WS_FLOG); float* KB = wsp<float>(kp, WS_KB); int* JLO = wsp<int>(kp, WS_JLO);
    const int gw = F.vcu * NWAVES + F.wave, NGW = F.G * NWAVES;
    for (int task = gw; task < NB * 16; task += NGW) {
        const int b = task >> 4, h = task & 15; const float bf = b_forget[h];
        float v[65];
        const int dbase = 65 * F.lane - 64, sel = MR + 16 - b * SEQ;
#pragma unroll
        for (int k = 0; k < 65; ++k) { const int d = dbase + k; const int row = d + b * SEQ + ((d >> 31) & sel);
            v[k] = FLOG[(size_t)(unsigned)row * 16 + h]; }
        float run = 0.f;
#pragma unroll
        for (int k = 0; k < 65; ++k) { const int e = 65 * F.lane + k; const float z = v[k] + bf;
            const float ez = __builtin_amdgcn_exp2f(-LOG2E * fabsf(z));
            const float ls = fminf(z, 0.f) - 0.6931471805599453f * __builtin_amdgcn_logf(1.0f + ez);
            const unsigned keep = ~(unsigned)((e - 48) >> 31);
            run += __uint_as_float(__float_as_uint(ls) & keep); v[k] = run; }
        float incl = run;
#pragma unroll
        for (int d = 1; d < 64; d <<= 1) { const float o = __shfl_up(incl, d); if (F.lane >= d) incl += o; }
        const float off = incl - run;
        float* kb = KB + (size_t)task * EKV + 65 * F.lane;
#pragma unroll
        for (int k = 0; k < 65; ++k) kb[k] = -ISCALE * (off + v[k]);
        asm volatile("s_waitcnt vmcnt(0)" ::: "memory");
        const float* kbrow = KB + (size_t)task * EKV;
        const float tend = __hip_atomic_load(kbrow + 64 * F.lane + 63, __ATOMIC_RELAXED, __HIP_MEMORY_SCOPE_AGENT);
        int* jlo = JLO + task * 16;
        const float q0l = __hip_atomic_load(kbrow + 64 + 256 * (F.lane & 15), __ATOMIC_RELAXED, __HIP_MEMORY_SCOPE_AGENT);
#pragma unroll
        for (int qb = 0; qb < 16; ++qb) {
            const float q0 = __builtin_amdgcn_readlane(q0l, qb);
            const unsigned long long keepm = __ballot(q0 - tend < SKIP_TH * ISCALE);
            int j = keepm ? __builtin_ctzll(keepm) : 0; j = (j > 4 * qb ? 4 * qb : j) & ~1;
            if (F.lane == 0) jlo[qb] = j;
        }
    }
}
template <bool PROBE_OUT> __device__ __forceinline__ void phase_diffnorm(Frame& F, KP kp) {
    const float* lq1 = karg<const float>(kp, A_LQ1); const float* lk1 = karg<const float>(kp, A_LK1); const float* lq2 = karg<const float>(kp, A_LQ2); const float* lk2 = karg<const float>(kp, A_LK2);
    const float* g_subln = karg<const float>(kp, A_G_SUBLN); bf16* AO = wsp<bf16>(kp, WS_AO);
    const int gw = F.vcu * NWAVES + F.wave, NGW = F.G * NWAVES;
    const float s1 = wave_sum(lq1[F.lane] * lk1[F.lane] + lq1[F.lane + 64] * lk1[F.lane + 64]);
    const float s2 = wave_sum(lq2[F.lane] * lk2[F.lane] + lq2[F.lane + 64] * lk2[F.lane + 64]);
    const float lam = expf(s1) - expf(s2) + LAMBDA_INIT;
    const int h = F.lane >> 3, sub = F.lane & 7;
    float gsub[32];
#pragma unroll
    for (int i = 0; i < 32; ++i) gsub[i] = g_subln[sub * 32 + i] * (1.0f - LAMBDA_INIT);
    for (int m = gw; m < MR; m += NGW) {
        const GAS v4u* p1 = (const GAS v4u*)(AO + (size_t)m * PAO + 2048 + h * 512 + sub * 32);
        const GAS v4u* p2 = (const GAS v4u*)(AO + (size_t)m * PAO + 2048 + h * 512 + 256 + sub * 32);
        float d[32]; float ss = 0.f;
#pragma unroll
        for (int q = 0; q < 4; ++q) { const v4u a = p1[q], b = p2[q];
            const unsigned aw[4] = {a.x, a.y, a.z, a.w}, bw[4] = {b.x, b.y, b.z, b.w};
#pragma unroll
            for (int i = 0; i < 4; ++i) { const float d0 = bflo(aw[i]) - lam * bflo(bw[i]), d1 = bfhi(aw[i]) - lam * bfhi(bw[i]); d[8 * q + 2 * i] = d0; d[8 * q + 2 * i + 1] = d1; ss += d0 * d0 + d1 * d1; } }
        ss += __shfl_xor(ss, 1); ss += __shfl_xor(ss, 2); ss += __shfl_xor(ss, 4);
        const float rstd = 1.0f / sqrtf(ss * (1.0f / 256.0f) + RMS_EPS);
        asm volatile("s_waitcnt vmcnt(0)" ::: "memory");
        GAS v4u* o = PROBE_OUT ? (GAS v4u*)(wsp<bf16>(kp, WS_MG) + (size_t)m * 4096 + h * 256 + sub * 32) : (GAS v4u*)(AO + (size_t)m * PAO + 2048 + h * 256 + sub * 32);
#pragma unroll
        for (int q = 0; q < 4; ++q) { v4u w;
            w.x = pk2(d[8 * q + 0] * rstd * gsub[8 * q + 0], d[8 * q + 1] * rstd * gsub[8 * q + 1]); w.y = pk2(d[8 * q + 2] * rstd * gsub[8 * q + 2], d[8 * q + 3] * rstd * gsub[8 * q + 3]);
            w.z = pk2(d[8 * q + 4] * rstd * gsub[8 * q + 4], d[8 * q + 5] * rstd * gsub[8 * q + 5]); w.w = pk2(d[8 * q + 6] * rstd * gsub[8 * q + 6], d[8 * q + 7] * rstd * gsub[8 * q + 7]);
            o[q] = w; }
    }
}
constexpr int est_nt(int vh, int qb) {
    const int ntabs = 4 * qb + 5;
    if (vh < 16) return ntabs < 17 ? ntabs : 17;
    const int h = (vh - 16) >> 2, W = 44 << (h + 1);
    int jlo = 64 + 256 * qb - W; jlo = jlo < 0 ? 0 : jlo / 64; jlo &= ~1;
    return ntabs - jlo;
}
struct ItemTab { unsigned short v[3072]; };
constexpr ItemTab make_items() {
    ItemTab t{}; int n = 0;
    for (int key = 65; key >= 1; --key)
        for (int vh = 0; vh < 48; ++vh) for (int qb = 0; qb < 16; ++qb) if (est_nt(vh, qb) == key)
            for (int b = 0; b < 4; ++b) t.v[n++] = (unsigned short)((b << 10) | (vh << 4) | qb);
    return t;
}
__device__ const ItemTab ITEMS = make_items();
template <int PROBE> __device__ __forceinline__ att::BlockRef attn_ref(const bf16* QKV, bf16* AO, const float* KB, const int* JLO, int idx) {
    const unsigned it = ITEMS.v[idx];
    const int b = it >> 10, vh = (it >> 4) & 63, qb = it & 15;
    att::BlockRef r; r.rowb = b * SEQ; r.P0 = 64 + 256 * qb; r.probe = PROBE == 2;
    const bf16* rowq = QKV + (size_t)(b * SEQ + 256 * qb) * PQKV; bf16* rowo = AO + (size_t)(b * SEQ + 256 * qb) * PAO;
    if (vh < 16) { const int h = vh; r.Q = rowq + h * 128; r.K = QKV + 4096 + h * 128; r.V = QKV + 6144 + h * 128; r.O = rowo + h * 128;
        r.kb = KB + (size_t)(b * 16 + h) * EKV; r.sl2 = 0.f; r.jlo = JLO[(b * 16 + h) * 16 + qb]; }
    else { const int dv = vh - 16, h = dv >> 2, c = (dv >> 1) & 1, jv = dv & 1;
        r.Q = rowq + 2048 + h * 256 + c * 128; r.K = QKV + 8192 + h * 256 + c * 128; r.V = QKV + 10240 + h * 256 + jv * 128;
        r.O = rowo + 2048 + h * 512 + c * 256 + jv * 128;
        r.kb = nullptr; r.sl2 = ISCALE * __builtin_amdgcn_exp2f(-(float)(h + 1));
        const int W = (int)SKIP_TH << (h + 1);
        int j = r.P0 - W; j = j < 0 ? 0 : j >> 6; r.jlo = j & ~1; }
    return r;
}
template <int PROBE> __device__ __forceinline__ void phase_attn(Frame& F, KP kp, char* lds) {
    constexpr int TOTAL = 3072;
    const bf16* QKV = wsp<bf16>(kp, WS_BIG); bf16* AO = wsp<bf16>(kp, WS_AO); const float* KB = wsp<float>(kp, WS_KB); const int* JLO = wsp<int>(kp, WS_JLO);
    unsigned* qhead = wsp<unsigned>(kp, WS_CTL) + CW_Q + (PROBE ? 64 : 0);
    volatile int* qs = (volatile int*)(lds + att::OFF_Q);
    if (F.tid == 0) { qs[0] = (int)__hip_atomic_fetch_add(qhead, 1u, __ATOMIC_RELAXED, __HIP_MEMORY_SCOPE_AGENT); qs[1] = (int)__hip_atomic_fetch_add(qhead, 1u, __ATOMIC_RELAXED, __HIP_MEMORY_SCOPE_AGENT); }
    __syncthreads();
    int icur = __builtin_amdgcn_readfirstlane(qs[0]), inxt = __builtin_amdgcn_readfirstlane(qs[1]);
    if (icur >= TOTAL) return;
    att::BlockRef cur = attn_ref<PROBE>(QKV, AO, KB, JLO, icur);
    att::Seam S;
    att::attn_prime(F.tid, cur, lds, S);
    for (;;) {
        unsigned claim = 0u; if (F.tid == 0) claim = __hip_atomic_fetch_add(qhead, 1u, __ATOMIC_RELAXED, __HIP_MEMORY_SCOPE_AGENT);
        const bool last = inxt >= TOTAL;
        const att::BlockRef nxt = last ? cur : attn_ref<PROBE>(QKV, AO, KB, JLO, inxt);
        att::attn_block(F.tid, cur, nxt, lds, S);
        if (last) break;
        if (F.tid == 0) qs[0] = (int)claim;
        __syncthreads();
        cur = nxt; inxt = __builtin_amdgcn_readfirstlane(qs[0]);
    }
}

#ifndef PROBE_ROWS
#define PROBE_ROWS 4096
#endif
#ifndef PROBE_DUP
#define PROBE_DUP 0
#endif
#ifndef PH
#define PH 0xFFFFF
#endif
#ifndef DUP
#define DUP 0
#endif
#ifndef DUP_ROWS
#define DUP_ROWS 4096
#endif
#ifndef ATT_PROBE
#define ATT_PROBE 1
#endif
#ifndef WGM_DOWN
#define WGM_DOWN 2
#endif
#ifndef ALIGN_SWIGLU
#define ALIGN_SWIGLU 1
#endif
#ifndef FFN2_F8
#define FFN2_F8 1
#endif
#ifndef TR_BIG
#define TR_BIG 0
#endif
#ifndef WGM_BIG
#define WGM_BIG 8
#endif
struct Args { const float* in[24]; float* out; unsigned char* ws; };
__global__ void __launch_bounds__(NWAVES * 64, 2) mega_fwd(Args args) {
    extern __shared__ __attribute__((aligned(16))) unsigned char lds[];
    Frame F;
    F.lds = (LAS unsigned char*)lds;
    F.wave = __builtin_amdgcn_readfirstlane((int)threadIdx.x >> 6);
    F.G = gridDim.x; { const int bx = blockIdx.x; F.vcu = (F.G % 8 == 0) ? (bx % 8) * (F.G / 8) + bx / 8 : bx; }
    frame_refresh(F);
    for (int u = F.tid; u < (LDS_BYTES - LDSCTL_OFF) / 4; u += NWAVES * 64) ((LAS unsigned*)(F.lds + LDSCTL_OFF))[u] = 0u;
    __syncthreads();
    (void)xcd_barrier_post(wsp<unsigned>(kargs(), WS_CTL) + CW_BAR, (volatile LAS unsigned*)(F.lds + MISC_OFF) + 8, F.tid);
    if (args.ws == nullptr) return;
#define GRID_BAR() do { frame_refresh(F); XcdBarrier b_; b_.bar = wsp<unsigned>(kargs(), WS_CTL) + CW_BAR; b_.x = xb_xcc_id(); b_.st = (volatile LAS unsigned*)(F.lds + MISC_OFF) + 8; xcd_barrier(b_, F.tid); } while (0)
#define GEMM_PHASE(EPI) do { frame_refresh(F); pg8::gemm_phase<EPI, pg8::StaticOrder, true>(F.lds + RING_OFF, F.tid, g, S, E); } while (0)
#define GEMM_PHASE_SW(EPI) do { frame_refresh(F); pg8::gemm_phase<EPI, pg8::StaticOrder, (ALIGN_SWIGLU != 0)>(F.lds + RING_OFF, F.tid, g, S, E); } while (0)

    { KP kp = kargs(); frame_refresh(F);
      convert_ffn<3>(F, kp, A_W_GATE1, A_W_UP1, A_W_DOWN1, A_G_FF1_PRE);
      __syncthreads();
      phase_norm0(F, kp); }
#if PROBE_DUP & 1
    GRID_BAR();
    { KP kp = kargs(); frame_refresh(F);
      convert_ffn<3>(F, kp, A_W_GATE1, A_W_UP1, A_W_DOWN1, A_G_FF1_PRE);
      __syncthreads();
      phase_norm0(F, kp); }
#endif
    GRID_BAR();
    { KP kp = kargs(); frame_refresh(F); SkGateUp T{wsp<bf16>(kp, WS_WGU), wsp<bf16>(kp, WS_U), wsp<bf16>(kp, WS_BIG), wsp<float>(kp, WS_RS0)}; skinny16<2>(F, DM, DFF / 16, T); }
    { KP kp = kargs(); pg8::Gemm g{wsp<bf16>(kp, WS_U), wsp<bf16>(kp, WS_WGU), MR, NGU, DM, PU, DM}; pg8::StaticOrder S; S.init(MR, NGU, F.G, (int)blockIdx.x, WGM_BIG, TR_BIG);
      pg8::EpiSwiGLU E{wsp<bf16>(kp, WS_BIG), HID_PSTR, wsp<float>(kp, WS_RS0)}; GEMM_PHASE_SW(pg8::EpiSwiGLU); }
    { KP kp = kargs(); frame_refresh(F); convert_mixer_queue(F, kp); __syncthreads(); }
    GRID_BAR();
    { KP kp = kargs(); frame_refresh(F); SkDown T{wsp<bf16>(kp, WS_WD), wsp<bf16>(kp, WS_BIG), wsp<bf16>(kp, WS_Y)}; skinny16<1>(F, DFF, DM / 16, T); }
    { KP kp = kargs(); pg8::Gemm g{wsp<bf16>(kp, WS_BIG), wsp<bf16>(kp, WS_WD), MR, DM, DFF, 4096, 4096, 6, 6, HID_PSTR * 2, WD_PSTR * 2}; pg8::StaticOrder S; S.init(MR, DM, F.G, (int)blockIdx.x, WGM_DOWN);
      pg8::EpiPlain E{wsp<bf16>(kp, WS_Y), DM}; GEMM_PHASE(pg8::EpiPlain); }
    GRID_BAR();
    { KP kp = kargs(); frame_refresh(F); phase_post<1>(F, kp); }
    GRID_BAR();
    { KP kp = kargs(); frame_refresh(F); SkWin T{wsp<bf16>(kp, WS_WIN), wsp<bf16>(kp, WS_U), wsp<bf16>(kp, WS_BIG), wsp<float>(kp, WS_FLOG), wsp<float>(kp, WS_RS1)}; skinny16<1>(F, DM, 1025 + 512, T); }
    { KP kp = kargs(); pg8::Gemm g{wsp<bf16>(kp, WS_U), wsp<bf16>(kp, WS_WIN), MR, 12288, DM, PU, DM}; pg8::StaticOrder S; S.init(MR, 12288, F.G, (int)blockIdx.x, WGM_BIG, TR_BIG);
      pg8::EpiWin E{wsp<bf16>(kp, WS_BIG), wsp<bf16>(kp, WS_GATES), wsp<float>(kp, WS_RS1)}; GEMM_PHASE(pg8::EpiWin); }
    { KP kp = kargs(); pg8::Gemm g{wsp<bf16>(kp, WS_U8), wsp<bf16>(kp, WS_WIN8), MR, 8192, DM / 2, 2048, 2048}; pg8::StaticOrder S; S.init(MR, 8192, F.G, (int)blockIdx.x, WGM_BIG, TR_BIG);
      pg8::EpiPlainRS E{wsp<bf16>(kp, WS_GATES), 8192, 1.0f / (pg8::F8_USCALE * pg8::F8_WINSCALE), wsp<float>(kp, WS_RS1)};
      frame_refresh(F); pg8::gemm_phase<pg8::EpiPlainRS, pg8::StaticOrder, true, pg8::MidNone, true>(F.lds + RING_OFF, F.tid, g, S, E); }
    GRID_BAR();
    { KP kp = kargs(); frame_refresh(F); phase_scan(F, kp); }
    GRID_BAR();
#if PROBE_DUP & 4
    { KP kp = kargs(); frame_refresh(F); phase_attn<1>(F, kp, (char*)lds + RING_OFF); }
    GRID_BAR();
#endif
    { KP kp = kargs(); frame_refresh(F); phase_attn<0>(F, kp, (char*)lds + RING_OFF); }
    GRID_BAR();
    { KP kp = kargs(); frame_refresh(F); phase_diffnorm<false>(F, kp); }
    GRID_BAR();
    { KP kp = kargs(); pg8::Gemm g{wsp<bf16>(kp, WS_AO), wsp<bf16>(kp, WS_WO), MR, DM, 4096, PAO, 4096}; pg8::StaticOrder S; S.init(MR, DM, F.G, (int)blockIdx.x);
      pg8::EpiGateOut E{wsp<bf16>(kp, WS_MG), wsp<bf16>(kp, WS_GATES)}; pg8::MidGate MH{32, wsp<bf16>(kp, WS_GATES)};
      frame_refresh(F); pg8::gemm_phase<pg8::EpiGateOut, pg8::StaticOrder, true, pg8::MidGate>(F.lds + RING_OFF, F.tid, g, S, E, MH); }
    GRID_BAR();
    { KP kp = kargs(); pg8::Gemm g{wsp<bf16>(kp, WS_MG), wsp<bf16>(kp, WS_WOUT), MR, DM, DM, DM, DM}; pg8::StaticOrder S; S.init(MR, DM, F.G, (int)blockIdx.x);
      pg8::EpiPlain E{wsp<bf16>(kp, WS_Y), DM}; GEMM_PHASE(pg8::EpiPlain); }
#if PROBE_DUP & 8
    GRID_BAR();
    { KP kp = kargs(); pg8::Gemm g{wsp<bf16>(kp, WS_MG), wsp<bf16>(kp, WS_WOUT), PROBE_ROWS, DM, DM, DM, DM}; pg8::StaticOrder S; S.init(PROBE_ROWS, DM, F.G, (int)blockIdx.x);
      pg8::EpiPlain E{wsp<bf16>(kp, WS_Y), DM}; GEMM_PHASE(pg8::EpiPlain); }
#endif
    { KP kp = kargs(); frame_refresh(F); convert_ffn<5>(F, kp, A_W_GATE2, A_W_UP2, A_W_DOWN2, A_G_FF2_PRE); __syncthreads(); }
    GRID_BAR();
    { KP kp = kargs(); frame_refresh(F); phase_post<2>(F, kp); }
    GRID_BAR();
    { KP kp = kargs(); pg8::Gemm g{wsp<bf16>(kp, WS_U), wsp<bf16>(kp, WS_WGU), MR, GU8_ROW0, DM, PU, DM}; pg8::StaticOrder S; S.init(MR, GU8_ROW0, F.G, (int)blockIdx.x, WGM_BIG, TR_BIG);
      pg8::EpiSwiGLU8 E{wsp<unsigned char>(kp, WS_BIG), (size_t)MT * 4096, wsp<float>(kp, WS_RS2)}; GEMM_PHASE_SW(pg8::EpiSwiGLU8); }
    { KP kp = kargs(); pg8::Gemm g{wsp<bf16>(kp, WS_U8), wsp<bf16>(kp, WS_WGU8), MR, GU8_TILES * 256, DM / 2, 2048, 2048}; pg8::StaticOrder S; S.init(MR, GU8_TILES * 256, F.G, (int)blockIdx.x, WGM_BIG, TR_BIG);
      pg8::EpiSwiGLU8 E{wsp<unsigned char>(kp, WS_BIG), (size_t)MT * 4096, wsp<float>(kp, WS_RS2), 86 - GU8_TILES, 1.0f / (pg8::F8_USCALE * pg8::F8_WINSCALE)};
      frame_refresh(F); pg8::gemm_phase<pg8::EpiSwiGLU8, pg8::StaticOrder, true, pg8::MidNone, true>(F.lds + RING_OFF, F.tid, g, S, E); }
    { KP kp = kargs(); frame_refresh(F); convert_down_queue8(F, kp, A_W_DOWN2, CW_CQ2); __syncthreads(); }
    GRID_BAR();
    { KP kp = kargs(); pg8::Gemm g{wsp<bf16>(kp, WS_BIG), wsp<bf16>(kp, WS_WD), MR, DM, DFF / 2, 2048, 2048, 5, 5, (size_t)MT * 4096, WD_PSTR}; pg8::StaticOrder S; S.init(MR, DM, F.G, (int)blockIdx.x, WGM_DOWN);
      pg8::EpiPlain E{wsp<bf16>(kp, WS_Y), DM, 1.0f / (pg8::F8_HSCALE * pg8::F8_WSCALE)};
      frame_refresh(F); pg8::gemm_phase<pg8::EpiPlain, pg8::StaticOrder, true, pg8::MidNone, true>(F.lds + RING_OFF, F.tid, g, S, E); }
    GRID_BAR();
    { KP kp = kargs(); frame_refresh(F); phase_post<3>(F, kp); }
#if PROBE_DUP & 2
    GRID_BAR();
    { KP kp = kargs(); frame_refresh(F); phase_post<3>(F, kp); }
#endif
#undef GRID_BAR
#undef GEMM_PHASE
#undef GEMM_PHASE_SW
}

extern "C" void kernel_launch(void* const* d_in, const int* in_sizes, int n_in, void* d_out, int out_size, void* d_ws, size_t ws_size, hipStream_t stream) {
    static int grid = 0;
    if (grid == 0) {
        if (n_in != 24 || in_sizes[0] != MR * DM || out_size != MR * DM || ws_size < WS_END) { fprintf(stderr, "kernel_launch: shape/workspace mismatch (n_in %d, in0 %d, out %d, ws %zu, need %zu)\n", n_in, n_in > 0 ? in_sizes[0] : -1, out_size, ws_size, (size_t)WS_END); grid = -1; return; }
        int dev = 0, cus = 0;
        if (hipGetDevice(&dev) != hipSuccess || hipDeviceGetAttribute(&cus, hipDeviceAttributeMultiprocessorCount, dev) != hipSuccess) { grid = -1; return; }
        if (hipFuncSetAttribute((const void*)mega_fwd, hipFuncAttributeMaxDynamicSharedMemorySize, LDS_BYTES) != hipSuccess) { fprintf(stderr, "kernel_launch: hipFuncSetAttribute failed\n"); grid = -1; return; }
        int per_cu = 0;
        if (hipOccupancyMaxActiveBlocksPerMultiprocessor(&per_cu, (const void*)mega_fwd, NWAVES * 64, LDS_BYTES) != hipSuccess || per_cu < 1) { fprintf(stderr, "kernel_launch: occupancy query reports %d\n", per_cu); }
        (void)hipGetLastError();
        grid = cus;
    }
    if (grid < 0) return;
    if (hipMemsetAsync((char*)d_ws + WS_CTL, 0, CTL_ZERO_BYTES, stream) != hipSuccess) return;
    Args a{};
    for (int i = 0; i < 24; ++i) a.in[i] = (const float*)d_in[i];
    a.out = (float*)d_out; a.ws = (unsigned char*)d_ws;
    hipLaunchKernelGGL(mega_fwd, dim3(grid), dim3(NWAVES * 64), LDS_BYTES, stream, a);
}
```

```cpp
#include <hip/hip_runtime.h>
#include <cstdio>
#include <cstdint>
#ifndef EPI_NT
#define EPI_NT 1
#endif
#ifndef PG8_PRIO
#define PG8_PRIO 3
#endif
namespace pg8 {
#define PG8_LAS __attribute__((address_space(3)))
typedef unsigned short bf16_t;
typedef short bf16x8 __attribute__((ext_vector_type(8)));
typedef float f32x4 __attribute__((ext_vector_type(4)));
typedef unsigned u32x4 __attribute__((ext_vector_type(4)));
constexpr int BM = 256, BK = 64, HALF = 128, HTB = HALF * BK * 2  , STAGE_BYTES = 8 * HTB, NXCD = 8, WGM = 8;

__host__ __device__ __forceinline__ int lds_byte(int r, int c) { const int st = (r >> 4) * 2 + (c >> 5), rr = r & 15, cc = c & 31, ob = rr * 64 + cc * 2; return st * 1024 + (ob ^ (((ob >> 9) & 1) << 5)); }
__host__ __device__ __forceinline__ void stage_rc(int b, int& R, int& C) { const int st = b / 1024, sb = b % 1024, swz = sb ^ (((sb >> 9) & 1) << 5); R = (st >> 1) * 16 + swz / 64; C = (st & 1) * 32 + (swz % 64) / 2; }
__host__ __device__ __forceinline__ int perm32(int rho) { const int n = rho >> 4, i = rho & 15; return 8 * (i >> 2) + 4 * n + (i & 3); }

struct Unit { int pm, pn; };
struct Gemm { const bf16_t* A; const bf16_t* Bt; int M, N, K, lda, ldb; int pshA = 30, pshB = 30; size_t pstrA = 0, pstrB = 0; };

struct StaticOrder {
    int nM, nN, nwg, G, c, wgm, tr;
    __host__ __device__ void init(int M, int N, int G_, int c_, int wgm_ = WGM, int tr_ = 0) { nM = M / BM; nN = N / BM; nwg = nM * nN; G = G_; c = c_; wgm = wgm_; tr = tr_; }
    __host__ __device__ bool next(int i, Unit& u) const {
        const long L = (long)i * G + c; if (L >= nwg) return false;
        int wgid = (int)L; { const int q = nwg / NXCD, r = nwg % NXCD, xcd = wgid % NXCD, off = wgid / NXCD; wgid = (xcd < r ? xcd * (q + 1) : r * (q + 1) + (xcd - r) * q) + off; }
        const int nA = tr ? nN : nM, nB = tr ? nM : nN;
        const int nig = wgm * nB, gid = wgid / nig, fm = gid * wgm, gsz = (nA - fm) < wgm ? (nA - fm) : wgm;
        const int a = fm + ((wgid % nig) % gsz), b = (wgid % nig) / gsz;
        u.pm = tr ? b : a; u.pn = tr ? a : b; return true;
    }
    __device__ __forceinline__ void a_ready(const Unit&) const {}
    __device__ __forceinline__ void done(const Unit&) const {}
};

__device__ __forceinline__ unsigned cvt_pk_bf16(float lo, float hi) { unsigned r; asm volatile("v_cvt_pk_bf16_f32 %0, %1, %2" : "=v"(r) : "v"(lo), "v"(hi)); return r; }
__device__ __forceinline__ float sigm(float x) { return __builtin_amdgcn_rcpf(1.0f + __builtin_amdgcn_exp2f(-1.4426950408889634f * x)); }
__device__ __forceinline__ float bf_lo(unsigned w) { return __uint_as_float(w << 16); }
__device__ __forceinline__ float bf_hi(unsigned w) { return __uint_as_float(w & 0xffff0000u); }

struct EpiPlain {
    static constexpr bool PERM = true, AFTER_DRAIN = false, ROWSCALE = false;
    bf16_t* O; int ldc; float scale = 1.0f; int nt = 0;
    __device__ __forceinline__ void operator()(const f32x4 (&acc)[2][2][4][2], const Unit& u, int wr, int wc, int fr, int fq, const PG8_LAS float*) const {
        const int row0 = u.pm * BM + wr * 64 + fr; const int col0 = u.pn * BM + wc * 32 + 8 * fq;
#pragma unroll
        for (int ai = 0; ai < 2; ++ai)
#pragma unroll
            for (int m = 0; m < 4; ++m) { bf16_t* rowp = O + (size_t)(row0 + ai * HALF + m * 16) * ldc + col0;
#pragma unroll
                for (int bj = 0; bj < 2; ++bj) { const f32x4 v0 = acc[ai][bj][m][0] * scale, v1 = acc[ai][bj][m][1] * scale;
                    u32x4 w; w.x = cvt_pk_bf16(v0[0], v0[1]); w.y = cvt_pk_bf16(v0[2], v0[3]); w.z = cvt_pk_bf16(v1[0], v1[1]); w.w = cvt_pk_bf16(v1[2], v1[3]);
                    if (nt) __builtin_nontemporal_store(w, (u32x4*)(rowp + bj * HALF)); else *(u32x4*)(rowp + bj * HALF) = w; } }
    }
};
struct EpiPlainRS {
    static constexpr bool PERM = true, AFTER_DRAIN = false, ROWSCALE = true;
    bf16_t* O; int ldc; float scale; const float* rs;
    __device__ __forceinline__ void operator()(const f32x4 (&acc)[2][2][4][2], const Unit& u, int wr, int wc, int fr, int fq, const PG8_LAS float* rsl) const {
        const int row0 = u.pm * BM + wr * 64 + fr; const int col0 = u.pn * BM + wc * 32 + 8 * fq;
#pragma unroll
        for (int ai = 0; ai < 2; ++ai)
#pragma unroll
            for (int m = 0; m < 4; ++m) { bf16_t* rowp = O + (size_t)(row0 + ai * HALF + m * 16) * ldc + col0; const float r = rsl[wr * 64 + ai * HALF + m * 16 + fr] * scale;
#pragma unroll
                for (int bj = 0; bj < 2; ++bj) { const f32x4 v0 = acc[ai][bj][m][0] * r, v1 = acc[ai][bj][m][1] * r;
                    u32x4 w; w.x = cvt_pk_bf16(v0[0], v0[1]); w.y = cvt_pk_bf16(v0[2], v0[3]); w.z = cvt_pk_bf16(v1[0], v1[1]); w.w = cvt_pk_bf16(v1[2], v1[3]);
                    *(u32x4*)(rowp + bj * HALF) = w; } }
    }
};
struct EpiSwiGLU {
    static constexpr bool PERM = true, AFTER_DRAIN = false, ROWSCALE = true;
    bf16_t* O; size_t pstr; const float* rs;
    __device__ __forceinline__ void operator()(const f32x4 (&acc)[2][2][4][2], const Unit& u, int wr, int wc, int fr, int fq, const PG8_LAS float* rsl) const {
        const int row0 = u.pm * BM + wr * 64 + fr; const int col0 = ((u.pn * HALF) & 4095) + wc * 32 + 8 * fq; bf16_t* Op = O + (size_t)(u.pn >> 5) * pstr;
#pragma unroll
        for (int ai = 0; ai < 2; ++ai)
#pragma unroll
            for (int m = 0; m < 4; ++m) { bf16_t* rowp = Op + (size_t)(row0 + ai * HALF + m * 16) * 4096 + col0; const float r = rsl[wr * 64 + ai * HALF + m * 16 + fr];
                const f32x4 g0 = acc[ai][0][m][0] * r, g1 = acc[ai][0][m][1] * r, u0 = acc[ai][1][m][0] * r, u1 = acc[ai][1][m][1] * r;
                f32x4 h0, h1;
#pragma unroll
                for (int i = 0; i < 4; ++i) { h0[i] = g0[i] * sigm(g0[i]) * u0[i]; h1[i] = g1[i] * sigm(g1[i]) * u1[i]; }
                u32x4 w; w.x = cvt_pk_bf16(h0[0], h0[1]); w.y = cvt_pk_bf16(h0[2], h0[3]); w.z = cvt_pk_bf16(h1[0], h1[1]); w.w = cvt_pk_bf16(h1[2], h1[3]);
                if (EPI_NT) __builtin_nontemporal_store(w, (u32x4*)rowp); else *(u32x4*)rowp = w; }
    }
};
constexpr float F8_HSCALE = 8.0f, F8_WSCALE = 1024.0f, F8_MAX = 416.0f, F8_USCALE = 16.0f, F8_WINSCALE = 512.0f;
__device__ __forceinline__ unsigned pack_fp8x4(float a, float b, float c, float d) {
    a = __builtin_fminf(__builtin_fmaxf(a, -F8_MAX), F8_MAX); b = __builtin_fminf(__builtin_fmaxf(b, -F8_MAX), F8_MAX); c = __builtin_fminf(__builtin_fmaxf(c, -F8_MAX), F8_MAX); d = __builtin_fminf(__builtin_fmaxf(d, -F8_MAX), F8_MAX);
    int w = 0; w = __builtin_amdgcn_cvt_pk_fp8_f32(a, b, w, false); w = __builtin_amdgcn_cvt_pk_fp8_f32(c, d, w, true); return (unsigned)w; }
struct EpiSwiGLU8 {
    static constexpr bool PERM = true, AFTER_DRAIN = false, ROWSCALE = true;
    unsigned char* O; size_t pstr; const float* rs; int pn_off = 0; float ascale = 1.0f;
    __device__ __forceinline__ void operator()(const f32x4 (&acc)[2][2][4][2], const Unit& u, int wr, int wc, int fr, int fq, const PG8_LAS float* rsl) const {
        const int pn = u.pn + pn_off;
        const int row0 = u.pm * BM + wr * 64 + fr; const int col0 = ((pn * HALF) & 4095) + wc * 32 + 8 * fq; unsigned char* Op = O + (size_t)(pn >> 5) * pstr;
#pragma unroll
        for (int ai = 0; ai < 2; ++ai)
#pragma unroll
            for (int m = 0; m < 4; ++m) { unsigned char* rowp = Op + (size_t)(row0 + ai * HALF + m * 16) * 4096 + col0; const float r = rsl[wr * 64 + ai * HALF + m * 16 + fr] * ascale;
                const f32x4 g0 = acc[ai][0][m][0] * r, g1 = acc[ai][0][m][1] * r, u0 = acc[ai][1][m][0] * r, u1 = acc[ai][1][m][1] * r;
                f32x4 h0, h1;
#pragma unroll
                for (int i = 0; i < 4; ++i) { h0[i] = g0[i] * sigm(g0[i]) * u0[i] * F8_HSCALE; h1[i] = g1[i] * sigm(g1[i]) * u1[i] * F8_HSCALE; }
                typedef unsigned u32x2 __attribute__((ext_vector_type(2)));
                u32x2 w; w.x = pack_fp8x4(h0[0], h0[1], h0[2], h0[3]); w.y = pack_fp8x4(h1[0], h1[1], h1[2], h1[3]);
                *(u32x2*)rowp = w; }
    }
};
struct EpiWin {
    static constexpr bool PERM = true, AFTER_DRAIN = false, ROWSCALE = true;
    bf16_t* QKV; bf16_t* GATES; const float* rs;
    __device__ __forceinline__ void operator()(const f32x4 (&acc)[2][2][4][2], const Unit& u, int wr, int wc, int fr, int fq, const PG8_LAS float* rsl) const {
        const int row0 = u.pm * BM + wr * 64 + fr;
        bf16_t* base; int ldc, colt;
        if (u.pn < 48) { base = QKV; ldc = 12288; colt = u.pn * BM; } else { base = GATES; ldc = 8192; colt = (u.pn - 48) * BM; }
        const int col0 = colt + wc * 32 + 8 * fq;
#pragma unroll
        for (int ai = 0; ai < 2; ++ai)
#pragma unroll
            for (int m = 0; m < 4; ++m) { bf16_t* rowp = base + (size_t)(row0 + ai * HALF + m * 16) * ldc + col0; const float r = rsl[wr * 64 + ai * HALF + m * 16 + fr];
#pragma unroll
                for (int bj = 0; bj < 2; ++bj) { const f32x4 v0 = acc[ai][bj][m][0] * r, v1 = acc[ai][bj][m][1] * r;
                    u32x4 w; w.x = cvt_pk_bf16(v0[0], v0[1]); w.y = cvt_pk_bf16(v0[2], v0[3]); w.z = cvt_pk_bf16(v1[0], v1[1]); w.w = cvt_pk_bf16(v1[2], v1[3]);
                    if (EPI_NT) __builtin_nontemporal_store(w, (u32x4*)(rowp + bj * HALF)); else *(u32x4*)(rowp + bj * HALF) = w; } }
    }
};
struct MidNone { static constexpr bool ON = false; int tmid; __device__ __forceinline__ void operator()(f32x4 (&)[2][2][4][2], const Unit&, int, int, int, int) const {} };
struct MidGate {
    static constexpr bool ON = true;
    int tmid; const bf16_t* G;
    __device__ __forceinline__ void operator()(f32x4 (&acc)[2][2][4][2], const Unit& u, int wr, int wc, int fr, int fq) const {
        asm volatile("" : "+v"(fr), "+v"(fq));
        const int row0 = u.pm * BM + wr * 64 + fr; const int col0 = u.pn * BM + wc * 32 + 8 * fq;
#pragma unroll
        for (int ai = 0; ai < 2; ++ai)
#pragma unroll
            for (int m = 0; m < 4; ++m) { const bf16_t* grow = G + (size_t)(row0 + ai * HALF + m * 16) * 8192 + col0;
#pragma unroll
                for (int bj = 0; bj < 2; ++bj) {
                    const u32x4 gf = *(const u32x4*)(grow + bj * HALF), gd = *(const u32x4*)(grow + 4096 + bj * HALF);
                    const unsigned fw[4] = {gf.x, gf.y, gf.z, gf.w}, dw[4] = {gd.x, gd.y, gd.z, gd.w};
#pragma unroll
                    for (int q = 0; q < 4; ++q) {
                        const float r0 = (1.0f + __builtin_amdgcn_exp2f(-1.4426950408889634f * bf_lo(dw[q]))) * __builtin_amdgcn_rcpf(1.0f + __builtin_amdgcn_exp2f(-1.4426950408889634f * bf_lo(fw[q])));
                        const float r1 = (1.0f + __builtin_amdgcn_exp2f(-1.4426950408889634f * bf_hi(dw[q]))) * __builtin_amdgcn_rcpf(1.0f + __builtin_amdgcn_exp2f(-1.4426950408889634f * bf_hi(fw[q])));
                        acc[ai][bj][m][q >> 1][2 * (q & 1)] *= r0; acc[ai][bj][m][q >> 1][2 * (q & 1) + 1] *= r1; } }
                asm volatile("" : "+v"(acc[ai][0][m][0]), "+v"(acc[ai][0][m][1]), "+v"(acc[ai][1][m][0]), "+v"(acc[ai][1][m][1]) :: "memory"); }
    }
};
struct EpiGateOut {
    static constexpr bool PERM = true, AFTER_DRAIN = false, ROWSCALE = false;
    bf16_t* O; const bf16_t* G;
    __device__ __forceinline__ void operator()(const f32x4 (&acc)[2][2][4][2], const Unit& u, int wr, int wc, int fr, int fq, const PG8_LAS float*) const {
        const int row0 = u.pm * BM + wr * 64 + fr; const int col0 = u.pn * BM + wc * 32 + 8 * fq;
#pragma unroll
        for (int ai = 0; ai < 2; ++ai)
#pragma unroll
            for (int m = 0; m < 4; ++m) { const size_t row = (size_t)(row0 + ai * HALF + m * 16);
#pragma unroll
                for (int bj = 0; bj < 2; ++bj) { const int col = col0 + bj * HALF;
                    const u32x4 gw = *(const u32x4*)(G + row * 8192 + 4096 + col);
                    f32x4 v0 = acc[ai][bj][m][0], v1 = acc[ai][bj][m][1];
                    v0[0] *= sigm(bf_lo(gw.x)); v0[1] *= sigm(bf_hi(gw.x)); v0[2] *= sigm(bf_lo(gw.y)); v0[3] *= sigm(bf_hi(gw.y));
                    v1[0] *= sigm(bf_lo(gw.z)); v1[1] *= sigm(bf_hi(gw.z)); v1[2] *= sigm(bf_lo(gw.w)); v1[3] *= sigm(bf_hi(gw.w));
                    u32x4 w; w.x = cvt_pk_bf16(v0[0], v0[1]); w.y = cvt_pk_bf16(v0[2], v0[3]); w.z = cvt_pk_bf16(v1[0], v1[1]); w.w = cvt_pk_bf16(v1[2], v1[3]);
                    *(u32x4*)(O + row * 4096 + col) = w; } }
    }
};

typedef int i32x4 __attribute__((ext_vector_type(4)));
typedef int i32x8 __attribute__((ext_vector_type(8)));
__device__ __forceinline__ i32x8 cat8(bf16x8 a, bf16x8 b) { const i32x4 x = __builtin_bit_cast(i32x4, a), y = __builtin_bit_cast(i32x4, b); return __builtin_shufflevector(x, y, 0, 1, 2, 3, 4, 5, 6, 7); }
template <class Epi, class Sched, bool ALIGN_EPI, class Mid = MidNone, bool F8 = false>
__device__ __forceinline__ void gemm_phase(PG8_LAS unsigned char* lds, const int tid, const Gemm g, const Sched& S, const Epi& E, const Mid MH = Mid{}) {
    const int wid = __builtin_amdgcn_readfirstlane(tid >> 6), lane = tid & 63, wr = wid >> 2, wc = wid & 3, fr = lane & 15, fq = lane >> 4;
    const int K = g.K, nt = K / BK;
    unsigned voffA[2], voffB[2];
#pragma unroll
    for (int i = 0; i < 2; ++i) { int R, C; stage_rc(tid * 16 + i * 8192, R, C); const int Rb = Epi::PERM ? ((R & ~31) + perm32(R & 31)) : R;
        voffA[i] = (unsigned)(R * g.lda + C) * 2u; voffB[i] = (unsigned)(Rb * g.ldb + C) * 2u; }
    const size_t kstep = (size_t)(BK * 2);
    const size_t hstepA = (size_t)HALF * g.lda * 2, hstepB = (size_t)HALF * g.ldb * 2;
    const size_t tstepA = 2 * hstepA, tstepB = 2 * hstepB;
    const unsigned ldsw = (unsigned)wid * 1024u;
    const int aoff = lds_byte(wr * 64 + fr, fq * 8), boff = lds_byte(wc * 32 + fr, fq * 8);
#define PG8_SA(b, h) (((b) * 2 + (h)) * HTB)
#define PG8_SB(b, h) ((4 + (b) * 2 + (h)) * HTB)
#define PG8_STAGE(bufoff, gbase, voff) do { _Pragma("unroll") for (int _i = 0; _i < 2; ++_i) \
        __builtin_amdgcn_global_load_lds((const unsigned*)((const char*)(gbase) + (voff)[_i]), (PG8_LAS unsigned*)(lds + (bufoff) + ldsw + _i * 8192), 16, 0, 0); } while (0)
#define PG8_LDA(dst, b, h) do { _Pragma("unroll") for (int m = 0; m < 4; ++m) _Pragma("unroll") for (int k = 0; k < 2; ++k) dst[m][k] = *(const PG8_LAS bf16x8*)(lds + PG8_SA(b, h) + aoff + m * 2048 + k * 1024); } while (0)
#define PG8_LDB(dst, b, h) do { _Pragma("unroll") for (int n = 0; n < 2; ++n) _Pragma("unroll") for (int k = 0; k < 2; ++k) dst[n][k] = *(const PG8_LAS bf16x8*)(lds + PG8_SB(b, h) + boff + n * 2048 + k * 1024); } while (0)
#define PG8_MMA(ai, bj, At, Bt) do { if (PG8_PRIO) __builtin_amdgcn_s_setprio(PG8_PRIO); _Pragma("unroll") for (int m = 0; m < 4; ++m) _Pragma("unroll") for (int n = 0; n < 2; ++n) { \
        if constexpr (F8) { asm volatile("v_mfma_scale_f32_16x16x128_f8f6f4 %0, %1, %2, %0, %3, %3 op_sel_hi:[0,0,0]" : "+v"(acc[ai][bj][m][n]) : "v"(cat8(Bt[n][0], Bt[n][1])), "v"(cat8(At[m][0], At[m][1])), "v"(f8one)); }   \
        else { _Pragma("unroll") for (int k = 0; k < 2; ++k) acc[ai][bj][m][n] = __builtin_amdgcn_mfma_f32_16x16x32_bf16(Bt[n][k], At[m][k], acc[ai][bj][m][n], 0, 0, 0); } } \
        if (PG8_PRIO) __builtin_amdgcn_s_setprio(0); } while (0)
#define PG8_WAIT_V(n) asm volatile("s_waitcnt vmcnt(" #n ")" ::: "memory")
#define PG8_WAIT_L(n) asm volatile("s_waitcnt lgkmcnt(" #n ")" ::: "memory")
#define PG8_BAR __builtin_amdgcn_s_barrier()
#define PG8_SCHED __builtin_amdgcn_sched_barrier(0)
    Unit cur, nxt; int ui = 0;
    if (!S.next(0, cur)) return;
    constexpr int RSL_OFF = STAGE_BYTES; int rpar = 0;
#define PG8_RSPF(uu, par) do { if constexpr (Epi::ROWSCALE) { if (wid == 0) __builtin_amdgcn_global_load_lds((const unsigned*)(E.rs + (size_t)(uu).pm * BM + lane * 4), (PG8_LAS unsigned*)(lds + RSL_OFF + (par) * 1024), 16, 0, 0); } } while (0)
    PG8_RSPF(cur, 0);
    f32x4 acc[2][2][4][2];
#pragma unroll
    for (int a = 0; a < 2; ++a)
#pragma unroll
        for (int b = 0; b < 2; ++b)
#pragma unroll
            for (int m = 0; m < 4; ++m)
#pragma unroll
                for (int n = 0; n < 2; ++n) acc[a][b][m][n] = (f32x4){0.f, 0.f, 0.f, 0.f};
    bf16x8 At[4][2], B0[2][2], B1[2][2];
    int f8one = 0x7F7F7F7F; if constexpr (F8) asm volatile("" : "+v"(f8one));
    const char* cA = (const char*)g.A + (size_t)cur.pm * tstepA; const char* cB = (const char*)g.Bt + (size_t)cur.pn * tstepB;
    S.a_ready(cur);
    PG8_STAGE(PG8_SB(0, 0), cB, voffB); PG8_STAGE(PG8_SB(0, 1), cB + hstepB, voffB); PG8_STAGE(PG8_SA(0, 0), cA, voffA); PG8_STAGE(PG8_SA(0, 1), cA + hstepA, voffA);
    if (wr == 1) PG8_BAR;
    PG8_WAIT_V(2); PG8_BAR;
    PG8_STAGE(PG8_SB(1, 0), cB + kstep, voffB); PG8_STAGE(PG8_SA(1, 0), cA + kstep, voffA); PG8_STAGE(PG8_SB(1, 1), cB + hstepB + kstep, voffB);
    PG8_WAIT_V(6); PG8_BAR;
    for (;;) {
        const bool has_next = S.next(ui + 1, nxt);
        const char* nA = has_next ? (const char*)g.A + (size_t)nxt.pm * tstepA : cA; const char* nB = has_next ? (const char*)g.Bt + (size_t)nxt.pn * tstepB : cB;
        for (int t = 0; t < nt; t += 2) {
            const bool last = (t == nt - 2);
            const char* a1 = cA + (size_t)(t >> g.pshA) * g.pstrA + (size_t)((t & ((1 << g.pshA) - 1)) + 1) * kstep;
            const int t2 = t + 2;
            const char* a2 = last ? nA : cA + (size_t)(t2 >> g.pshA) * g.pstrA + (size_t)(t2 & ((1 << g.pshA) - 1)) * kstep;
            const char* b2 = last ? nB : cB + (size_t)(t2 >> g.pshB) * g.pstrB + (size_t)(t2 & ((1 << g.pshB) - 1)) * kstep;
            const char* a3 = a2 + kstep; const char* b3 = b2 + kstep;
            if (last && has_next) S.a_ready(nxt);
            if constexpr (Mid::ON) { if (t == MH.tmid) MH(acc, cur, wr, wc, fr, fq); }
            PG8_LDB(B0, 0, 0); PG8_LDB(B1, 0, 1); PG8_SCHED; PG8_LDA(At, 0, 0); PG8_STAGE(PG8_SA(1, 1), a1 + hstepA, voffA);
            PG8_WAIT_V(8); PG8_WAIT_L(0); PG8_BAR; PG8_MMA(0, 0, At, B0); PG8_MMA(0, 1, At, B1); PG8_BAR; PG8_SCHED;
            PG8_LDA(At, 0, 1); PG8_STAGE(PG8_SB(0, 0), b2, voffB); PG8_STAGE(PG8_SB(0, 1), b2 + hstepB, voffB); PG8_STAGE(PG8_SA(0, 0), a2, voffA);
            PG8_WAIT_V(8); PG8_WAIT_L(0); PG8_BAR; PG8_MMA(1, 0, At, B0); PG8_MMA(1, 1, At, B1); PG8_BAR; PG8_SCHED;
            PG8_LDB(B0, 1, 0); PG8_LDB(B1, 1, 1); PG8_SCHED; PG8_LDA(At, 1, 0); PG8_STAGE(PG8_SA(0, 1), a2 + hstepA, voffA);
            PG8_WAIT_V(8); PG8_WAIT_L(0); PG8_BAR; PG8_MMA(0, 0, At, B0); PG8_MMA(0, 1, At, B1); PG8_BAR; PG8_SCHED;
            PG8_LDA(At, 1, 1); PG8_STAGE(PG8_SB(1, 0), b3, voffB); PG8_STAGE(PG8_SB(1, 1), b3 + hstepB, voffB); PG8_STAGE(PG8_SA(1, 0), a3, voffA);
            PG8_WAIT_V(8); PG8_WAIT_L(0); PG8_BAR; PG8_MMA(1, 0, At, B0); PG8_MMA(1, 1, At, B1); PG8_BAR; PG8_SCHED;
        }
        if constexpr (ALIGN_EPI) { if (wr == 0) PG8_BAR; }
        if constexpr (F8) {
            asm volatile("s_nop 15\n\ts_nop 15" : "+v"(acc[0][0][0][0]), "+v"(acc[0][0][0][1]), "+v"(acc[0][0][1][0]), "+v"(acc[0][0][1][1]), "+v"(acc[0][0][2][0]), "+v"(acc[0][0][2][1]), "+v"(acc[0][0][3][0]), "+v"(acc[0][0][3][1]),
                                                   "+v"(acc[0][1][0][0]), "+v"(acc[0][1][0][1]), "+v"(acc[0][1][1][0]), "+v"(acc[0][1][1][1]), "+v"(acc[0][1][2][0]), "+v"(acc[0][1][2][1]), "+v"(acc[0][1][3][0]), "+v"(acc[0][1][3][1]) :: "memory");
            asm volatile("" : "+v"(acc[1][0][0][0]), "+v"(acc[1][0][0][1]), "+v"(acc[1][0][1][0]), "+v"(acc[1][0][1][1]), "+v"(acc[1][0][2][0]), "+v"(acc[1][0][2][1]), "+v"(acc[1][0][3][0]), "+v"(acc[1][0][3][1]),
                              "+v"(acc[1][1][0][0]), "+v"(acc[1][1][0][1]), "+v"(acc[1][1][1][0]), "+v"(acc[1][1][1][1]), "+v"(acc[1][1][2][0]), "+v"(acc[1][1][2][1]), "+v"(acc[1][1][3][0]), "+v"(acc[1][1][3][1]) :: "memory"); }
        E(acc, cur, wr, wc, fr, fq, (const PG8_LAS float*)(lds + RSL_OFF + rpar * 1024)); S.done(cur); rpar ^= 1;
        if (!has_next) break;
#pragma unroll
        for (int a = 0; a < 2; ++a)
#pragma unroll
            for (int b = 0; b < 2; ++b)
#pragma unroll
                for (int m = 0; m < 4; ++m)
#pragma unroll
                    for (int n = 0; n < 2; ++n) acc[a][b][m][n] = (f32x4){0.f, 0.f, 0.f, 0.f};
        cur = nxt; cA = nA; cB = nB; ++ui;
        PG8_RSPF(cur, rpar);
        if constexpr (ALIGN_EPI) { if (wr == 1) PG8_BAR; }
    }
    PG8_WAIT_V(0);
    if constexpr (!ALIGN_EPI) { if (wr == 0) PG8_BAR; }
    PG8_BAR;
#undef PG8_SA
#undef PG8_SB
#undef PG8_STAGE
#undef PG8_LDA
#undef PG8_LDB
#undef PG8_MMA
#undef PG8_WAIT_V
#undef PG8_WAIT_L
#undef PG8_BAR
#undef PG8_SCHED
#undef PG8_RSPF
}
}
#ifndef ATT_PRIO
#define ATT_PRIO 2
#endif
#ifndef ATT_STAGGER
#define ATT_STAGGER 0
#endif
namespace att {
typedef unsigned short bf16_t;
typedef short bf16x8 __attribute__((ext_vector_type(8)));
typedef short s16x4 __attribute__((ext_vector_type(4)));
typedef float f32x16 __attribute__((ext_vector_type(16)));
typedef float f32x4 __attribute__((ext_vector_type(4)));
typedef unsigned u32x4 __attribute__((ext_vector_type(4)));
constexpr int D = 128, NW = 8, QBLK = 32, KVBLK = 64, QB = NW * QBLK;
constexpr int SHM_V = KVBLK * D * 2, SHM_K = KVBLK * D * 2;
constexpr int OFF_WS = 2 * SHM_V + 2 * SHM_K;
constexpr int OFF_BIAS = OFF_WS + NW * 64 * 4;
constexpr int OFF_Q = OFF_BIAS + 2 * 64 * 4;
constexpr int OFF_OST = 69632;
constexpr int OST_PITCH = 136, OST_WAVE = 32 * OST_PITCH * 2;
constexpr int LDS_BYTES = OFF_OST + NW * OST_WAVE;
static_assert(OFF_Q + 16 <= OFF_OST, "attention LDS map");
constexpr int PKV = 12288;
constexpr int PO = 6144;
constexpr int META_ROW0 = 16384;
constexpr float SCALE = 0.08838834764831845f;
constexpr float C2 = 1.4426950408889634f * SCALE;
constexpr float THR = 8.f;
constexpr unsigned WBIG = 0x40000000u;

#define KSWZ(row, colB) ((row) * 256 + ((colB) ^ (((row) & 7) << 4)))
#define SBAR() __builtin_amdgcn_sched_barrier(0)
__device__ __forceinline__ int v_st(int k, int c) { const int kk = (k & ~0xC) | ((k & 4) << 1) | ((k & 8) >> 1); return ((kk >> 3) * 4 + (c >> 5)) * 512 + ((kk & 7) * 32 + (c & 31)) * 2; }
__device__ __forceinline__ int v_rd_base(int lane) { return ((lane & 3) << 3) | (((lane >> 2) & 3) << 6) | (((lane >> 4) & 1) << 5) | (((lane >> 5) & 1) << 8); }
constexpr int v_rd_off(int d0, int ks, int half) { return d0 * 512 + ks * 4096 + half * 2048; }
__device__ __forceinline__ int crow(int r, int hi) { return (r & 3) + 8 * (r >> 2) + 4 * hi; }
__device__ __forceinline__ unsigned cvtpk(float lo, float hi) { unsigned r; asm volatile("v_cvt_pk_bf16_f32 %0, %1, %2" : "=v"(r) : "v"(lo), "v"(hi)); return r; }
__device__ __forceinline__ bf16x8 load8(const bf16_t* p) { return *reinterpret_cast<const bf16x8*>(p); }

__device__ __forceinline__ void mask_tile(f32x16& p0, f32x16& p1, int dq) {
    const float NEG = -__builtin_inff();
#pragma unroll
    for (int r = 0; r < 16; ++r) {
        const int c = (r & 3) + 8 * (r >> 2);
        if ((unsigned)(dq - c) >= WBIG) p0[r] = NEG;
        if ((unsigned)(dq - c - 32) >= WBIG) p1[r] = NEG;
    }
}
__device__ __forceinline__ void mask_tile0(f32x16& p0, f32x16& p1) {
    const float NEG = -__builtin_inff();
#pragma unroll
    for (int r = 0; r < 16; ++r) { p0[r] = NEG; if (r < 8) p1[r] = NEG; }
}
__device__ __forceinline__ void partialSM(f32x16& p0, f32x16& p1, float& m_reg, float& mn, float& alpha) {
    float pmax = p0[0]; for (int r = 1; r < 16; ++r) pmax = fmaxf(pmax, p0[r]); for (int r = 0; r < 16; ++r) pmax = fmaxf(pmax, p1[r]);
    { auto rr = __builtin_amdgcn_permlane32_swap(__float_as_uint(pmax), __float_as_uint(pmax), false, false);
      pmax = fmaxf(__uint_as_float(rr[0]), __uint_as_float(rr[1])); }
    if (__builtin_expect(__all((pmax - m_reg) * SCALE <= THR), 1)) { mn = m_reg; alpha = 1.f; }
    else { mn = fmaxf(m_reg, pmax); alpha = __builtin_amdgcn_exp2f((m_reg - mn) * C2); m_reg = mn; }
    const float mnL = -mn * C2;
    for (int r = 0; r < 16; ++r) p0[r] = fmaf(p0[r], C2, mnL); for (int r = 0; r < 16; ++r) p1[r] = fmaf(p1[r], C2, mnL);
    for (int r = 0; r < 16; ++r) p0[r] = __builtin_amdgcn_exp2f(p0[r]);
}
__device__ __forceinline__ void finishSM(f32x16& p0, f32x16& p1, float alpha, float& l_reg, bf16x8& pa0, bf16x8& pa1, bf16x8& pa2, bf16x8& pa3) {
    for (int r = 0; r < 16; ++r) p1[r] = __builtin_amdgcn_exp2f(p1[r]);
    float ps = 0; for (int r = 0; r < 16; ++r) ps += p0[r]; for (int r = 0; r < 16; ++r) ps += p1[r];
    { auto rr = __builtin_amdgcn_permlane32_swap(__float_as_uint(ps), __float_as_uint(ps), false, false);
      ps = __uint_as_float(rr[0]) + __uint_as_float(rr[1]); }
    l_reg = l_reg * alpha + ps;
#define PK4(P, B_, OUT) do { unsigned a0 = cvtpk(P[B_+0], P[B_+1]), a1 = cvtpk(P[B_+2], P[B_+3]);                          \
        unsigned b0 = cvtpk(P[B_+4], P[B_+5]), b1 = cvtpk(P[B_+6], P[B_+7]);                                             \
        auto r0 = __builtin_amdgcn_permlane32_swap(a0, b0, false, false); auto r1 = __builtin_amdgcn_permlane32_swap(a1, b1, false, false); \
        u32x4 w = {r0[0], r1[0], r0[1], r1[1]}; OUT = *reinterpret_cast<bf16x8*>(&w); } while (0)
    PK4(p0, 0, pa0); PK4(p0, 8, pa1); PK4(p1, 0, pa2); PK4(p1, 8, pa3);
#undef PK4
}
template <int KB>
__device__ __forceinline__ void qkt(f32x16& p0, f32x16& p1, const char* K_lds, int r32, int hi, const bf16x8* qr, const float* bias_l) {
    { const f32x4* bb = (const f32x4*)(bias_l + KB * 64 + 4 * hi);
#pragma unroll
      for (int g = 0; g < 4; ++g) { const f32x4 b0 = bb[2 * g], b1 = bb[8 + 2 * g];
#pragma unroll
          for (int i = 0; i < 4; ++i) { p0[4 * g + i] = b0[i]; p1[4 * g + i] = b1[i]; } } }
    const char* kb[4];
#pragma unroll
    for (int dd = 0; dd < 4; ++dd) kb[dd] = K_lds + KB * SHM_K + KSWZ(r32, (dd * 16 + hi * 8) * 2);
    if (ATT_PRIO & 1) __builtin_amdgcn_s_setprio(1);
#pragma unroll
    for (int d0 = 0; d0 < 8; ++d0) { const char* a = kb[d0 & 3] + (d0 >> 2) * 128;
        bf16x8 b0 = *reinterpret_cast<const bf16x8*>(a);
        bf16x8 b1 = *reinterpret_cast<const bf16x8*>(a + 32 * 256);
        p0 = __builtin_amdgcn_mfma_f32_32x32x16_bf16(b0, qr[d0], p0, 0, 0, 0);
        p1 = __builtin_amdgcn_mfma_f32_32x32x16_bf16(b1, qr[d0], p1, 0, 0, 0); }
    if (ATT_PRIO & 1) __builtin_amdgcn_s_setprio(0);
}
template <int VB>
__device__ __forceinline__ void pv_tile(f32x16* o, int vb0, bf16x8 pa0, bf16x8 pa1, bf16x8 pa2, bf16x8 pa3) {
#define TRRD(dst, off) asm volatile("ds_read_b64_tr_b16 %0, %1 offset:%2" : "=&v"(dst) : "v"(vb0), "i"(off) : "memory")
#define PV_D0(d0) do { s16x4 l0, l1, l2, l3, h0, h1, h2, h3; constexpr int b_ = VB * SHM_V + v_rd_off(d0, 0, 0);     \
        TRRD(l0, b_); TRRD(h0, b_ + 2048); TRRD(l1, b_ + 4096); TRRD(h1, b_ + 6144); TRRD(l2, b_ + 8192); TRRD(h2, b_ + 10240); TRRD(l3, b_ + 12288); TRRD(h3, b_ + 14336); \
        asm volatile("s_waitcnt lgkmcnt(0)" ::: "memory"); SBAR();   \
        o[d0] = __builtin_amdgcn_mfma_f32_32x32x16_bf16(pa0, (bf16x8){l0[0], l0[1], l0[2], l0[3], h0[0], h0[1], h0[2], h0[3]}, o[d0], 0, 0, 0);   \
        o[d0] = __builtin_amdgcn_mfma_f32_32x32x16_bf16(pa1, (bf16x8){l1[0], l1[1], l1[2], l1[3], h1[0], h1[1], h1[2], h1[3]}, o[d0], 0, 0, 0);   \
        o[d0] = __builtin_amdgcn_mfma_f32_32x32x16_bf16(pa2, (bf16x8){l2[0], l2[1], l2[2], l2[3], h2[0], h2[1], h2[2], h2[3]}, o[d0], 0, 0, 0);   \
        o[d0] = __builtin_amdgcn_mfma_f32_32x32x16_bf16(pa3, (bf16x8){l3[0], l3[1], l3[2], l3[3], h3[0], h3[1], h3[2], h3[3]}, o[d0], 0, 0, 0); } while (0)
    if (ATT_PRIO & 2) __builtin_amdgcn_s_setprio(1);
    PV_D0(0); PV_D0(1); PV_D0(2); PV_D0(3);
    if (ATT_PRIO & 2) __builtin_amdgcn_s_setprio(0);
#undef PV_D0
#undef TRRD
}

struct BlockRef { const bf16_t* Q; const bf16_t* K; const bf16_t* V; bf16_t* O; const float* kb; float sl2; int rowb; int P0; int jlo; int probe; };
struct Seam { bf16x8 qr[8]; bf16x8 st_v0, st_v1, st_k0, st_k1; float st_b; };

#define VMW() asm volatile("s_waitcnt vmcnt(0)" ::: "memory")
#define VMWN(n) asm volatile("s_waitcnt vmcnt(%0)" :: "i"(n) : "memory")
__device__ __forceinline__ bf16x8 load8o(const bf16_t* base, unsigned byteoff) { return *reinterpret_cast<const bf16x8*>((const char*)base + byteoff); }
__device__ __forceinline__ void sload(Seam& S, const BlockRef& R, int j, int sr, int sc, int wid, int lane) {
    if (R.probe) j = R.jlo;
    const int rb = (j == 0) ? (META_ROW0 - 48) : (R.rowb + 64 * (j - 1));
    const unsigned o0 = (unsigned)((rb + sr) * PKV + sc) * 2u, o1 = (unsigned)((rb + 32 + sr) * PKV + sc) * 2u;
    S.st_v0 = load8o(R.V, o0); S.st_v1 = load8o(R.V, o1);
    S.st_k0 = load8o(R.K, o0); S.st_k1 = load8o(R.K, o1);
    if (wid == 0) { const int e = 64 * j + lane; S.st_b = R.kb ? R.kb[e] : R.sl2 * (float)(e - (R.P0 + QB)); }
}
__device__ __forceinline__ float row_bias(const BlockRef& R, int wid, int r32) { const int rr = wid * QBLK + r32; return R.kb ? R.kb[R.P0 + rr] : R.sl2 * (float)(rr - QB); }
#define SWRITE_K(bf) do { *(bf16x8*)(K_lds + (bf) * SHM_K + kws) = S.st_k0; *(bf16x8*)(K_lds + (bf) * SHM_K + kws + 32 * 256) = S.st_k1; \
                          if (wid == 0) bias_l[(bf) * 64 + lane] = S.st_b; } while (0)
#define SWRITE_V(bf) do { *(bf16x8*)(V_lds + (bf) * SHM_V + vst0) = S.st_v0; *(bf16x8*)(V_lds + (bf) * SHM_V + vst0 + 8192) = S.st_v1; } while (0)

__device__ __forceinline__ void attn_prime(const int tid, const BlockRef& cur, char* lds, Seam& S) {
    const int wid = __builtin_amdgcn_readfirstlane(tid >> 6), lane = tid & 63, r32 = lane & 31, hi = lane >> 5;
    const int sr = tid >> 4, sc = (tid & 15) * 8, kws = KSWZ(sr, sc * 2); char* K_lds = lds + 2 * SHM_V; float* bias_l = (float*)(lds + OFF_BIAS);
#pragma unroll
    for (int d0 = 0; d0 < 8; ++d0) S.qr[d0] = load8o(cur.Q, (unsigned)((wid * QBLK + r32) * PKV + d0 * 16 + hi * 8) * 2u);
    sload(S, cur, cur.jlo, sr, sc, wid, lane); VMW(); SWRITE_K(0);
    __syncthreads();
}
__device__ __forceinline__ void attn_block(const int tid, const BlockRef& cur, const BlockRef& nxt, char* lds, Seam& S) {
    const int wid = __builtin_amdgcn_readfirstlane(tid >> 6), lane = tid & 63, r32 = lane & 31, hi = lane >> 5;
    const int j0 = cur.jlo, NT = (cur.P0 + QB - 1) / KVBLK + 1 - j0;
    const int qlo = cur.P0 + wid * QBLK, qm = qlo + r32 - 4 * hi;
    char* V_lds = lds; char* K_lds = lds + 2 * SHM_V;
    float* ws = (float*)(lds + OFF_WS) + wid * 64; float* li_l = ws, * al_l = ws + 32;
    float* bias_l = (float*)(lds + OFF_BIAS);
    float m_reg = -1e30f, l_reg = 0; f32x16 o[4] = {};
    const int sr = tid >> 4, sc = (tid & 15) * 8, vst0 = v_st(sr, sc), kws = KSWZ(sr, sc * 2);
    const int vb0 = (int)(uintptr_t)V_lds + v_rd_base(lane);
#define RESC(a) do { if (__any((a) < 1.f)) { if (hi == 0) al_l[r32] = (a); asm volatile("s_waitcnt lgkmcnt(0)" ::: "memory");              \
                     for (int d_ = 0; d_ < 4; ++d_) for (int r = 0; r < 16; ++r) o[d_][r] *= al_l[crow(r, hi)]; } } while (0)
#define MASKT(P0_, P1_, t) do { const int kb_ = (j0 + (t)) * KVBLK; if (kb_ + KVBLK - 1 > qlo) mask_tile(P0_, P1_, qm - kb_); } while (0)
    f32x16 pA0, pA1, pB0, pB1; float mnA, mnB, alA, alB; bf16x8 pa0, pa1, pa2, pa3;
    SWRITE_V(0); SBAR();
    if (NT > 1) sload(S, cur, j0 + 1, sr, sc, wid, lane);
    SBAR(); qkt<0>(pA0, pA1, K_lds, r32, hi, S.qr, bias_l);
    if (j0 == 0) mask_tile0(pA0, pA1);
    partialSM(pA0, pA1, m_reg, mnA, alA);
    if (NT > 1) { VMW(); SWRITE_V(1); SWRITE_K(1); }
    __syncthreads();
#define HALF_STEP(PX0, PX1, mnX, alX, PY0, PY1, alY, t, KB, VB, SB) do {                                                      \
        SBAR(); if (ATT_STAGGER && wid >= 4) __builtin_amdgcn_s_sleep(ATT_STAGGER); SBAR(); if ((t) + 1 < NT) { sload(S, cur, j0 + (t) + 1, sr, sc, wid, lane); SBAR(); }     \
        qkt<KB>(PX0, PX1, K_lds, r32, hi, S.qr, bias_l);                                                                      \
        finishSM(PY0, PY1, alY, l_reg, pa0, pa1, pa2, pa3); SBAR();                                                           \
        pv_tile<VB>(o, vb0, pa0, pa1, pa2, pa3); MASKT(PX0, PX1, (t)); partialSM(PX0, PX1, m_reg, mnX, alX);       \
        __syncthreads();                                                                                                      \
        if ((t) + 1 < NT) { VMW(); SWRITE_V(SB); SWRITE_K(SB); }                                                              \
        RESC(alX); __syncthreads(); } while (0)
    for (int t = 1; t + 1 < NT; t += 2) {
        HALF_STEP(pB0, pB1, mnB, alB, pA0, pA1, alA, t, 1, 0, 0);
        HALF_STEP(pA0, pA1, mnA, alA, pB0, pB1, alB, t + 1, 0, 1, 1);
    }
    constexpr bool even = false;
    if (even) { SBAR(); qkt<1>(pB0, pB1, K_lds, r32, hi, S.qr, bias_l); SBAR(); }
    sload(S, nxt, nxt.jlo, sr, sc, wid, lane); SBAR();
#pragma unroll
    for (int d0 = 0; d0 < 8; ++d0) S.qr[d0] = load8o(nxt.Q, (unsigned)((wid * QBLK + r32) * PKV + d0 * 16 + hi * 8) * 2u);
    SBAR();
    finishSM(pA0, pA1, alA, l_reg, pa0, pa1, pa2, pa3); SBAR();
    pv_tile<0>(o, vb0, pa0, pa1, pa2, pa3);
    if (even) { MASKT(pB0, pB1, NT - 1); partialSM(pB0, pB1, m_reg, mnB, alB); __syncthreads(); RESC(alB);
        finishSM(pB0, pB1, alB, l_reg, pa0, pa1, pa2, pa3); SBAR(); pv_tile<1>(o, vb0, pa0, pa1, pa2, pa3); }
    SBAR(); VMWN(8); SWRITE_K(0); SBAR();
    if (hi == 0) li_l[r32] = l_reg; asm volatile("s_waitcnt lgkmcnt(0)" ::: "memory");
    float rli[16];
#pragma unroll
    for (int r = 0; r < 16; ++r) rli[r] = __builtin_amdgcn_rcpf(li_l[crow(r, hi)]);
    bf16_t* Ow = cur.O + (size_t)(wid * QBLK) * PO;
    bf16_t* stg = (bf16_t*)(lds + OFF_OST + wid * OST_WAVE);
#pragma unroll
    for (int r = 0; r < 16; ++r) { const int orow = crow(r, hi);
#pragma unroll
        for (int d0 = 0; d0 < 4; ++d0) { const float v = o[d0][r] * rli[r];
            const float vn = __int_as_float(__builtin_amdgcn_mov_dpp(__float_as_int(v), 0xB1, 0xF, 0xF, true));
            if ((r32 & 1) == 0) *(unsigned*)(stg + orow * OST_PITCH + d0 * 32 + r32) = cvtpk(v, vn); } }
    asm volatile("s_waitcnt lgkmcnt(0)" ::: "memory");
#pragma unroll
    for (int i = 0; i < 8; ++i) { const int row = i * 4 + (lane >> 4), ch = lane & 15;
        const u32x4 v = *(const u32x4*)(stg + row * OST_PITCH + ch * 8);
        *(u32x4*)(Ow + (size_t)row * PO + ch * 8) = v; }
    __syncthreads();
#undef RESC
#undef MASKT
#undef HALF_STEP
}
#undef VMW
#undef VMWN
#undef SWRITE_K
#undef SWRITE_V
#undef KSWZ
#undef SBAR
}
constexpr int NWAVES = 8;
constexpr int DM = 4096, NB = 4, SEQ = 4096, NMETA = 16, DFF = 11008;
constexpr int MR = NB * SEQ;
constexpr int MT = MR + 256;
constexpr int NGU = 2 * DFF;
constexpr int NIN = 20736;
constexpr int PQKV = 12288, PGATE = 8192, PAO = 6144;
#ifndef GU_F8
#define GU_F8 1
#endif
#ifndef GATES_F8
#define GATES_F8 1
#endif
#ifndef PU_PAD
#define PU_PAD 0
#endif
constexpr int PU = DM + PU_PAD;
constexpr size_t WD_PSTR = (size_t)4096 * 4096;
constexpr int EKV = 4160;
constexpr float RMS_EPS = 1e-6f;
constexpr float LOG2E = 1.4426950408889634f;
constexpr float ISCALE = 11.313708498984761f;
constexpr float LAMBDA_INIT = 0.2f;

constexpr size_t MiB = 1u << 20;
constexpr size_t WS_CTL = 0, CTL_ZERO_BYTES = 1 * MiB;
constexpr size_t WS_KB = 1 * MiB;
constexpr size_t WS_FLOG = 3 * MiB;
constexpr size_t WS_JLO = 5 * MiB;
constexpr size_t WS_RS0 = 6 * MiB, WS_RS1 = WS_RS0 + 128 * 1024, WS_RS2 = WS_RS1 + 128 * 1024;
constexpr size_t WS_WGU = 8 * MiB;
constexpr size_t WS_WD = 180 * MiB;
constexpr size_t WS_P = WS_WGU;
constexpr size_t WS_WIN = 276 * MiB;
constexpr size_t WS_WGU8 = WS_WIN;
constexpr int GU8_TILES = 22, GU8_ROW0 = (86 - GU8_TILES) * 256;
constexpr size_t WS_WIN8 = WS_WIN + 96 * MiB;
constexpr size_t WS_U8 = 1412 * MiB;
constexpr size_t WS_WO = 438 * MiB;
constexpr size_t WS_WOUT = 470 * MiB;
constexpr size_t WS_U = 502 * MiB;
constexpr size_t WS_Y = 632 * MiB;
constexpr size_t WS_BIG = 762 * MiB;
constexpr size_t WS_GATES = WS_BIG + 390 * MiB;
constexpr size_t WS_AO = 1412 * MiB;
constexpr size_t WS_MG = 1604 * MiB;
constexpr size_t WS_END = 1732 * MiB;
static_assert((size_t)NGU * DM * 2 <= 172 * MiB && (size_t)3 * DM * 4096 * 2 <= 96 * MiB && (size_t)NIN * DM * 2 <= 162 * MiB && (size_t)MT * DM * 2 <= 130 * MiB && (size_t)MT * PU * 2 <= 130 * MiB, "ws map");
static_assert((size_t)MT * DFF * 2 <= 650 * MiB && (size_t)MT * PQKV * 2 <= 390 * MiB && (size_t)MT * PGATE * 2 <= 260 * MiB && (size_t)MR * DM * 4 <= 258 * MiB, "ws map");
static_assert((size_t)NB * 16 * EKV * 4 <= 2 * MiB && (size_t)MT * 16 * 4 <= 2 * MiB, "ws map");
constexpr int CW_BAR = 4096;
constexpr int CW_CQ2 = 8448;
constexpr int CW_CQ = 8320;
constexpr int CW_Q = 8192;
constexpr float SKIP_TH = 44.0f;

constexpr int RING_OFF = 0, RING_BYTES = 131072;
constexpr int LDSCTL_OFF = 139264, MISC_OFF = LDSCTL_OFF + 320;
constexpr int LDS_BYTES = 147456;
static_assert(MISC_OFF + 128 <= LDS_BYTES && att::LDS_BYTES <= LDSCTL_OFF && RING_BYTES <= LDSCTL_OFF, "LDS map");

#define GAS __attribute__((address_space(1)))
#define LAS __attribute__((address_space(3)))
typedef unsigned short bf16;
typedef unsigned v4u __attribute__((ext_vector_type(4)));
typedef unsigned v2u __attribute__((ext_vector_type(2)));
typedef float f32x4 __attribute__((ext_vector_type(4)));
typedef GAS unsigned gu32;
#define RLX_AGENT __ATOMIC_RELAXED, __HIP_MEMORY_SCOPE_AGENT
#define LDS_WAIT() asm volatile("s_waitcnt lgkmcnt(0)" ::: "memory")
#define VM_WAIT() asm volatile("s_waitcnt vmcnt(0)" ::: "memory")
__device__ __forceinline__ unsigned f2bf(float f) { unsigned u = __builtin_bit_cast(unsigned, f); return (u + 0x7fffu + ((u >> 16) & 1u)) >> 16; }
__device__ __forceinline__ unsigned pk2(float lo, float hi) { return f2bf(lo) | (f2bf(hi) << 16); }
__device__ __forceinline__ float bflo(unsigned w) { return __uint_as_float(w << 16); }
__device__ __forceinline__ float bfhi(unsigned w) { return __uint_as_float(w & 0xffff0000u); }

#define XB_TMO      128
#define XB_XCNT(j)  (256  + 64 * (j))
#define XB_XSUB(j)  (1280 + 64 * (j))
#define XB_XGEN(j)  (2304 + 64 * (j))
#define XB_TOP      3328
#define XB_TOPGEN   3392
#define XCD_BAR_WORDS 3456
#define XB_SPIN_CAP (1u << 22)

__device__ __forceinline__ unsigned xb_ld(unsigned* p)              { return __hip_atomic_load(p, __ATOMIC_RELAXED, __HIP_MEMORY_SCOPE_AGENT); }
__device__ __forceinline__ unsigned xb_add(unsigned* p, unsigned v) { return __hip_atomic_fetch_add(p, v, __ATOMIC_RELAXED, __HIP_MEMORY_SCOPE_AGENT); }
__device__ __forceinline__ unsigned xb_xcc_id() { return (unsigned)__builtin_amdgcn_s_getreg((3 << 11) | 20) & 0xFu; }
#define XB_SPIN(cond, bar) do { unsigned _sp = 0; while (cond) { __builtin_amdgcn_s_sleep(1); \
    if ((++_sp & 255u) == 0u) { if (xb_ld(&(bar)[XB_TMO])) break; if (_sp > XB_SPIN_CAP) { atomicAdd(&(bar)[XB_TMO], 1u); break; } } } } while (0)

struct XcdBarrier {
    unsigned* bar; unsigned x;
    volatile LAS unsigned* st;
};
__device__ __forceinline__ XcdBarrier xcd_barrier_post(unsigned* bar, volatile LAS unsigned* st, int tid) {
    XcdBarrier b; b.bar = bar; b.x = xb_xcc_id(); b.st = st;
    if (tid == 0) (void)xb_add(&bar[XB_XCNT(b.x)], 1u);
    return b;
}
__device__ __forceinline__ void xcd_barrier_complete(unsigned* bar, unsigned x, unsigned& nloc, unsigned& nx) {
    const unsigned G = gridDim.x * gridDim.y * gridDim.z;
    unsigned sum, cnt, mine, sp = 0u;
    for (;;) {
        sum = 0u; cnt = 0u; mine = 0u;
#pragma unroll
        for (unsigned j = 0; j < 16; ++j) { const unsigned c = xb_ld(&bar[XB_XCNT(j)]); sum += c; cnt += (c > 0u) ? 1u : 0u; mine = (j == x) ? c : mine; }
        if (sum == G) break;
        __builtin_amdgcn_s_sleep(1);
        if ((++sp & 255u) == 0u) { if (xb_ld(&bar[XB_TMO])) break; if (sp > XB_SPIN_CAP) { atomicAdd(&bar[XB_TMO], 1u); break; } }
    }
    nloc = mine > 0u ? mine : 1u; nx = cnt > 0u ? cnt : 1u;
}
__device__ __forceinline__ void xcd_barrier(const XcdBarrier& b, int tid) {
    asm volatile("s_waitcnt vmcnt(0)" ::: "memory");
    __syncthreads();
    if (tid == 0) {
        unsigned* bar = b.bar;
        __builtin_amdgcn_s_waitcnt(0);
        unsigned nloc = b.st[0], nx = b.st[1];
        if (nloc == 0u) { xcd_barrier_complete(bar, b.x, nloc, nx); b.st[0] = nloc; b.st[1] = nx; }
        const unsigned old = xb_add(&bar[XB_XSUB(b.x)], 1u);
        const unsigned gen = old / nloc;
        if (old + 1u == (gen + 1u) * nloc) {
            __builtin_amdgcn_fence(__ATOMIC_RELEASE, "agent");
            asm volatile("s_waitcnt vmcnt(0)" ::: "memory");
            const unsigned og = xb_add(&bar[XB_TOP], 1u);
            const unsigned tg = og / nx;
            if (og + 1u == (tg + 1u) * nx) xb_add(&bar[XB_TOPGEN], 1u);
            else XB_SPIN(xb_ld(&bar[XB_TOPGEN]) == tg, bar);
            __builtin_amdgcn_fence(__ATOMIC_ACQUIRE, "agent");
            xb_add(&bar[XB_XGEN(b.x)], 1u);
            asm volatile("s_waitcnt vmcnt(0)" ::: "memory");
        } else {
            XB_SPIN(xb_ld(&bar[XB_XGEN(b.x)]) == gen, bar);
            __builtin_amdgcn_fence(__ATOMIC_ACQUIRE, "agent");
            asm volatile("s_waitcnt vmcnt(0)" ::: "memory");
        }
    }
    __syncthreads();
}

typedef const __attribute__((address_space(4))) char* KP;
__device__ __forceinline__ KP kargs() { KP p = (KP)__builtin_amdgcn_kernarg_segment_ptr(); asm volatile("" : "+s"(p)); return p; }
template <class T> __device__ __forceinline__ T* karg(KP kp, int i) { return *(T* const __attribute__((address_space(4)))*)(kp + 8 * i); }
enum { A_X = 0, A_META, A_G_FF1_PRE, A_W_GATE1, A_W_UP1, A_W_DOWN1, A_G_FF1_POST, A_G_MIX_PRE, A_W_IN, A_B_FORGET, A_LQ1, A_LK1, A_LQ2, A_LK2, A_G_SUBLN, A_W_O_FOX, A_W_O_DIFF, A_W_OUT,
       A_G_MIX_POST, A_G_FF2_PRE, A_W_GATE2, A_W_UP2, A_W_DOWN2, A_G_FF2_POST, A_OUT, A_WS };
struct Frame {
    LAS unsigned char* lds;
    int tid, lane, wave;
    int vcu, G;
};
__device__ __forceinline__ void frame_refresh(Frame& F) {
    int l; asm volatile("v_mbcnt_lo_u32_b32 %0, -1, 0\n\tv_mbcnt_hi_u32_b32 %0, -1, %0" : "=v"(l));
    F.lane = l; F.tid = F.wave * 64 + l;
}
template <class T> __device__ __forceinline__ T* wsp(KP kp, size_t off) { return (T*)(karg<unsigned char>(kp, A_WS) + off); }

__device__ __forceinline__ float wave_sum(float v) {
#pragma unroll
    for (int o = 1; o < 64; o <<= 1) v += __shfl_xor(v, o);
    return v;
}
struct OnesTab { float v[DFF]; };
constexpr OnesTab make_ones() { OnesTab t{}; for (int i = 0; i < DFF; ++i) t.v[i] = 1.0f; return t; }
__device__ const OnesTab ONES = make_ones();
struct TrDesc { const float* W; unsigned char* WT; const float* gk; int N, k0, ns, nd, kd; unsigned ldt; float sc;
    __device__ __forceinline__ void set(const float* W_, unsigned char* WT_, const float* gk_, int N_, int k0_, int ns_, int nd_, int kd_, unsigned ldt_, float sc_) { W = W_; WT = WT_; gk = gk_; N = N_; k0 = k0_; ns = ns_; nd = nd_; kd = kd_; ldt = ldt_; sc = sc_; } };
__device__ __forceinline__ void tr_load(const TrDesc& d, int lane, float (&r)[32], f32x4 (&g)[2]) {
    g[0] = *(const GAS f32x4*)(d.gk + d.k0 + 8 * (lane & 7)); g[1] = *(const GAS f32x4*)(d.gk + d.k0 + 8 * (lane & 7) + 4);
    const GAS float* p = (const GAS float*)d.W + (size_t)(d.k0 + (lane >> 5)) * d.N + d.ns + (lane & 31);
#pragma unroll
    for (int i = 0; i < 32; ++i) r[i] = p[(size_t)(2 * i) * d.N];
}
__device__ __forceinline__ void tr_finish(const TrDesc& d, LAS float* scr, int lane, const float (&r)[32], const f32x4 (&g)[2]) {
#pragma unroll
    for (int i = 0; i < 32; ++i) scr[(2 * i + (lane >> 5)) * 33 + (lane & 31)] = r[i];
    const int c = lane & 7;
    f32x4 ga = g[0], gb = g[1];
    LDS_WAIT(); asm volatile("" ::: "memory");
    if (d.sc != 0.f) { ga = ga * d.sc; gb = gb * d.sc;
#pragma unroll
        for (int j = 0; j < 4; ++j) { const int n = (lane >> 3) + 8 * j; const LAS float* s = scr + (8 * c) * 33 + n;
            v2u o; o.x = pg8::pack_fp8x4(s[0 * 33] * ga.x, s[1 * 33] * ga.y, s[2 * 33] * ga.z, s[3 * 33] * ga.w); o.y = pg8::pack_fp8x4(s[4 * 33] * gb.x, s[5 * 33] * gb.y, s[6 * 33] * gb.z, s[7 * 33] * gb.w);
            *(GAS v2u*)(d.WT + (size_t)(d.nd + n) * d.ldt + d.kd + 8 * c) = o; } }
    else {
#pragma unroll
        for (int j = 0; j < 4; ++j) { const int n = (lane >> 3) + 8 * j; const LAS float* s = scr + (8 * c) * 33 + n;
            v4u o; o.x = pk2(s[0 * 33] * ga.x, s[1 * 33] * ga.y); o.y = pk2(s[2 * 33] * ga.z, s[3 * 33] * ga.w); o.z = pk2(s[4 * 33] * gb.x, s[5 * 33] * gb.y); o.w = pk2(s[6 * 33] * gb.z, s[7 * 33] * gb.w);
            *(GAS v4u*)(d.WT + (size_t)(d.nd + n) * d.ldt + (size_t)(d.kd + 8 * c) * 2) = o; } }
    LDS_WAIT(); asm volatile("" ::: "memory");
}
struct GenStride { int it, hi, step; __device__ __forceinline__ bool next(int& o) { if (it >= hi) return false; o = it; it += step; return true; } };
struct GenQueue { unsigned* qhead; int total, lane, cur = 0, end = 0;
    __device__ __forceinline__ bool next(int& o) {
        if (cur >= end) { unsigned base = 0u; if (lane == 0) base = __hip_atomic_fetch_add(qhead, 16u, __ATOMIC_RELAXED, __HIP_MEMORY_SCOPE_AGENT);
            base = (unsigned)__builtin_amdgcn_readfirstlane((int)base); if (base >= (unsigned)total) return false;
            cur = (int)base; end = (int)base + 16 < total ? (int)base + 16 : total; }
        o = cur++; return true; } };
template <class Gen, class Dec>
__device__ __forceinline__ void tr_stream(Frame& F, Gen gen, const Dec& dec) {
    LAS float* scr = (LAS float*)(F.lds + RING_OFF + F.wave * 16384);
    float ra[32], rb[32]; f32x4 gA[2], gB[2]; TrDesc da, db; int it;
    if (!gen.next(it)) return;
    dec(it, da); tr_load(da, F.lane, ra, gA);
    bool hb = gen.next(it); if (hb) dec(it, db); else db = da;
    tr_load(db, F.lane, rb, gB); tr_finish(da, scr, F.lane, ra, gA);
    while (hb) {
        const bool ha = gen.next(it); if (ha) dec(it, da); else da = db;
        tr_load(da, F.lane, ra, gA); tr_finish(db, scr, F.lane, rb, gB);
        if (!ha) break;
        hb = gen.next(it); if (hb) dec(it, db); else db = da;
        tr_load(db, F.lane, rb, gB); tr_finish(da, scr, F.lane, ra, gA);
    }
}
template <int WHICH  >
struct DecFfn { const float* wg; const float* wu; const float* wd; const float* gk; unsigned char* WGU; unsigned char* WD; unsigned char* WGU8;
    static constexpr int NBG = NGU / 32, I_GU = (DM / 64) * NBG, I_D = (DFF / 64) * (DM / 32);
    __device__ __forceinline__ void operator()(int it, TrDesc& d) const {
        if (it < I_GU) { const int kb = it / NBG, nb = it % NBG, pn = nb >> 3, w8 = nb & 7; const float* wa = wg; const float* wb = wu; asm volatile("" : "+s"(wa), "+s"(wb));
            const float* W = w8 < 4 ? wa : wb; const int ns = 128 * pn + 32 * (w8 & 3);
            if ((WHICH & 4) && 32 * nb >= GU8_ROW0) { d.set(W, WGU8, gk, DFF, 64 * kb, ns, 32 * nb - GU8_ROW0, 64 * kb, 4096u, pg8::F8_WINSCALE); return; }
            { d.set(W, WGU, gk, DFF, 64 * kb, ns, 32 * nb, 64 * kb, (unsigned)DM * 2u, 0.f); return; } }
        const int r = it - I_GU, kb = r / (DM / 32), nb = r % (DM / 32);
        { d.set(wd, WD + (size_t)(kb >> 6) * WD_PSTR * 2, ONES.v, DM, 64 * kb, 32 * nb, 32 * nb, (64 * kb) & 4095, 8192u, 0.f); return; } } };
template <int WHICH>
__device__ __forceinline__ void convert_ffn(Frame& F, KP kp, int a_gate, int a_up, int a_down, int a_gain) {
    DecFfn<WHICH> D{karg<const float>(kp, a_gate), karg<const float>(kp, a_up), karg<const float>(kp, a_down), karg<const float>(kp, a_gain), wsp<unsigned char>(kp, WS_WGU), wsp<unsigned char>(kp, WS_WD), wsp<unsigned char>(kp, WS_WGU8)};
    const int gw = F.vcu * NWAVES + F.wave, NGW = F.G * NWAVES;
    constexpr int LO = (WHICH & 1) ? 0 : DecFfn<WHICH>::I_GU, HI = (WHICH & 2) ? DecFfn<WHICH>::I_GU + DecFfn<WHICH>::I_D : DecFfn<WHICH>::I_GU;
    tr_stream(F, GenStride{LO + gw, HI, NGW}, D);
}
struct DecDown8 { const float* wd; unsigned char* WD8;
    __device__ __forceinline__ void operator()(int r, TrDesc& d) const { const int kb = r / (DM / 32), nb = r % (DM / 32);
        { d.set(wd, WD8 + (size_t)(kb >> 6) * WD_PSTR, ONES.v, DM, 64 * kb, 32 * nb, 32 * nb, (64 * kb) & 4095, 4096u, pg8::F8_WSCALE); return; } } };
__device__ __forceinline__ void convert_down_queue8(Frame& F, KP kp, int a_down, int cw) {
    DecDown8 D{karg<const float>(kp, a_down), wsp<unsigned char>(kp, WS_WD)};
    tr_stream(F, GenQueue{wsp<unsigned>(kp, WS_CTL) + cw, (DFF / 64) * (DM / 32), F.lane}, D);
}
__device__ __forceinline__ int win_src_col(int nd) {
    if (nd < 2048) return nd;
    if (nd < 4096) return 6160 + (nd - 2048);
    if (nd < 6144) return 2048 + (nd - 4096);
    if (nd < 8192) return 4096 + (nd - 6144);
    if (nd < 10240) return 8208 + (nd - 8192);
    if (nd < 12288) return 10256 + (nd - 10240);
    if (nd < 16384) return 12304 + (nd - 12288);
    if (nd < 20480) return 16400 + (nd - 16384);
    return 6144;
}
struct DecMixer { const float* w_in; const float* w_o_fox; const float* w_o_diff; const float* w_out; const float* gk; unsigned char* WIN; unsigned char* WO; unsigned char* WOUT; unsigned char* WIN8;
    static constexpr int NBI = 641;
    static constexpr int I_IN = (DM / 64) * NBI, I_OF = (2048 / 64) * (DM / 32), I_OUT = (DM / 64) * (DM / 32), TOTAL = I_IN + 2 * I_OF + I_OUT;
    __device__ __forceinline__ void operator()(int it, TrDesc& d) const {
        int r = it;
        if (r < I_IN) { const int kb = r / NBI, nb = r % NBI, nd = 32 * nb;
            if (GATES_F8 && nd >= 12288 && nd < 20480) { d.set(w_in, WIN8, gk, 20496, 64 * kb, win_src_col(nd), nd - 12288, 64 * kb, 4096u, pg8::F8_WINSCALE); return; }
            { d.set(w_in, WIN, gk, 20496, 64 * kb, win_src_col(nd), nd, 64 * kb, (unsigned)DM * 2u, 0.f); return; } }
        r -= I_IN;
        if (r < I_OF) { const int kb = r / (DM / 32), nb = r % (DM / 32); { d.set(w_o_fox, WO, ONES.v, DM, 64 * kb, 32 * nb, 32 * nb, 64 * kb, 8192u, 0.f); return; } }
        r -= I_OF;
        if (r < I_OF) { const int kb = r / (DM / 32), nb = r % (DM / 32); { d.set(w_o_diff, WO, ONES.v, DM, 64 * kb, 32 * nb, 32 * nb, 2048 + 64 * kb, 8192u, 0.f); return; } }
        r -= I_OF;
        const int kb = r / (DM / 32), nb = r % (DM / 32); { d.set(w_out, WOUT, ONES.v, DM, 64 * kb, 32 * nb, 32 * nb, 64 * kb, (unsigned)DM * 2u, 0.f); return; } } };
__device__ __forceinline__ void convert_mixer_queue(Frame& F, KP kp) {
    DecMixer D{karg<const float>(kp, A_W_IN), karg<const float>(kp, A_W_O_FOX), karg<const float>(kp, A_W_O_DIFF), karg<const float>(kp, A_W_OUT), karg<const float>(kp, A_G_MIX_PRE),
               wsp<unsigned char>(kp, WS_WIN), wsp<unsigned char>(kp, WS_WO), wsp<unsigned char>(kp, WS_WOUT), wsp<unsigned char>(kp, WS_WIN8)};
    tr_stream(F, GenQueue{wsp<unsigned>(kp, WS_CTL) + CW_CQ, DecMixer::TOTAL, F.lane}, D);
}
__device__ __forceinline__ void gain_to_lds(Frame& F, const float* g, int off) {
    const GAS f32x4* s = (const GAS f32x4*)g; LAS f32x4* d = (LAS f32x4*)(F.lds + off);
    for (int i = F.tid; i < DM / 4; i += NWAVES * 64) d[i] = s[i];
}
__device__ __forceinline__ void row_load_f32(const float* p, int lane, f32x4 (&v)[16]) {
    const GAS f32x4* r = (const GAS f32x4*)p + lane;
#pragma unroll
    for (int j = 0; j < 16; ++j) v[j] = r[64 * j];
}
__device__ __forceinline__ void row_load_bf16p(const bf16* p, int lane, v2u (&w)[16]) {
    const GAS v2u* r = (const GAS v2u*)p + lane;
#pragma unroll
    for (int j = 0; j < 16; ++j) w[j] = r[64 * j];
}
__device__ __forceinline__ f32x4 unpack4(v2u w) { return (f32x4){bflo(w.x), bfhi(w.x), bflo(w.y), bfhi(w.y)}; }
__device__ __forceinline__ float row_rstd_p(const v2u (&w)[16]) {
    float s = 0.f;
#pragma unroll
    for (int j = 0; j < 16; ++j) { const f32x4 v = unpack4(w[j]); s += (v.x * v.x + v.y * v.y) + (v.z * v.z + v.w * v.w); }
    return 1.0f / sqrtf(wave_sum(s) * (1.0f / DM) + RMS_EPS);
}
__device__ __forceinline__ void row_store_f32(float* p, int lane, const f32x4 (&v)[16]) {
    GAS f32x4* r = (GAS f32x4*)p + lane;
#pragma unroll
    for (int j = 0; j < 16; ++j) r[64 * j] = v[j];
}
__device__ __forceinline__ void row_store_bf16(bf16* p, int lane, const f32x4 (&v)[16]) {
    GAS v2u* o = (GAS v2u*)p + lane;
#pragma unroll
    for (int j = 0; j < 16; ++j) { v2u w; w.x = pk2(v[j].x, v[j].y); w.y = pk2(v[j].z, v[j].w); o[64 * j] = w; }
}
__device__ __forceinline__ float row_rstd(const f32x4 (&v)[16]) {
    float s = 0.f;
#pragma unroll
    for (int j = 0; j < 16; ++j) s += (v[j].x * v[j].x + v[j].y * v[j].y) + (v[j].z * v[j].z + v[j].w * v[j].w);
    return 1.0f / sqrtf(wave_sum(s) * (1.0f / DM) + RMS_EPS);
}
__device__ __forceinline__ void row_norm_store_both(bf16* orow, unsigned char* o8row, int lane, const f32x4 (&v)[16], float rstd, const LAS f32x4* g) {
    GAS v2u* o = (GAS v2u*)orow + lane; GAS unsigned* o8 = (GAS unsigned*)o8row + lane;
#pragma unroll
    for (int j = 0; j < 16; ++j) { const f32x4 gg = g[lane + 64 * j]; const float a = v[j].x * rstd * gg.x, b = v[j].y * rstd * gg.y, c = v[j].z * rstd * gg.z, d = v[j].w * rstd * gg.w;
        v2u w; w.x = pk2(a, b); w.y = pk2(c, d); o[64 * j] = w;
        o8[64 * j] = pg8::pack_fp8x4(a * pg8::F8_USCALE, b * pg8::F8_USCALE, c * pg8::F8_USCALE, d * pg8::F8_USCALE); }
}
__device__ __forceinline__ void row_store_bf16_fp8(bf16* orow, unsigned char* o8row, int lane, const f32x4 (&v)[16]) {
    GAS v2u* o = (GAS v2u*)orow + lane; GAS unsigned* o8 = (GAS unsigned*)o8row + lane;
#pragma unroll
    for (int j = 0; j < 16; ++j) { v2u w; w.x = pk2(v[j].x, v[j].y); w.y = pk2(v[j].z, v[j].w); o[64 * j] = w;
        o8[64 * j] = pg8::pack_fp8x4(v[j].x * pg8::F8_USCALE, v[j].y * pg8::F8_USCALE, v[j].z * pg8::F8_USCALE, v[j].w * pg8::F8_USCALE); }
}
__device__ __forceinline__ void row_norm_store_bf16(bf16* orow, int lane, const f32x4 (&v)[16], float rstd, const LAS f32x4* g) {
    GAS v2u* o = (GAS v2u*)orow + lane;
#pragma unroll
    for (int j = 0; j < 16; ++j) { const f32x4 gg = g[lane + 64 * j]; v2u w; w.x = pk2(v[j].x * rstd * gg.x, v[j].y * rstd * gg.y); w.y = pk2(v[j].z * rstd * gg.z, v[j].w * rstd * gg.w); o[64 * j] = w; }
}

typedef short s_bf16x8 __attribute__((ext_vector_type(8)));
template <int NX, class Task>
__device__ __forceinline__ void skinny16(Frame& F, int K, int ntasks, const Task& T) {
    const int wid = F.wave, lane = F.lane, fr = lane & 15, fq = lane >> 4;
    LAS f32x4* part = (LAS f32x4*)(F.lds + RING_OFF);
    const int spw = K / 256;
    for (int task = blockIdx.x; task < ntasks; task += F.G) {
        const bf16* xp[NX]; const bf16* yp; int ldx, ldy; T.ptrs(task, xp, yp, ldx, ldy);
        f32x4 acc[NX];
#pragma unroll
        for (int n = 0; n < NX; ++n) acc[n] = (f32x4){0.f, 0.f, 0.f, 0.f};
        const unsigned koff = (unsigned)(wid * spw * 32 + 8 * fq);
        const unsigned ylane = (unsigned)(fr * ldy), xlane = (unsigned)(fr * ldx);
        for (int s = 0; s < spw; s += 8) {
            s_bf16x8 yv[8], xv[NX][8];
#pragma unroll
            for (int i = 0; i < 8; ++i) if (s + i < spw) { const unsigned k = koff + 32u * (unsigned)(s + i);
                yv[i] = *(const GAS s_bf16x8*)((const GAS char*)yp + (size_t)((ylane + T.ykoff(k)) * 2u));
#pragma unroll
                for (int n = 0; n < NX; ++n) xv[n][i] = *(const GAS s_bf16x8*)((const GAS char*)xp[n] + (size_t)((xlane + T.xkoff(k)) * 2u)); }
#pragma unroll
            for (int i = 0; i < 8; ++i) if (s + i < spw) {
#pragma unroll
                for (int n = 0; n < NX; ++n) acc[n] = __builtin_amdgcn_mfma_f32_16x16x32_bf16(xv[n][i], yv[i], acc[n], 0, 0, 0); }
        }
#pragma unroll
        for (int n = 0; n < NX; ++n) part[(wid * NX + n) * 64 + lane] = acc[n];
        LDS_WAIT(); __syncthreads();
        if (wid == 0) { f32x4 v[NX];
#pragma unroll
            for (int n = 0; n < NX; ++n) { v[n] = part[n * 64 + lane];
#pragma unroll
                for (int w = 1; w < NWAVES; ++w) v[n] = v[n] + part[(w * NX + n) * 64 + lane]; }
            T.store(task, fr, fq, v); }
        LDS_WAIT(); __syncthreads();
    }
}
__device__ __forceinline__ float sigm_f(float x) { return __builtin_amdgcn_rcpf(1.0f + __builtin_amdgcn_exp2f(-LOG2E * x)); }
constexpr size_t HID_PSTR = (size_t)MT * 4096;
struct SkGateUp {
    const bf16* WGU; const bf16* U; bf16* HID; const float* rs;
    __device__ __forceinline__ unsigned ykoff(unsigned k) const { return k; }
    __device__ __forceinline__ unsigned xkoff(unsigned k) const { return k; }
    __device__ __forceinline__ void ptrs(int t, const bf16* (&xp)[2], const bf16*& yp, int& ldx, int& ldy) const { xp[0] = WGU + (size_t)(256 * (t >> 3) + 16 * (t & 7)) * DM; xp[1] = xp[0] + (size_t)128 * DM; yp = U + (size_t)MR * PU; ldx = DM; ldy = PU; }
    __device__ __forceinline__ void store(int t, int fr, int fq, const f32x4 (&vv)[2]) const {
        const float r = rs[MR + fr]; const f32x4 v[2] = {vv[0] * r, vv[1] * r};
        v2u w; w.x = pk2(v[0][0] * sigm_f(v[0][0]) * v[1][0], v[0][1] * sigm_f(v[0][1]) * v[1][1]); w.y = pk2(v[0][2] * sigm_f(v[0][2]) * v[1][2], v[0][3] * sigm_f(v[0][3]) * v[1][3]);
        const int c = 16 * t + 4 * fq; *(GAS v2u*)(HID + (size_t)(c >> 12) * HID_PSTR + (size_t)(MR + fr) * 4096 + (c & 4095)) = w; }
};
struct SkDown {
    const bf16* WD; const bf16* HID; bf16* Y;
    __device__ __forceinline__ unsigned ykoff(unsigned k) const { return (k >> 12) * (unsigned)HID_PSTR + (k & 4095u); }
    __device__ __forceinline__ unsigned xkoff(unsigned k) const { return (k >> 12) * (unsigned)WD_PSTR + (k & 4095u); }
    __device__ __forceinline__ void ptrs(int t, const bf16* (&xp)[1], const bf16*& yp, int& ldx, int& ldy) const { xp[0] = WD + (size_t)(16 * t) * 4096; yp = HID + (size_t)MR * 4096; ldx = 4096; ldy = 4096; }
    __device__ __forceinline__ void store(int t, int fr, int fq, const f32x4 (&v)[1]) const {
        v2u w; w.x = pk2(v[0][0], v[0][1]); w.y = pk2(v[0][2], v[0][3]); *(GAS v2u*)(Y + (size_t)(MR + fr) * DM + 16 * t + 4 * fq) = w; }
};
struct SkWin {
    const bf16* WIN; const bf16* U; bf16* QKV; float* FLOG; const float* rs;
    __device__ __forceinline__ unsigned ykoff(unsigned k) const { return k; }
    __device__ __forceinline__ unsigned xkoff(unsigned k) const { return k; }
    __device__ __forceinline__ void ptrs(int t, const bf16* (&xp)[1], const bf16*& yp, int& ldx, int& ldy) const { ldx = DM; ldy = PU;
        if (t < 1025) { xp[0] = WIN + (size_t)20480 * DM; yp = U + (size_t)(16 * t) * PU; } else { xp[0] = WIN + (size_t)(4096 + 16 * (t - 1025)) * DM; yp = U + (size_t)MR * PU; } }
    __device__ __forceinline__ void store(int t, int fr, int fq, const f32x4 (&vv)[1]) const {
        const f32x4 v[1] = {vv[0] * rs[t < 1025 ? 16 * t + fr : MR + fr]};
        if (t < 1025) { *(GAS f32x4*)(FLOG + (size_t)(16 * t + fr) * 16 + 4 * fq) = v[0]; }
        else { v2u w; w.x = pk2(v[0][0], v[0][1]); w.y = pk2(v[0][2], v[0][3]); *(GAS v2u*)(QKV + (size_t)(MR + fr) * PQKV + 4096 + 16 * (t - 1025) + 4 * fq) = w; } }
};
constexpr int G0_OFF = 0, G1_OFF = 16384;

__device__ __forceinline__ void norm0_row(bf16* U, float* RS, int m, int lane, const f32x4 (&v)[16]) {
    const float rstd = row_rstd(v);
    row_store_bf16(U + (size_t)m * PU, lane, v);
    if (lane == 0) RS[m] = rstd;
}
__device__ __forceinline__ void phase_norm0(Frame& F, KP kp) {
    const float* x = karg<const float>(kp, A_X); const float* meta = karg<const float>(kp, A_META); bf16* U = wsp<bf16>(kp, WS_U); float* RS = wsp<float>(kp, WS_RS0);
    const int gw = F.vcu * NWAVES + F.wave, NGW = F.G * NWAVES;
    constexpr int M = MR + NMETA;
    int m = gw;
    f32x4 va[16], vb[16];
    if (m < M) row_load_f32(m < MR ? x + (size_t)m * DM : meta + (size_t)(m - MR) * DM, F.lane, va);
    while (m < M) {
        const int m1 = m + NGW;
        if (m1 < M) row_load_f32(m1 < MR ? x + (size_t)m1 * DM : meta + (size_t)(m1 - MR) * DM, F.lane, vb);
        norm0_row(U, RS, m, F.lane, va);
        if (m1 >= M) break;
        const int m2 = m1 + NGW;
        if (m2 < M) row_load_f32(m2 < MR ? x + (size_t)m2 * DM : meta + (size_t)(m2 - MR) * DM, F.lane, va);
        norm0_row(U, RS, m1, F.lane, vb);
        m = m2;
    }
    __syncthreads();
}
template <int STEP>
__device__ __forceinline__ void post_row(float* out, bf16* U, unsigned char* U8, float* RS, const LAS f32x4* g0, int m, int lane, const v2u (&y)[16], const v2u (&hp)[16]) {
    asm volatile("" ::: "memory");
    const float ry = (STEP == 2 ? 1.0f : 0.5f) * row_rstd_p(y);
    GAS f32x4* of = (GAS f32x4*)(out + (size_t)m * DM) + lane; GAS v2u* ob = (GAS v2u*)(U + (size_t)m * PU) + lane; GAS unsigned* o8 = (GAS unsigned*)(U8 + (size_t)m * DM) + lane;
    float ss = 0.f;
#pragma unroll
    for (int j = 0; j < 16; ++j) { const f32x4 gg = g0[lane + 64 * j]; const f32x4 h = unpack4(hp[j]) + unpack4(y[j]) * ry * gg;
        if (STEP == 3) of[64 * j] = h;
        else { ss += (h.x * h.x + h.y * h.y) + (h.z * h.z + h.w * h.w);
            v2u w; w.x = pk2(h.x, h.y); w.y = pk2(h.z, h.w); ob[64 * j] = w;
            if (m < MR) o8[64 * j] = pg8::pack_fp8x4(h.x * pg8::F8_USCALE, h.y * pg8::F8_USCALE, h.z * pg8::F8_USCALE, h.w * pg8::F8_USCALE); } }
    if (STEP != 3) { const float rh = 1.0f / sqrtf(wave_sum(ss) * (1.0f / DM) + RMS_EPS); if (lane == 0) RS[m] = rh; }
}
template <int STEP>
__device__ __forceinline__ void phase_post(Frame& F, KP kp) {
    float* out = karg<float>(kp, A_OUT); bf16* U = wsp<bf16>(kp, WS_U); const bf16* Y = wsp<bf16>(kp, WS_Y); unsigned char* U8 = wsp<unsigned char>(kp, WS_U8);
    float* RS = wsp<float>(kp, STEP == 1 ? WS_RS1 : WS_RS2);
    gain_to_lds(F, karg<const float>(kp, STEP == 1 ? A_G_FF1_POST : STEP == 2 ? A_G_MIX_POST : A_G_FF2_POST), G0_OFF); LDS_WAIT(); __syncthreads();
    const LAS f32x4* g0 = (const LAS f32x4*)(F.lds + G0_OFF);
    const int gw = F.vcu * NWAVES + F.wave, NGW = F.G * NWAVES;
    constexpr int M = (STEP == 1 ? MR + NMETA : MR);
    int m = gw;
    v2u ya[16], ha[16], yb[16], hb[16];
    if (m < M) { row_load_bf16p(Y + (size_t)m * DM, F.lane, ya); row_load_bf16p(U + (size_t)m * PU, F.lane, ha); }
    while (m < M) {
        const int m1 = m + NGW;
        if (m1 < M) { row_load_bf16p(Y + (size_t)m1 * DM, F.lane, yb); row_load_bf16p(U + (size_t)m1 * PU, F.lane, hb); }
        post_row<STEP>(out, U, U8, RS, g0, m, F.lane, ya, ha);
        if (m1 >= M) break;
        const int m2 = m1 + NGW;
        if (m2 < M) { row_load_bf16p(Y + (size_t)m2 * DM, F.lane, ya); row_load_bf16p(U + (size_t)m2 * PU, F.lane, ha); }
        post_row<STEP>(out, U, U8, RS, g0, m1, F.lane, yb, hb);
        m = m2;
    }
    __syncthreads();
}
__device__ __forceinline__ void phase_scan(Frame& F, KP kp) {
    const float* b_forget = karg<const float>(kp, A_B_FORGET); const float* FLOG = wsp<float>(kp, WS_FLOG); float* KB = wsp<float>(kp, WS_KB); int* JLO = wsp<int>(kp, WS_JLO);
    const int gw = F.vcu * NWAVES + F.wave, NGW = F.G * NWAVES;
    for (int task = gw; task < NB * 16; task += NGW) {
        const int b = task >> 4, h = task & 15; const float bf = b_forget[h];
        float v[65];
        const int dbase = 65 * F.lane - 64, sel = MR + 16 - b * SEQ;
#pragma unroll
        for (int k = 0; k < 65; ++k) { const int d = dbase + k; const int row = d + b * SEQ + ((d >> 31) & sel);
            v[k] = FLOG[(size_t)(unsigned)row * 16 + h]; }
        float run = 0.f;
#pragma unroll
        for (int k = 0; k < 65; ++k) { const int e = 65 * F.lane + k; const float z = v[k] + bf;
            const float ez = __builtin_amdgcn_exp2f(-LOG2E * fabsf(z));
            const float ls = fminf(z, 0.f) - 0.6931471805599453f * __builtin_amdgcn_logf(1.0f + ez);
            const unsigned keep = ~(unsigned)((e - 48) >> 31);
            run += __uint_as_float(__float_as_uint(ls) & keep); v[k] = run; }
        float incl = run;
#pragma unroll
        for (int d = 1; d < 64; d <<= 1) { const float o = __shfl_up(incl, d); if (F.lane >= d) incl += o; }
        const float off = incl - run;
        float* kb = KB + (size_t)task * EKV + 65 * F.lane;
#pragma unroll
        for (int k = 0; k < 65; ++k) kb[k] = -ISCALE * (off + v[k]);
        asm volatile("s_waitcnt vmcnt(0)" ::: "memory");
        const float* kbrow = KB + (size_t)task * EKV;
        const float tend = __hip_atomic_load(kbrow + 64 * F.lane + 63, __ATOMIC_RELAXED, __HIP_MEMORY_SCOPE_AGENT);
        int* jlo = JLO + task * 16;
        const float q0l = __hip_atomic_load(kbrow + 64 + 256 * (F.lane & 15), __ATOMIC_RELAXED, __HIP_MEMORY_SCOPE_AGENT);
#pragma unroll
        for (int qb = 0; qb < 16; ++qb) {
            const float q0 = __builtin_amdgcn_readlane(q0l, qb);
            const unsigned long long keepm = __ballot(q0 - tend < SKIP_TH * ISCALE);
            int j = keepm ? __builtin_ctzll(keepm) : 0; j = (j > 4 * qb ? 4 * qb : j) & ~1;
            if (F.lane == 0) jlo[qb] = j;
        }
    }
}
template <bool PROBE_OUT> __device__ __forceinline__ void phase_diffnorm(Frame& F, KP kp) {
    const float* lq1 = karg<const float>(kp, A_LQ1); const float* lk1 = karg<const float>(kp, A_LK1); const float* lq2 = karg<const float>(kp, A_LQ2); const float* lk2 = karg<const float>(kp, A_LK2);
    const float* g_subln = karg<const float>(kp, A_G_SUBLN); bf16* AO = wsp<bf16>(kp, WS_AO);
    const int gw = F.vcu * NWAVES + F.wave, NGW = F.G * NWAVES;
    const float s1 = wave_sum(lq1[F.lane] * lk1[F.lane] + lq1[F.lane + 64] * lk1[F.lane + 64]);
    const float s2 = wave_sum(lq2[F.lane] * lk2[F.lane] + lq2[F.lane + 64] * lk2[F.lane + 64]);
    const float lam = expf(s1) - expf(s2) + LAMBDA_INIT;
    const int h = F.lane >> 3, sub = F.lane & 7;
    float gsub[32];
#pragma unroll
    for (int i = 0; i < 32; ++i) gsub[i] = g_subln[sub * 32 + i] * (1.0f - LAMBDA_INIT);
    for (int m = gw; m < MR; m += NGW) {
        const GAS v4u* p1 = (const GAS v4u*)(AO + (size_t)m * PAO + 2048 + h * 512 + sub * 32);
        const GAS v4u* p2 = (const GAS v4u*)(AO + (size_t)m * PAO + 2048 + h * 512 + 256 + sub * 32);
        float d[32]; float ss = 0.f;
#pragma unroll
        for (int q = 0; q < 4; ++q) { const v4u a = p1[q], b = p2[q];
            const unsigned aw[4] = {a.x, a.y, a.z, a.w}, bw[4] = {b.x, b.y, b.z, b.w};
#pragma unroll
            for (int i = 0; i < 4; ++i) { const float d0 = bflo(aw[i]) - lam * bflo(bw[i]), d1 = bfhi(aw[i]) - lam * bfhi(bw[i]); d[8 * q + 2 * i] = d0; d[8 * q + 2 * i + 1] = d1; ss += d0 * d0 + d1 * d1; } }
        ss += __shfl_xor(ss, 1); ss += __shfl_xor(ss, 2); ss += __shfl_xor(ss, 4);
        const float rstd = 1.0f / sqrtf(ss * (1.0f / 256.0f) + RMS_EPS);
        asm volatile("s_waitcnt vmcnt(0)" ::: "memory");
        GAS v4u* o = PROBE_OUT ? (GAS v4u*)(wsp<bf16>(kp, WS_MG) + (size_t)m * 4096 + h * 256 + sub * 32) : (GAS v4u*)(AO + (size_t)m * PAO + 2048 + h * 256 + sub * 32);
#pragma unroll
        for (int q = 0; q < 4; ++q) { v4u w;
            w.x = pk2(d[8 * q + 0] * rstd * gsub[8 * q + 0], d[8 * q + 1] * rstd * gsub[8 * q + 1]); w.y = pk2(d[8 * q + 2] * rstd * gsub[8 * q + 2], d[8 * q + 3] * rstd * gsub[8 * q + 3]);
            w.z = pk2(d[8 * q + 4] * rstd * gsub[8 * q + 4], d[8 * q + 5] * rstd * gsub[8 * q + 5]); w.w = pk2(d[8 * q + 6] * rstd * gsub[8 * q + 6], d[8 * q + 7] * rstd * gsub[8 * q + 7]);
            o[q] = w; }
    }
}
constexpr int est_nt(int vh, int qb) {
    const int ntabs = 4 * qb + 5;
    if (vh < 16) return ntabs < 17 ? ntabs : 17;
    const int h = (vh - 16) >> 2, W = 44 << (h + 1);
    int jlo = 64 + 256 * qb - W; jlo = jlo < 0 ? 0 : jlo / 64; jlo &= ~1;
    return ntabs - jlo;
}
struct ItemTab { unsigned short v[3072]; };
constexpr ItemTab make_items() {
    ItemTab t{}; int n = 0;
    for (int key = 65; key >= 1; --key)
        for (int vh = 0; vh < 48; ++vh) for (int qb = 0; qb < 16; ++qb) if (est_nt(vh, qb) == key)
            for (int b = 0; b < 4; ++b) t.v[n++] = (unsigned short)((b << 10) | (vh << 4) | qb);
    return t;
}
__device__ const ItemTab ITEMS = make_items();
template <int PROBE> __device__ __forceinline__ att::BlockRef attn_ref(const bf16* QKV, bf16* AO, const float* KB, const int* JLO, int idx) {
    const unsigned it = ITEMS.v[idx];
    const int b = it >> 10, vh = (it >> 4) & 63, qb = it & 15;
    att::BlockRef r; r.rowb = b * SEQ; r.P0 = 64 + 256 * qb; r.probe = PROBE == 2;
    const bf16* rowq = QKV + (size_t)(b * SEQ + 256 * qb) * PQKV; bf16* rowo = AO + (size_t)(b * SEQ + 256 * qb) * PAO;
    if (vh < 16) { const int h = vh; r.Q = rowq + h * 128; r.K = QKV + 4096 + h * 128; r.V = QKV + 6144 + h * 128; r.O = rowo + h * 128;
        r.kb = KB + (size_t)(b * 16 + h) * EKV; r.sl2 = 0.f; r.jlo = JLO[(b * 16 + h) * 16 + qb]; }
    else { const int dv = vh - 16, h = dv >> 2, c = (dv >> 1) & 1, jv = dv & 1;
        r.Q = rowq + 2048 + h * 256 + c * 128; r.K = QKV + 8192 + h * 256 + c * 128; r.V = QKV + 10240 + h * 256 + jv * 128;
        r.O = rowo + 2048 + h * 512 + c * 256 + jv * 128;
        r.kb = nullptr; r.sl2 = ISCALE * __builtin_amdgcn_exp2f(-(float)(h + 1));
        const int W = (int)SKIP_TH << (h + 1);
        int j = r.P0 - W; j = j < 0 ? 0 : j >> 6; r.jlo = j & ~1; }
    return r;
}
template <int PROBE> __device__ __forceinline__ void phase_attn(Frame& F, KP kp, char* lds) {
    constexpr int TOTAL = 3072;
    const bf16* QKV = wsp<bf16>(kp, WS_BIG); bf16* AO = wsp<bf16>(kp, WS_AO); const float* KB = wsp<float>(kp, WS_KB); const int* JLO = wsp<int>(kp, WS_JLO);
    unsigned* qhead = wsp<unsigned>(kp, WS_CTL) + CW_Q + (PROBE ? 64 : 0);
    volatile int* qs = (volatile int*)(lds + att::OFF_Q);
    if (F.tid == 0) { qs[0] = (int)__hip_atomic_fetch_add(qhead, 1u, __ATOMIC_RELAXED, __HIP_MEMORY_SCOPE_AGENT); qs[1] = (int)__hip_atomic_fetch_add(qhead, 1u, __ATOMIC_RELAXED, __HIP_MEMORY_SCOPE_AGENT); }
    __syncthreads();
    int icur = __builtin_amdgcn_readfirstlane(qs[0]), inxt = __builtin_amdgcn_readfirstlane(qs[1]);
    if (icur >= TOTAL) return;
    att::BlockRef cur = attn_ref<PROBE>(QKV, AO, KB, JLO, icur);
    att::Seam S;
    att::attn_prime(F.tid, cur, lds, S);
    for (;;) {
        unsigned claim = 0u; if (F.tid == 0) claim = __hip_atomic_fetch_add(qhead, 1u, __ATOMIC_RELAXED, __HIP_MEMORY_SCOPE_AGENT);
        const bool last = inxt >= TOTAL;
        const att::BlockRef nxt = last ? cur : attn_ref<PROBE>(QKV, AO, KB, JLO, inxt);
        att::attn_block(F.tid, cur, nxt, lds, S);
        if (last) break;
        if (F.tid == 0) qs[0] = (int)claim;
        __syncthreads();
        cur = nxt; inxt = __builtin_amdgcn_readfirstlane(qs[0]);
    }
}

#ifndef Y_NT
#define Y_NT 1
#endif
#ifndef PROBE_NT
#define PROBE_NT 1
#endif
#ifndef PROBE_ROWS
#define PROBE_ROWS 4096
#endif
#ifndef PROBE_DUP
#define PROBE_DUP 0
#endif
#ifndef PH
#define PH 0xFFFFF
#endif
#ifndef DUP
#define DUP 0
#endif
#ifndef DUP_ROWS
#define DUP_ROWS 4096
#endif
#ifndef ATT_PROBE
#define ATT_PROBE 1
#endif
#ifndef WGM_DOWN
#define WGM_DOWN 2
#endif
#ifndef ALIGN_SWIGLU
#define ALIGN_SWIGLU 1
#endif
#ifndef FFN2_F8
#define FFN2_F8 1
#endif
#ifndef TR_BIG
#define TR_BIG 0
#endif
#ifndef WGM_BIG
#define WGM_BIG 8
#endif
struct Args { const float* in[24]; float* out; unsigned char* ws; };
__global__ void __launch_bounds__(NWAVES * 64, 2) mega_fwd(Args args) {
    extern __shared__ __attribute__((aligned(16))) unsigned char lds[];
    Frame F;
    F.lds = (LAS unsigned char*)lds;
    F.wave = __builtin_amdgcn_readfirstlane((int)threadIdx.x >> 6);
    F.G = gridDim.x; { const int bx = blockIdx.x; F.vcu = (F.G % 8 == 0) ? (bx % 8) * (F.G / 8) + bx / 8 : bx; }
    frame_refresh(F);
    for (int u = F.tid; u < (LDS_BYTES - LDSCTL_OFF) / 4; u += NWAVES * 64) ((LAS unsigned*)(F.lds + LDSCTL_OFF))[u] = 0u;
    __syncthreads();
    (void)xcd_barrier_post(wsp<unsigned>(kargs(), WS_CTL) + CW_BAR, (volatile LAS unsigned*)(F.lds + MISC_OFF) + 8, F.tid);
    if (args.ws == nullptr) return;
#define GRID_BAR() do { frame_refresh(F); XcdBarrier b_; b_.bar = wsp<unsigned>(kargs(), WS_CTL) + CW_BAR; b_.x = xb_xcc_id(); b_.st = (volatile LAS unsigned*)(F.lds + MISC_OFF) + 8; xcd_barrier(b_, F.tid); } while (0)
#define GEMM_PHASE(EPI) do { frame_refresh(F); pg8::gemm_phase<EPI, pg8::StaticOrder, true>(F.lds + RING_OFF, F.tid, g, S, E); } while (0)
#define GEMM_PHASE_SW(EPI) do { frame_refresh(F); pg8::gemm_phase<EPI, pg8::StaticOrder, (ALIGN_SWIGLU != 0)>(F.lds + RING_OFF, F.tid, g, S, E); } while (0)

    { KP kp = kargs(); frame_refresh(F);
      convert_ffn<3>(F, kp, A_W_GATE1, A_W_UP1, A_W_DOWN1, A_G_FF1_PRE);
      __syncthreads();
      phase_norm0(F, kp); }
#if PROBE_DUP & 1
    GRID_BAR();
    { KP kp = kargs(); frame_refresh(F);
      convert_ffn<3>(F, kp, A_W_GATE1, A_W_UP1, A_W_DOWN1, A_G_FF1_PRE);
      __syncthreads();
      phase_norm0(F, kp); }
#endif
    GRID_BAR();
    { KP kp = kargs(); frame_refresh(F); SkGateUp T{wsp<bf16>(kp, WS_WGU), wsp<bf16>(kp, WS_U), wsp<bf16>(kp, WS_BIG), wsp<float>(kp, WS_RS0)}; skinny16<2>(F, DM, DFF / 16, T); }
    { KP kp = kargs(); pg8::Gemm g{wsp<bf16>(kp, WS_U), wsp<bf16>(kp, WS_WGU), MR, NGU, DM, PU, DM}; pg8::StaticOrder S; S.init(MR, NGU, F.G, (int)blockIdx.x, WGM_BIG, TR_BIG);
      pg8::EpiSwiGLU E{wsp<bf16>(kp, WS_BIG), HID_PSTR, wsp<float>(kp, WS_RS0)}; GEMM_PHASE_SW(pg8::EpiSwiGLU); }
    { KP kp = kargs(); frame_refresh(F); convert_mixer_queue(F, kp); __syncthreads(); }
    GRID_BAR();
    { KP kp = kargs(); frame_refresh(F); SkDown T{wsp<bf16>(kp, WS_WD), wsp<bf16>(kp, WS_BIG), wsp<bf16>(kp, WS_Y)}; skinny16<1>(F, DFF, DM / 16, T); }
    { KP kp = kargs(); pg8::Gemm g{wsp<bf16>(kp, WS_BIG), wsp<bf16>(kp, WS_WD), MR, DM, DFF, 4096, 4096, 6, 6, HID_PSTR * 2, WD_PSTR * 2}; pg8::StaticOrder S; S.init(MR, DM, F.G, (int)blockIdx.x, WGM_DOWN);
      pg8::EpiPlain E{wsp<bf16>(kp, WS_Y), DM, 1.0f, Y_NT}; GEMM_PHASE(pg8::EpiPlain); }
    GRID_BAR();
    { KP kp = kargs(); frame_refresh(F); phase_post<1>(F, kp); }
    GRID_BAR();
    { KP kp = kargs(); frame_refresh(F); SkWin T{wsp<bf16>(kp, WS_WIN), wsp<bf16>(kp, WS_U), wsp<bf16>(kp, WS_BIG), wsp<float>(kp, WS_FLOG), wsp<float>(kp, WS_RS1)}; skinny16<1>(F, DM, 1025 + 512, T); }
    { KP kp = kargs(); pg8::Gemm g{wsp<bf16>(kp, WS_U), wsp<bf16>(kp, WS_WIN), MR, 12288, DM, PU, DM}; pg8::StaticOrder S; S.init(MR, 12288, F.G, (int)blockIdx.x, WGM_BIG, TR_BIG);
      pg8::EpiWin E{wsp<bf16>(kp, WS_BIG), wsp<bf16>(kp, WS_GATES), wsp<float>(kp, WS_RS1)}; GEMM_PHASE(pg8::EpiWin); }
    { KP kp = kargs(); pg8::Gemm g{wsp<bf16>(kp, WS_U8), wsp<bf16>(kp, WS_WIN8), MR, 8192, DM / 2, 2048, 2048}; pg8::StaticOrder S; S.init(MR, 8192, F.G, (int)blockIdx.x, WGM_BIG, TR_BIG);
      pg8::EpiPlainRS E{wsp<bf16>(kp, WS_GATES), 8192, 1.0f / (pg8::F8_USCALE * pg8::F8_WINSCALE), wsp<float>(kp, WS_RS1)};
      frame_refresh(F); pg8::gemm_phase<pg8::EpiPlainRS, pg8::StaticOrder, true, pg8::MidNone, true>(F.lds + RING_OFF, F.tid, g, S, E); }
    GRID_BAR();
    { KP kp = kargs(); frame_refresh(F); phase_scan(F, kp); }
    GRID_BAR();
#if PROBE_DUP & 4
    { KP kp = kargs(); frame_refresh(F); phase_attn<1>(F, kp, (char*)lds + RING_OFF); }
    GRID_BAR();
#endif
    { KP kp = kargs(); frame_refresh(F); phase_attn<0>(F, kp, (char*)lds + RING_OFF); }
    GRID_BAR();
    { KP kp = kargs(); frame_refresh(F); phase_diffnorm<false>(F, kp); }
    GRID_BAR();
    { KP kp = kargs(); pg8::Gemm g{wsp<bf16>(kp, WS_AO), wsp<bf16>(kp, WS_WO), MR, DM, 4096, PAO, 4096}; pg8::StaticOrder S; S.init(MR, DM, F.G, (int)blockIdx.x);
      pg8::EpiGateOut E{wsp<bf16>(kp, WS_MG), wsp<bf16>(kp, WS_GATES)}; pg8::MidGate MH{32, wsp<bf16>(kp, WS_GATES)};
      frame_refresh(F); pg8::gemm_phase<pg8::EpiGateOut, pg8::StaticOrder, true, pg8::MidGate>(F.lds + RING_OFF, F.tid, g, S, E, MH); }
    GRID_BAR();
    { KP kp = kargs(); pg8::Gemm g{wsp<bf16>(kp, WS_MG), wsp<bf16>(kp, WS_WOUT), MR, DM, DM, DM, DM}; pg8::StaticOrder S; S.init(MR, DM, F.G, (int)blockIdx.x);
      pg8::EpiPlain E{wsp<bf16>(kp, WS_Y), DM, 1.0f, Y_NT}; GEMM_PHASE(pg8::EpiPlain); }
#if PROBE_DUP & 8
    GRID_BAR();
    { KP kp = kargs(); pg8::Gemm g{wsp<bf16>(kp, WS_MG), wsp<bf16>(kp, WS_WOUT), PROBE_ROWS, DM, DM, DM, DM}; pg8::StaticOrder S; S.init(PROBE_ROWS, DM, F.G, (int)blockIdx.x);
      pg8::EpiPlain E{wsp<bf16>(kp, WS_Y), DM, 1.0f, PROBE_NT}; GEMM_PHASE(pg8::EpiPlain); }
#endif
    { KP kp = kargs(); frame_refresh(F); convert_ffn<5>(F, kp, A_W_GATE2, A_W_UP2, A_W_DOWN2, A_G_FF2_PRE); __syncthreads(); }
    GRID_BAR();
    { KP kp = kargs(); frame_refresh(F); phase_post<2>(F, kp); }
    GRID_BAR();
    { KP kp = kargs(); pg8::Gemm g{wsp<bf16>(kp, WS_U), wsp<bf16>(kp, WS_WGU), MR, GU8_ROW0, DM, PU, DM}; pg8::StaticOrder S; S.init(MR, GU8_ROW0, F.G, (int)blockIdx.x, WGM_BIG, TR_BIG);
      pg8::EpiSwiGLU8 E{wsp<unsigned char>(kp, WS_BIG), (size_t)MT * 4096, wsp<float>(kp, WS_RS2)}; GEMM_PHASE_SW(pg8::EpiSwiGLU8); }
    { KP kp = kargs(); pg8::Gemm g{wsp<bf16>(kp, WS_U8), wsp<bf16>(kp, WS_WGU8), MR, GU8_TILES * 256, DM / 2, 2048, 2048}; pg8::StaticOrder S; S.init(MR, GU8_TILES * 256, F.G, (int)blockIdx.x, WGM_BIG, TR_BIG);
      pg8::EpiSwiGLU8 E{wsp<unsigned char>(kp, WS_BIG), (size_t)MT * 4096, wsp<float>(kp, WS_RS2), 86 - GU8_TILES, 1.0f / (pg8::F8_USCALE * pg8::F8_WINSCALE)};
      frame_refresh(F); pg8::gemm_phase<pg8::EpiSwiGLU8, pg8::StaticOrder, true, pg8::MidNone, true>(F.lds + RING_OFF, F.tid, g, S, E); }
    { KP kp = kargs(); frame_refresh(F); convert_down_queue8(F, kp, A_W_DOWN2, CW_CQ2); __syncthreads(); }
    GRID_BAR();
    { KP kp = kargs(); pg8::Gemm g{wsp<bf16>(kp, WS_BIG), wsp<bf16>(kp, WS_WD), MR, DM, DFF / 2, 2048, 2048, 5, 5, (size_t)MT * 4096, WD_PSTR}; pg8::StaticOrder S; S.init(MR, DM, F.G, (int)blockIdx.x, WGM_DOWN);
      pg8::EpiPlain E{wsp<bf16>(kp, WS_Y), DM, 1.0f / (pg8::F8_HSCALE * pg8::F8_WSCALE), Y_NT};
      frame_refresh(F); pg8::gemm_phase<pg8::EpiPlain, pg8::StaticOrder, true, pg8::MidNone, true>(F.lds + RING_OFF, F.tid, g, S, E); }
    GRID_BAR();
    { KP kp = kargs(); frame_refresh(F); phase_post<3>(F, kp); }
#if PROBE_DUP & 2
    GRID_BAR();
    { KP kp = kargs(); frame_refresh(F); phase_post<3>(F, kp); }
#endif
#undef GRID_BAR
#undef GEMM_PHASE
#undef GEMM_PHASE_SW
}

extern "C" void kernel_launch(void* const* d_in, const int* in_sizes, int n_in, void* d_out, int out_size, void* d_ws, size_t ws_size, hipStream_t stream) {
    static int grid = 0;
    if (grid == 0) {
        if (n_in != 24 || in_sizes[0] != MR * DM || out_size != MR * DM || ws_size < WS_END) { fprintf(stderr, "kernel_launch: shape/workspace mismatch (n_in %d, in0 %d, out %d, ws %zu, need %zu)\n", n_in, n_in > 0 ? in_sizes[0] : -1, out_size, ws_size, (size_t)WS_END); grid = -1; return; }
        int dev = 0, cus = 0;
        if (hipGetDevice(&dev) != hipSuccess || hipDeviceGetAttribute(&cus, hipDeviceAttributeMultiprocessorCount, dev) != hipSuccess) { grid = -1; return; }
        if (hipFuncSetAttribute((const void*)mega_fwd, hipFuncAttributeMaxDynamicSharedMemorySize, LDS_BYTES) != hipSuccess) { fprintf(stderr, "kernel_launch: hipFuncSetAttribute failed\n"); grid = -1; return; }
        int per_cu = 0;
        if (hipOccupancyMaxActiveBlocksPerMultiprocessor(&per_cu, (const void*)mega_fwd, NWAVES * 64, LDS_BYTES) != hipSuccess || per_cu < 1) { fprintf(stderr, "kernel_launch: occupancy query reports %d\n", per_cu); }
        (void)hipGetLastError();
        grid = cus;
    }
    if (grid < 0) return;
    if (hipMemsetAsync((char*)d_ws + WS_CTL, 0, CTL_ZERO_BYTES, stream) != hipSuccess) return;
    Args a{};
    for (int i = 0; i < 24; ++i) a.in[i] = (const float*)d_in[i];
    a.out = (float*)d_out; a.ws = (unsigned char*)d_ws;
    hipLaunchKernelGGL(mega_fwd, dim3(grid), dim3(NWAVES * 64), LDS_BYTES, stream, a);
}
```

```cpp
#include <hip/hip_runtime.h>
#include <cstdio>
#include <cstdint>
#ifndef EPI_NT
#define EPI_NT 1
#endif
#ifndef PG8_PRIO
#define PG8_PRIO 3
#endif
namespace pg8 {
#define PG8_LAS __attribute__((address_space(3)))
typedef unsigned short bf16_t;
typedef short bf16x8 __attribute__((ext_vector_type(8)));
typedef float f32x4 __attribute__((ext_vector_type(4)));
typedef unsigned u32x4 __attribute__((ext_vector_type(4)));
constexpr int BM = 256, BK = 64, HALF = 128, HTB = HALF * BK * 2  , STAGE_BYTES = 8 * HTB, NXCD = 8, WGM = 8;

__host__ __device__ __forceinline__ int lds_byte(int r, int c) { const int st = (r >> 4) * 2 + (c >> 5), rr = r & 15, cc = c & 31, ob = rr * 64 + cc * 2; return st * 1024 + (ob ^ (((ob >> 9) & 1) << 5)); }
__host__ __device__ __forceinline__ void stage_rc(int b, int& R, int& C) { const int st = b / 1024, sb = b % 1024, swz = sb ^ (((sb >> 9) & 1) << 5); R = (st >> 1) * 16 + swz / 64; C = (st & 1) * 32 + (swz % 64) / 2; }
__host__ __device__ __forceinline__ int perm32(int rho) { const int n = rho >> 4, i = rho & 15; return 8 * (i >> 2) + 4 * n + (i & 3); }

struct Unit { int pm, pn; };
struct Gemm { const bf16_t* A; const bf16_t* Bt; int M, N, K, lda, ldb; int pshA = 30, pshB = 30; size_t pstrA = 0, pstrB = 0; };

struct StaticOrder {
    int nM, nN, nwg, G, c, wgm, tr;
    __host__ __device__ void init(int M, int N, int G_, int c_, int wgm_ = WGM, int tr_ = 0) { nM = M / BM; nN = N / BM; nwg = nM * nN; G = G_; c = c_; wgm = wgm_; tr = tr_; }
    __host__ __device__ bool next(int i, Unit& u) const {
        const long L = (long)i * G + c; if (L >= nwg) return false;
        int wgid = (int)L; { const int q = nwg / NXCD, r = nwg % NXCD, xcd = wgid % NXCD, off = wgid / NXCD; wgid = (xcd < r ? xcd * (q + 1) : r * (q + 1) + (xcd - r) * q) + off; }
        const int nA = tr ? nN : nM, nB = tr ? nM : nN;
        const int nig = wgm * nB, gid = wgid / nig, fm = gid * wgm, gsz = (nA - fm) < wgm ? (nA - fm) : wgm;
        const int a = fm + ((wgid % nig) % gsz), b = (wgid % nig) / gsz;
        u.pm = tr ? b : a; u.pn = tr ? a : b; return true;
    }
    __device__ __forceinline__ void a_ready(const Unit&) const {}
    __device__ __forceinline__ void done(const Unit&) const {}
};

__device__ __forceinline__ unsigned cvt_pk_bf16(float lo, float hi) { unsigned r; asm volatile("v_cvt_pk_bf16_f32 %0, %1, %2" : "=v"(r) : "v"(lo), "v"(hi)); return r; }
__device__ __forceinline__ float sigm(float x) { return __builtin_amdgcn_rcpf(1.0f + __builtin_amdgcn_exp2f(-1.4426950408889634f * x)); }
__device__ __forceinline__ float bf_lo(unsigned w) { return __uint_as_float(w << 16); }
__device__ __forceinline__ float bf_hi(unsigned w) { return __uint_as_float(w & 0xffff0000u); }

struct EpiPlain {
    static constexpr bool PERM = true, AFTER_DRAIN = false, ROWSCALE = false;
    bf16_t* O; int ldc; float scale = 1.0f; int nt = 0;
    __device__ __forceinline__ void operator()(const f32x4 (&acc)[2][2][4][2], const Unit& u, int wr, int wc, int fr, int fq, const PG8_LAS float*) const {
        const int row0 = u.pm * BM + wr * 64 + fr; const int col0 = u.pn * BM + wc * 32 + 8 * fq;
#pragma unroll
        for (int ai = 0; ai < 2; ++ai)
#pragma unroll
            for (int m = 0; m < 4; ++m) { bf16_t* rowp = O + (size_t)(row0 + ai * HALF + m * 16) * ldc + col0;
#pragma unroll
                for (int bj = 0; bj < 2; ++bj) { const f32x4 v0 = acc[ai][bj][m][0] * scale, v1 = acc[ai][bj][m][1] * scale;
                    u32x4 w; w.x = cvt_pk_bf16(v0[0], v0[1]); w.y = cvt_pk_bf16(v0[2], v0[3]); w.z = cvt_pk_bf16(v1[0], v1[1]); w.w = cvt_pk_bf16(v1[2], v1[3]);
                    if (nt == 1) __builtin_nontemporal_store(w, (u32x4*)(rowp + bj * HALF));
                    else if (nt == 2) asm volatile("global_store_dwordx4 %0, %1, off sc1\n\ts_nop 2" :: "v"(rowp + bj * HALF), "v"(w) : "memory");
                    else if (nt == 3) asm volatile("global_store_dwordx4 %0, %1, off sc0 sc1\n\ts_nop 2" :: "v"(rowp + bj * HALF), "v"(w) : "memory");
                    else *(u32x4*)(rowp + bj * HALF) = w; } }
    }
};
struct EpiPlainRS {
    static constexpr bool PERM = true, AFTER_DRAIN = false, ROWSCALE = true;
    bf16_t* O; int ldc; float scale; const float* rs;
    __device__ __forceinline__ void operator()(const f32x4 (&acc)[2][2][4][2], const Unit& u, int wr, int wc, int fr, int fq, const PG8_LAS float* rsl) const {
        const int row0 = u.pm * BM + wr * 64 + fr; const int col0 = u.pn * BM + wc * 32 + 8 * fq;
#pragma unroll
        for (int ai = 0; ai < 2; ++ai)
#pragma unroll
            for (int m = 0; m < 4; ++m) { bf16_t* rowp = O + (size_t)(row0 + ai * HALF + m * 16) * ldc + col0; const float r = rsl[wr * 64 + ai * HALF + m * 16 + fr] * scale;
#pragma unroll
                for (int bj = 0; bj < 2; ++bj) { const f32x4 v0 = acc[ai][bj][m][0] * r, v1 = acc[ai][bj][m][1] * r;
                    u32x4 w; w.x = cvt_pk_bf16(v0[0], v0[1]); w.y = cvt_pk_bf16(v0[2], v0[3]); w.z = cvt_pk_bf16(v1[0], v1[1]); w.w = cvt_pk_bf16(v1[2], v1[3]);
                    *(u32x4*)(rowp + bj * HALF) = w; } }
    }
};
struct EpiSwiGLU {
    static constexpr bool PERM = true, AFTER_DRAIN = false, ROWSCALE = true;
    bf16_t* O; size_t pstr; const float* rs;
    __device__ __forceinline__ void operator()(const f32x4 (&acc)[2][2][4][2], const Unit& u, int wr, int wc, int fr, int fq, const PG8_LAS float* rsl) const {
        const int row0 = u.pm * BM + wr * 64 + fr; const int col0 = ((u.pn * HALF) & 4095) + wc * 32 + 8 * fq; bf16_t* Op = O + (size_t)(u.pn >> 5) * pstr;
#pragma unroll
        for (int ai = 0; ai < 2; ++ai)
#pragma unroll
            for (int m = 0; m < 4; ++m) { bf16_t* rowp = Op + (size_t)(row0 + ai * HALF + m * 16) * 4096 + col0; const float r = rsl[wr * 64 + ai * HALF + m * 16 + fr];
                const f32x4 g0 = acc[ai][0][m][0] * r, g1 = acc[ai][0][m][1] * r, u0 = acc[ai][1][m][0] * r, u1 = acc[ai][1][m][1] * r;
                f32x4 h0, h1;
#pragma unroll
                for (int i = 0; i < 4; ++i) { h0[i] = g0[i] * sigm(g0[i]) * u0[i]; h1[i] = g1[i] * sigm(g1[i]) * u1[i]; }
                u32x4 w; w.x = cvt_pk_bf16(h0[0], h0[1]); w.y = cvt_pk_bf16(h0[2], h0[3]); w.z = cvt_pk_bf16(h1[0], h1[1]); w.w = cvt_pk_bf16(h1[2], h1[3]);
                if (EPI_NT) __builtin_nontemporal_store(w, (u32x4*)rowp); else *(u32x4*)rowp = w; }
    }
};
constexpr float F8_HSCALE = 8.0f, F8_WSCALE = 1024.0f, F8_MAX = 416.0f, F8_USCALE = 16.0f, F8_WINSCALE = 512.0f;
__device__ __forceinline__ unsigned pack_fp8x4(float a, float b, float c, float d) {
    a = __builtin_fminf(__builtin_fmaxf(a, -F8_MAX), F8_MAX); b = __builtin_fminf(__builtin_fmaxf(b, -F8_MAX), F8_MAX); c = __builtin_fminf(__builtin_fmaxf(c, -F8_MAX), F8_MAX); d = __builtin_fminf(__builtin_fmaxf(d, -F8_MAX), F8_MAX);
    int w = 0; w = __builtin_amdgcn_cvt_pk_fp8_f32(a, b, w, false); w = __builtin_amdgcn_cvt_pk_fp8_f32(c, d, w, true); return (unsigned)w; }
struct EpiSwiGLU8 {
    static constexpr bool PERM = true, AFTER_DRAIN = false, ROWSCALE = true;
    unsigned char* O; size_t pstr; const float* rs; int pn_off = 0; float ascale = 1.0f;
    __device__ __forceinline__ void operator()(const f32x4 (&acc)[2][2][4][2], const Unit& u, int wr, int wc, int fr, int fq, const PG8_LAS float* rsl) const {
        const int pn = u.pn + pn_off;
        const int row0 = u.pm * BM + wr * 64 + fr; const int col0 = ((pn * HALF) & 4095) + wc * 32 + 8 * fq; unsigned char* Op = O + (size_t)(pn >> 5) * pstr;
#pragma unroll
        for (int ai = 0; ai < 2; ++ai)
#pragma unroll
            for (int m = 0; m < 4; ++m) { unsigned char* rowp = Op + (size_t)(row0 + ai * HALF + m * 16) * 4096 + col0; const float r = rsl[wr * 64 + ai * HALF + m * 16 + fr] * ascale;
                const f32x4 g0 = acc[ai][0][m][0] * r, g1 = acc[ai][0][m][1] * r, u0 = acc[ai][1][m][0] * r, u1 = acc[ai][1][m][1] * r;
                f32x4 h0, h1;
#pragma unroll
                for (int i = 0; i < 4; ++i) { h0[i] = g0[i] * sigm(g0[i]) * u0[i] * F8_HSCALE; h1[i] = g1[i] * sigm(g1[i]) * u1[i] * F8_HSCALE; }
                typedef unsigned u32x2 __attribute__((ext_vector_type(2)));
                u32x2 w; w.x = pack_fp8x4(h0[0], h0[1], h0[2], h0[3]); w.y = pack_fp8x4(h1[0], h1[1], h1[2], h1[3]);
                *(u32x2*)rowp = w; }
    }
};
struct EpiWin {
    static constexpr bool PERM = true, AFTER_DRAIN = false, ROWSCALE = true;
    bf16_t* QKV; bf16_t* GATES; const float* rs;
    __device__ __forceinline__ void operator()(const f32x4 (&acc)[2][2][4][2], const Unit& u, int wr, int wc, int fr, int fq, const PG8_LAS float* rsl) const {
        const int row0 = u.pm * BM + wr * 64 + fr;
        bf16_t* base; int ldc, colt;
        if (u.pn < 48) { base = QKV; ldc = 12288; colt = u.pn * BM; } else { base = GATES; ldc = 8192; colt = (u.pn - 48) * BM; }
        const int col0 = colt + wc * 32 + 8 * fq;
#pragma unroll
        for (int ai = 0; ai < 2; ++ai)
#pragma unroll
            for (int m = 0; m < 4; ++m) { bf16_t* rowp = base + (size_t)(row0 + ai * HALF + m * 16) * ldc + col0; const float r = rsl[wr * 64 + ai * HALF + m * 16 + fr];
#pragma unroll
                for (int bj = 0; bj < 2; ++bj) { const f32x4 v0 = acc[ai][bj][m][0] * r, v1 = acc[ai][bj][m][1] * r;
                    u32x4 w; w.x = cvt_pk_bf16(v0[0], v0[1]); w.y = cvt_pk_bf16(v0[2], v0[3]); w.z = cvt_pk_bf16(v1[0], v1[1]); w.w = cvt_pk_bf16(v1[2], v1[3]);
                    if (EPI_NT) __builtin_nontemporal_store(w, (u32x4*)(rowp + bj * HALF)); else *(u32x4*)(rowp + bj * HALF) = w; } }
    }
};
struct MidNone { static constexpr bool ON = false; int tmid; __device__ __forceinline__ void operator()(f32x4 (&)[2][2][4][2], const Unit&, int, int, int, int) const {} };
struct MidGate {
    static constexpr bool ON = true;
    int tmid; const bf16_t* G;
    __device__ __forceinline__ void operator()(f32x4 (&acc)[2][2][4][2], const Unit& u, int wr, int wc, int fr, int fq) const {
        asm volatile("" : "+v"(fr), "+v"(fq));
        const int row0 = u.pm * BM + wr * 64 + fr; const int col0 = u.pn * BM + wc * 32 + 8 * fq;
#pragma unroll
        for (int ai = 0; ai < 2; ++ai)
#pragma unroll
            for (int m = 0; m < 4; ++m) { const bf16_t* grow = G + (size_t)(row0 + ai * HALF + m * 16) * 8192 + col0;
#pragma unroll
                for (int bj = 0; bj < 2; ++bj) {
                    const u32x4 gf = *(const u32x4*)(grow + bj * HALF), gd = *(const u32x4*)(grow + 4096 + bj * HALF);
                    const unsigned fw[4] = {gf.x, gf.y, gf.z, gf.w}, dw[4] = {gd.x, gd.y, gd.z, gd.w};
#pragma unroll
                    for (int q = 0; q < 4; ++q) {
                        const float r0 = (1.0f + __builtin_amdgcn_exp2f(-1.4426950408889634f * bf_lo(dw[q]))) * __builtin_amdgcn_rcpf(1.0f + __builtin_amdgcn_exp2f(-1.4426950408889634f * bf_lo(fw[q])));
                        const float r1 = (1.0f + __builtin_amdgcn_exp2f(-1.4426950408889634f * bf_hi(dw[q]))) * __builtin_amdgcn_rcpf(1.0f + __builtin_amdgcn_exp2f(-1.4426950408889634f * bf_hi(fw[q])));
                        acc[ai][bj][m][q >> 1][2 * (q & 1)] *= r0; acc[ai][bj][m][q >> 1][2 * (q & 1) + 1] *= r1; } }
                asm volatile("" : "+v"(acc[ai][0][m][0]), "+v"(acc[ai][0][m][1]), "+v"(acc[ai][1][m][0]), "+v"(acc[ai][1][m][1]) :: "memory"); }
    }
};
struct EpiGateOut {
    static constexpr bool PERM = true, AFTER_DRAIN = false, ROWSCALE = false;
    bf16_t* O; const bf16_t* G;
    __device__ __forceinline__ void operator()(const f32x4 (&acc)[2][2][4][2], const Unit& u, int wr, int wc, int fr, int fq, const PG8_LAS float*) const {
        const int row0 = u.pm * BM + wr * 64 + fr; const int col0 = u.pn * BM + wc * 32 + 8 * fq;
#pragma unroll
        for (int ai = 0; ai < 2; ++ai)
#pragma unroll
            for (int m = 0; m < 4; ++m) { const size_t row = (size_t)(row0 + ai * HALF + m * 16);
#pragma unroll
                for (int bj = 0; bj < 2; ++bj) { const int col = col0 + bj * HALF;
                    const u32x4 gw = *(const u32x4*)(G + row * 8192 + 4096 + col);
                    f32x4 v0 = acc[ai][bj][m][0], v1 = acc[ai][bj][m][1];
                    v0[0] *= sigm(bf_lo(gw.x)); v0[1] *= sigm(bf_hi(gw.x)); v0[2] *= sigm(bf_lo(gw.y)); v0[3] *= sigm(bf_hi(gw.y));
                    v1[0] *= sigm(bf_lo(gw.z)); v1[1] *= sigm(bf_hi(gw.z)); v1[2] *= sigm(bf_lo(gw.w)); v1[3] *= sigm(bf_hi(gw.w));
                    u32x4 w; w.x = cvt_pk_bf16(v0[0], v0[1]); w.y = cvt_pk_bf16(v0[2], v0[3]); w.z = cvt_pk_bf16(v1[0], v1[1]); w.w = cvt_pk_bf16(v1[2], v1[3]);
                    *(u32x4*)(O + row * 4096 + col) = w; } }
    }
};

typedef int i32x4 __attribute__((ext_vector_type(4)));
typedef int i32x8 __attribute__((ext_vector_type(8)));
__device__ __forceinline__ i32x8 cat8(bf16x8 a, bf16x8 b) { const i32x4 x = __builtin_bit_cast(i32x4, a), y = __builtin_bit_cast(i32x4, b); return __builtin_shufflevector(x, y, 0, 1, 2, 3, 4, 5, 6, 7); }
template <class Epi, class Sched, bool ALIGN_EPI, class Mid = MidNone, bool F8 = false>
__device__ __forceinline__ void gemm_phase(PG8_LAS unsigned char* lds, const int tid, const Gemm g, const Sched& S, const Epi& E, const Mid MH = Mid{}) {
    const int wid = __builtin_amdgcn_readfirstlane(tid >> 6), lane = tid & 63, wr = wid >> 2, wc = wid & 3, fr = lane & 15, fq = lane >> 4;
    const int K = g.K, nt = K / BK;
    unsigned voffA[2], voffB[2];
#pragma unroll
    for (int i = 0; i < 2; ++i) { int R, C; stage_rc(tid * 16 + i * 8192, R, C); const int Rb = Epi::PERM ? ((R & ~31) + perm32(R & 31)) : R;
        voffA[i] = (unsigned)(R * g.lda + C) * 2u; voffB[i] = (unsigned)(Rb * g.ldb + C) * 2u; }
    const size_t kstep = (size_t)(BK * 2);
    const size_t hstepA = (size_t)HALF * g.lda * 2, hstepB = (size_t)HALF * g.ldb * 2;
    const size_t tstepA = 2 * hstepA, tstepB = 2 * hstepB;
    const unsigned ldsw = (unsigned)wid * 1024u;
    const int aoff = lds_byte(wr * 64 + fr, fq * 8), boff = lds_byte(wc * 32 + fr, fq * 8);
#define PG8_SA(b, h) (((b) * 2 + (h)) * HTB)
#define PG8_SB(b, h) ((4 + (b) * 2 + (h)) * HTB)
#define PG8_STAGE(bufoff, gbase, voff) do { _Pragma("unroll") for (int _i = 0; _i < 2; ++_i) \
        __builtin_amdgcn_global_load_lds((const unsigned*)((const char*)(gbase) + (voff)[_i]), (PG8_LAS unsigned*)(lds + (bufoff) + ldsw + _i * 8192), 16, 0, 0); } while (0)
#define PG8_LDA(dst, b, h) do { _Pragma("unroll") for (int m = 0; m < 4; ++m) _Pragma("unroll") for (int k = 0; k < 2; ++k) dst[m][k] = *(const PG8_LAS bf16x8*)(lds + PG8_SA(b, h) + aoff + m * 2048 + k * 1024); } while (0)
#define PG8_LDB(dst, b, h) do { _Pragma("unroll") for (int n = 0; n < 2; ++n) _Pragma("unroll") for (int k = 0; k < 2; ++k) dst[n][k] = *(const PG8_LAS bf16x8*)(lds + PG8_SB(b, h) + boff + n * 2048 + k * 1024); } while (0)
#define PG8_MMA(ai, bj, At, Bt) do { if (PG8_PRIO) __builtin_amdgcn_s_setprio(PG8_PRIO); _Pragma("unroll") for (int m = 0; m < 4; ++m) _Pragma("unroll") for (int n = 0; n < 2; ++n) { \
        if constexpr (F8) { asm volatile("v_mfma_scale_f32_16x16x128_f8f6f4 %0, %1, %2, %0, %3, %3 op_sel_hi:[0,0,0]" : "+v"(acc[ai][bj][m][n]) : "v"(cat8(Bt[n][0], Bt[n][1])), "v"(cat8(At[m][0], At[m][1])), "v"(f8one)); }   \
        else { _Pragma("unroll") for (int k = 0; k < 2; ++k) acc[ai][bj][m][n] = __builtin_amdgcn_mfma_f32_16x16x32_bf16(Bt[n][k], At[m][k], acc[ai][bj][m][n], 0, 0, 0); } } \
        if (PG8_PRIO) __builtin_amdgcn_s_setprio(0); } while (0)
#define PG8_WAIT_V(n) asm volatile("s_waitcnt vmcnt(" #n ")" ::: "memory")
#define PG8_WAIT_L(n) asm volatile("s_waitcnt lgkmcnt(" #n ")" ::: "memory")
#define PG8_BAR __builtin_amdgcn_s_barrier()
#define PG8_SCHED __builtin_amdgcn_sched_barrier(0)
    Unit cur, nxt; int ui = 0;
    if (!S.next(0, cur)) return;
    constexpr int RSL_OFF = STAGE_BYTES; int rpar = 0;
#define PG8_RSPF(uu, par) do { if constexpr (Epi::ROWSCALE) { if (wid == 0) __builtin_amdgcn_global_load_lds((const unsigned*)(E.rs + (size_t)(uu).pm * BM + lane * 4), (PG8_LAS unsigned*)(lds + RSL_OFF + (par) * 1024), 16, 0, 0); } } while (0)
    PG8_RSPF(cur, 0);
    f32x4 acc[2][2][4][2];
#pragma unroll
    for (int a = 0; a < 2; ++a)
#pragma unroll
        for (int b = 0; b < 2; ++b)
#pragma unroll
            for (int m = 0; m < 4; ++m)
#pragma unroll
                for (int n = 0; n < 2; ++n) acc[a][b][m][n] = (f32x4){0.f, 0.f, 0.f, 0.f};
    bf16x8 At[4][2], B0[2][2], B1[2][2];
    int f8one = 0x7F7F7F7F; if constexpr (F8) asm volatile("" : "+v"(f8one));
    const char* cA = (const char*)g.A + (size_t)cur.pm * tstepA; const char* cB = (const char*)g.Bt + (size_t)cur.pn * tstepB;
    S.a_ready(cur);
    PG8_STAGE(PG8_SB(0, 0), cB, voffB); PG8_STAGE(PG8_SB(0, 1), cB + hstepB, voffB); PG8_STAGE(PG8_SA(0, 0), cA, voffA); PG8_STAGE(PG8_SA(0, 1), cA + hstepA, voffA);
    if (wr == 1) PG8_BAR;
    PG8_WAIT_V(2); PG8_BAR;
    PG8_STAGE(PG8_SB(1, 0), cB + kstep, voffB); PG8_STAGE(PG8_SA(1, 0), cA + kstep, voffA); PG8_STAGE(PG8_SB(1, 1), cB + hstepB + kstep, voffB);
    PG8_WAIT_V(6); PG8_BAR;
    for (;;) {
        const bool has_next = S.next(ui + 1, nxt);
        const char* nA = has_next ? (const char*)g.A + (size_t)nxt.pm * tstepA : cA; const char* nB = has_next ? (const char*)g.Bt + (size_t)nxt.pn * tstepB : cB;
        for (int t = 0; t < nt; t += 2) {
            const bool last = (t == nt - 2);
            const char* a1 = cA + (size_t)(t >> g.pshA) * g.pstrA + (size_t)((t & ((1 << g.pshA) - 1)) + 1) * kstep;
            const int t2 = t + 2;
            const char* a2 = last ? nA : cA + (size_t)(t2 >> g.pshA) * g.pstrA + (size_t)(t2 & ((1 << g.pshA) - 1)) * kstep;
            const char* b2 = last ? nB : cB + (size_t)(t2 >> g.pshB) * g.pstrB + (size_t)(t2 & ((1 << g.pshB) - 1)) * kstep;
            const char* a3 = a2 + kstep; const char* b3 = b2 + kstep;
            if (last && has_next) S.a_ready(nxt);
            if constexpr (Mid::ON) { if (t == MH.tmid) MH(acc, cur, wr, wc, fr, fq); }
            PG8_LDB(B0, 0, 0); PG8_LDB(B1, 0, 1); PG8_SCHED; PG8_LDA(At, 0, 0); PG8_STAGE(PG8_SA(1, 1), a1 + hstepA, voffA);
            PG8_WAIT_V(8); PG8_WAIT_L(0); PG8_BAR; PG8_MMA(0, 0, At, B0); PG8_MMA(0, 1, At, B1); PG8_BAR; PG8_SCHED;
            PG8_LDA(At, 0, 1); PG8_STAGE(PG8_SB(0, 0), b2, voffB); PG8_STAGE(PG8_SB(0, 1), b2 + hstepB, voffB); PG8_STAGE(PG8_SA(0, 0), a2, voffA);
            PG8_WAIT_V(8); PG8_WAIT_L(0); PG8_BAR; PG8_MMA(1, 0, At, B0); PG8_MMA(1, 1, At, B1); PG8_BAR; PG8_SCHED;
            PG8_LDB(B0, 1, 0); PG8_LDB(B1, 1, 1); PG8_SCHED; PG8_LDA(At, 1, 0); PG8_STAGE(PG8_SA(0, 1), a2 + hstepA, voffA);
            PG8_WAIT_V(8); PG8_WAIT_L(0); PG8_BAR; PG8_MMA(0, 0, At, B0); PG8_MMA(0, 1, At, B1); PG8_BAR; PG8_SCHED;
            PG8_LDA(At, 1, 1); PG8_STAGE(PG8_SB(1, 0), b3, voffB); PG8_STAGE(PG8_SB(1, 1), b3 + hstepB, voffB); PG8_STAGE(PG8_SA(1, 0), a3, voffA);
            PG8_WAIT_V(8); PG8_WAIT_L(0); PG8_BAR; PG8_MMA(1, 0, At, B0); PG8_MMA(1, 1, At, B1); PG8_BAR; PG8_SCHED;
        }
        if constexpr (ALIGN_EPI) { if (wr == 0) PG8_BAR; }
        if constexpr (F8) {
            asm volatile("s_nop 15\n\ts_nop 15" : "+v"(acc[0][0][0][0]), "+v"(acc[0][0][0][1]), "+v"(acc[0][0][1][0]), "+v"(acc[0][0][1][1]), "+v"(acc[0][0][2][0]), "+v"(acc[0][0][2][1]), "+v"(acc[0][0][3][0]), "+v"(acc[0][0][3][1]),
                                                   "+v"(acc[0][1][0][0]), "+v"(acc[0][1][0][1]), "+v"(acc[0][1][1][0]), "+v"(acc[0][1][1][1]), "+v"(acc[0][1][2][0]), "+v"(acc[0][1][2][1]), "+v"(acc[0][1][3][0]), "+v"(acc[0][1][3][1]) :: "memory");
            asm volatile("" : "+v"(acc[1][0][0][0]), "+v"(acc[1][0][0][1]), "+v"(acc[1][0][1][0]), "+v"(acc[1][0][1][1]), "+v"(acc[1][0][2][0]), "+v"(acc[1][0][2][1]), "+v"(acc[1][0][3][0]), "+v"(acc[1][0][3][1]),
                              "+v"(acc[1][1][0][0]), "+v"(acc[1][1][0][1]), "+v"(acc[1][1][1][0]), "+v"(acc[1][1][1][1]), "+v"(acc[1][1][2][0]), "+v"(acc[1][1][2][1]), "+v"(acc[1][1][3][0]), "+v"(acc[1][1][3][1]) :: "memory"); }
        E(acc, cur, wr, wc, fr, fq, (const PG8_LAS float*)(lds + RSL_OFF + rpar * 1024)); S.done(cur); rpar ^= 1;
        if (!has_next) break;
#pragma unroll
        for (int a = 0; a < 2; ++a)
#pragma unroll
            for (int b = 0; b < 2; ++b)
#pragma unroll
                for (int m = 0; m < 4; ++m)
#pragma unroll
                    for (int n = 0; n < 2; ++n) acc[a][b][m][n] = (f32x4){0.f, 0.f, 0.f, 0.f};
        cur = nxt; cA = nA; cB = nB; ++ui;
        PG8_RSPF(cur, rpar);
        if constexpr (ALIGN_EPI) { if (wr == 1) PG8_BAR; }
    }
    PG8_WAIT_V(0);
    if constexpr (!ALIGN_EPI) { if (wr == 0) PG8_BAR; }
    PG8_BAR;
#undef PG8_SA
#undef PG8_SB
#undef PG8_STAGE
#undef PG8_LDA
#undef PG8_LDB
#undef PG8_MMA
#undef PG8_WAIT_V
#undef PG8_WAIT_L
#undef PG8_BAR
#undef PG8_SCHED
#undef PG8_RSPF
}
}
#ifndef ATT_PRIO
#define ATT_PRIO 2
#endif
#ifndef ATT_STAGGER
#define ATT_STAGGER 0
#endif
namespace att {
typedef unsigned short bf16_t;
typedef short bf16x8 __attribute__((ext_vector_type(8)));
typedef short s16x4 __attribute__((ext_vector_type(4)));
typedef float f32x16 __attribute__((ext_vector_type(16)));
typedef float f32x4 __attribute__((ext_vector_type(4)));
typedef unsigned u32x4 __attribute__((ext_vector_type(4)));
constexpr int D = 128, NW = 8, QBLK = 32, KVBLK = 64, QB = NW * QBLK;
constexpr int SHM_V = KVBLK * D * 2, SHM_K = KVBLK * D * 2;
constexpr int OFF_WS = 2 * SHM_V + 2 * SHM_K;
constexpr int OFF_BIAS = OFF_WS + NW * 64 * 4;
constexpr int OFF_Q = OFF_BIAS + 2 * 64 * 4;
constexpr int OFF_OST = 69632;
constexpr int OST_PITCH = 136, OST_WAVE = 32 * OST_PITCH * 2;
constexpr int LDS_BYTES = OFF_OST + NW * OST_WAVE;
static_assert(OFF_Q + 16 <= OFF_OST, "attention LDS map");
constexpr int PKV = 12288;
constexpr int PO = 6144;
constexpr int META_ROW0 = 16384;
constexpr float SCALE = 0.08838834764831845f;
constexpr float C2 = 1.4426950408889634f * SCALE;
constexpr float THR = 8.f;
constexpr unsigned WBIG = 0x40000000u;

#define KSWZ(row, colB) ((row) * 256 + ((colB) ^ (((row) & 7) << 4)))
#define SBAR() __builtin_amdgcn_sched_barrier(0)
__device__ __forceinline__ int v_st(int k, int c) { const int kk = (k & ~0xC) | ((k & 4) << 1) | ((k & 8) >> 1); return ((kk >> 3) * 4 + (c >> 5)) * 512 + ((kk & 7) * 32 + (c & 31)) * 2; }
__device__ __forceinline__ int v_rd_base(int lane) { return ((lane & 3) << 3) | (((lane >> 2) & 3) << 6) | (((lane >> 4) & 1) << 5) | (((lane >> 5) & 1) << 8); }
constexpr int v_rd_off(int d0, int ks, int half) { return d0 * 512 + ks * 4096 + half * 2048; }
__device__ __forceinline__ int crow(int r, int hi) { return (r & 3) + 8 * (r >> 2) + 4 * hi; }
__device__ __forceinline__ unsigned cvtpk(float lo, float hi) { unsigned r; asm volatile("v_cvt_pk_bf16_f32 %0, %1, %2" : "=v"(r) : "v"(lo), "v"(hi)); return r; }
__device__ __forceinline__ bf16x8 load8(const bf16_t* p) { return *reinterpret_cast<const bf16x8*>(p); }

__device__ __forceinline__ void mask_tile(f32x16& p0, f32x16& p1, int dq) {
    const float NEG = -__builtin_inff();
#pragma unroll
    for (int r = 0; r < 16; ++r) {
        const int c = (r & 3) + 8 * (r >> 2);
        if ((unsigned)(dq - c) >= WBIG) p0[r] = NEG;
        if ((unsigned)(dq - c - 32) >= WBIG) p1[r] = NEG;
    }
}
__device__ __forceinline__ void mask_tile0(f32x16& p0, f32x16& p1) {
    const float NEG = -__builtin_inff();
#pragma unroll
    for (int r = 0; r < 16; ++r) { p0[r] = NEG; if (r < 8) p1[r] = NEG; }
}
__device__ __forceinline__ void partialSM(f32x16& p0, f32x16& p1, float& m_reg, float& mn, float& alpha) {
    float pmax = p0[0]; for (int r = 1; r < 16; ++r) pmax = fmaxf(pmax, p0[r]); for (int r = 0; r < 16; ++r) pmax = fmaxf(pmax, p1[r]);
    { auto rr = __builtin_amdgcn_permlane32_swap(__float_as_uint(pmax), __float_as_uint(pmax), false, false);
      pmax = fmaxf(__uint_as_float(rr[0]), __uint_as_float(rr[1])); }
    if (__builtin_expect(__all((pmax - m_reg) * SCALE <= THR), 1)) { mn = m_reg; alpha = 1.f; }
    else { mn = fmaxf(m_reg, pmax); alpha = __builtin_amdgcn_exp2f((m_reg - mn) * C2); m_reg = mn; }
    const float mnL = -mn * C2;
    for (int r = 0; r < 16; ++r) p0[r] = fmaf(p0[r], C2, mnL); for (int r = 0; r < 16; ++r) p1[r] = fmaf(p1[r], C2, mnL);
    for (int r = 0; r < 16; ++r) p0[r] = __builtin_amdgcn_exp2f(p0[r]);
}
__device__ __forceinline__ void finishSM(f32x16& p0, f32x16& p1, float alpha, float& l_reg, bf16x8& pa0, bf16x8& pa1, bf16x8& pa2, bf16x8& pa3) {
    for (int r = 0; r < 16; ++r) p1[r] = __builtin_amdgcn_exp2f(p1[r]);
    float ps = 0; for (int r = 0; r < 16; ++r) ps += p0[r]; for (int r = 0; r < 16; ++r) ps += p1[r];
    { auto rr = __builtin_amdgcn_permlane32_swap(__float_as_uint(ps), __float_as_uint(ps), false, false);
      ps = __uint_as_float(rr[0]) + __uint_as_float(rr[1]); }
    l_reg = l_reg * alpha + ps;
#define PK4(P, B_, OUT) do { unsigned a0 = cvtpk(P[B_+0], P[B_+1]), a1 = cvtpk(P[B_+2], P[B_+3]);                          \
        unsigned b0 = cvtpk(P[B_+4], P[B_+5]), b1 = cvtpk(P[B_+6], P[B_+7]);                                             \
        auto r0 = __builtin_amdgcn_permlane32_swap(a0, b0, false, false); auto r1 = __builtin_amdgcn_permlane32_swap(a1, b1, false, false); \
        u32x4 w = {r0[0], r1[0], r0[1], r1[1]}; OUT = *reinterpret_cast<bf16x8*>(&w); } while (0)
    PK4(p0, 0, pa0); PK4(p0, 8, pa1); PK4(p1, 0, pa2); PK4(p1, 8, pa3);
#undef PK4
}
template <int KB>
__device__ __forceinline__ void qkt(f32x16& p0, f32x16& p1, const char* K_lds, int r32, int hi, const bf16x8* qr, const float* bias_l) {
    { const f32x4* bb = (const f32x4*)(bias_l + KB * 64 + 4 * hi);
#pragma unroll
      for (int g = 0; g < 4; ++g) { const f32x4 b0 = bb[2 * g], b1 = bb[8 + 2 * g];
#pragma unroll
          for (int i = 0; i < 4; ++i) { p0[4 * g + i] = b0[i]; p1[4 * g + i] = b1[i]; } } }
    const char* kb[4];
#pragma unroll
    for (int dd = 0; dd < 4; ++dd) kb[dd] = K_lds + KB * SHM_K + KSWZ(r32, (dd * 16 + hi * 8) * 2);
    if (ATT_PRIO & 1) __builtin_amdgcn_s_setprio(1);
#pragma unroll
    for (int d0 = 0; d0 < 8; ++d0) { const char* a = kb[d0 & 3] + (d0 >> 2) * 128;
        bf16x8 b0 = *reinterpret_cast<const bf16x8*>(a);
        bf16x8 b1 = *reinterpret_cast<const bf16x8*>(a + 32 * 256);
        p0 = __builtin_amdgcn_mfma_f32_32x32x16_bf16(b0, qr[d0], p0, 0, 0, 0);
        p1 = __builtin_amdgcn_mfma_f32_32x32x16_bf16(b1, qr[d0], p1, 0, 0, 0); }
    if (ATT_PRIO & 1) __builtin_amdgcn_s_setprio(0);
}
template <int VB>
__device__ __forceinline__ void pv_tile(f32x16* o, int vb0, bf16x8 pa0, bf16x8 pa1, bf16x8 pa2, bf16x8 pa3) {
#define TRRD(dst, off) asm volatile("ds_read_b64_tr_b16 %0, %1 offset:%2" : "=&v"(dst) : "v"(vb0), "i"(off) : "memory")
#define PV_D0(d0) do { s16x4 l0, l1, l2, l3, h0, h1, h2, h3; constexpr int b_ = VB * SHM_V + v_rd_off(d0, 0, 0);     \
        TRRD(l0, b_); TRRD(h0, b_ + 2048); TRRD(l1, b_ + 4096); TRRD(h1, b_ + 6144); TRRD(l2, b_ + 8192); TRRD(h2, b_ + 10240); TRRD(l3, b_ + 12288); TRRD(h3, b_ + 14336); \
        asm volatile("s_waitcnt lgkmcnt(0)" ::: "memory"); SBAR();   \
        o[d0] = __builtin_amdgcn_mfma_f32_32x32x16_bf16(pa0, (bf16x8){l0[0], l0[1], l0[2], l0[3], h0[0], h0[1], h0[2], h0[3]}, o[d0], 0, 0, 0);   \
        o[d0] = __builtin_amdgcn_mfma_f32_32x32x16_bf16(pa1, (bf16x8){l1[0], l1[1], l1[2], l1[3], h1[0], h1[1], h1[2], h1[3]}, o[d0], 0, 0, 0);   \
        o[d0] = __builtin_amdgcn_mfma_f32_32x32x16_bf16(pa2, (bf16x8){l2[0], l2[1], l2[2], l2[3], h2[0], h2[1], h2[2], h2[3]}, o[d0], 0, 0, 0);   \
        o[d0] = __builtin_amdgcn_mfma_f32_32x32x16_bf16(pa3, (bf16x8){l3[0], l3[1], l3[2], l3[3], h3[0], h3[1], h3[2], h3[3]}, o[d0], 0, 0, 0); } while (0)
    if (ATT_PRIO & 2) __builtin_amdgcn_s_setprio(1);
    PV_D0(0); PV_D0(1); PV_D0(2); PV_D0(3);
    if (ATT_PRIO & 2) __builtin_amdgcn_s_setprio(0);
#undef PV_D0
#undef TRRD
}

struct BlockRef { const bf16_t* Q; const bf16_t* K; const bf16_t* V; bf16_t* O; const float* kb; float sl2; int rowb; int P0; int jlo; int probe; };
struct Seam { bf16x8 qr[8]; bf16x8 st_v0, st_v1, st_k0, st_k1; float st_b; };

#define VMW() asm volatile("s_waitcnt vmcnt(0)" ::: "memory")
#define VMWN(n) asm volatile("s_waitcnt vmcnt(%0)" :: "i"(n) : "memory")
__device__ __forceinline__ bf16x8 load8o(const bf16_t* base, unsigned byteoff) { return *reinterpret_cast<const bf16x8*>((const char*)base + byteoff); }
__device__ __forceinline__ void sload(Seam& S, const BlockRef& R, int j, int sr, int sc, int wid, int lane) {
    if (R.probe) j = R.jlo;
    const int rb = (j == 0) ? (META_ROW0 - 48) : (R.rowb + 64 * (j - 1));
    const unsigned o0 = (unsigned)((rb + sr) * PKV + sc) * 2u, o1 = (unsigned)((rb + 32 + sr) * PKV + sc) * 2u;
    S.st_v0 = load8o(R.V, o0); S.st_v1 = load8o(R.V, o1);
    S.st_k0 = load8o(R.K, o0); S.st_k1 = load8o(R.K, o1);
    if (wid == 0) { const int e = 64 * j + lane; S.st_b = R.kb ? R.kb[e] : R.sl2 * (float)(e - (R.P0 + QB)); }
}
__device__ __forceinline__ float row_bias(const BlockRef& R, int wid, int r32) { const int rr = wid * QBLK + r32; return R.kb ? R.kb[R.P0 + rr] : R.sl2 * (float)(rr - QB); }
#define SWRITE_K(bf) do { *(bf16x8*)(K_lds + (bf) * SHM_K + kws) = S.st_k0; *(bf16x8*)(K_lds + (bf) * SHM_K + kws + 32 * 256) = S.st_k1; \
                          if (wid == 0) bias_l[(bf) * 64 + lane] = S.st_b; } while (0)
#define SWRITE_V(bf) do { *(bf16x8*)(V_lds + (bf) * SHM_V + vst0) = S.st_v0; *(bf16x8*)(V_lds + (bf) * SHM_V + vst0 + 8192) = S.st_v1; } while (0)

__device__ __forceinline__ void attn_prime(const int tid, const BlockRef& cur, char* lds, Seam& S) {
    const int wid = __builtin_amdgcn_readfirstlane(tid >> 6), lane = tid & 63, r32 = lane & 31, hi = lane >> 5;
    const int sr = tid >> 4, sc = (tid & 15) * 8, kws = KSWZ(sr, sc * 2); char* K_lds = lds + 2 * SHM_V; float* bias_l = (float*)(lds + OFF_BIAS);
#pragma unroll
    for (int d0 = 0; d0 < 8; ++d0) S.qr[d0] = load8o(cur.Q, (unsigned)((wid * QBLK + r32) * PKV + d0 * 16 + hi * 8) * 2u);
    sload(S, cur, cur.jlo, sr, sc, wid, lane); VMW(); SWRITE_K(0);
    __syncthreads();
}
__device__ __forceinline__ void attn_block(const int tid, const BlockRef& cur, const BlockRef& nxt, char* lds, Seam& S) {
    const int wid = __builtin_amdgcn_readfirstlane(tid >> 6), lane = tid & 63, r32 = lane & 31, hi = lane >> 5;
    const int j0 = cur.jlo, NT = (cur.P0 + QB - 1) / KVBLK + 1 - j0;
    const int qlo = cur.P0 + wid * QBLK, qm = qlo + r32 - 4 * hi;
    char* V_lds = lds; char* K_lds = lds + 2 * SHM_V;
    float* ws = (float*)(lds + OFF_WS) + wid * 64; float* li_l = ws, * al_l = ws + 32;
    float* bias_l = (float*)(lds + OFF_BIAS);
    float m_reg = -1e30f, l_reg = 0; f32x16 o[4] = {};
    const int sr = tid >> 4, sc = (tid & 15) * 8, vst0 = v_st(sr, sc), kws = KSWZ(sr, sc * 2);
    const int vb0 = (int)(uintptr_t)V_lds + v_rd_base(lane);
#define RESC(a) do { if (__any((a) < 1.f)) { if (hi == 0) al_l[r32] = (a); asm volatile("s_waitcnt lgkmcnt(0)" ::: "memory");              \
                     for (int d_ = 0; d_ < 4; ++d_) for (int r = 0; r < 16; ++r) o[d_][r] *= al_l[crow(r, hi)]; } } while (0)
#define MASKT(P0_, P1_, t) do { const int kb_ = (j0 + (t)) * KVBLK; if (kb_ + KVBLK - 1 > qlo) mask_tile(P0_, P1_, qm - kb_); } while (0)
    f32x16 pA0, pA1, pB0, pB1; float mnA, mnB, alA, alB; bf16x8 pa0, pa1, pa2, pa3;
    SWRITE_V(0); SBAR();
    if (NT > 1) sload(S, cur, j0 + 1, sr, sc, wid, lane);
    SBAR(); qkt<0>(pA0, pA1, K_lds, r32, hi, S.qr, bias_l);
    if (j0 == 0) mask_tile0(pA0, pA1);
    partialSM(pA0, pA1, m_reg, mnA, alA);
    if (NT > 1) { VMW(); SWRITE_V(1); SWRITE_K(1); }
    __syncthreads();
#define HALF_STEP(PX0, PX1, mnX, alX, PY0, PY1, alY, t, KB, VB, SB) do {                                                      \
        SBAR(); if (ATT_STAGGER && wid >= 4) __builtin_amdgcn_s_sleep(ATT_STAGGER); SBAR(); if ((t) + 1 < NT) { sload(S, cur, j0 + (t) + 1, sr, sc, wid, lane); SBAR(); }     \
        qkt<KB>(PX0, PX1, K_lds, r32, hi, S.qr, bias_l);                                                                      \
        finishSM(PY0, PY1, alY, l_reg, pa0, pa1, pa2, pa3); SBAR();                                                           \
        pv_tile<VB>(o, vb0, pa0, pa1, pa2, pa3); MASKT(PX0, PX1, (t)); partialSM(PX0, PX1, m_reg, mnX, alX);       \
        __syncthreads();                                                                                                      \
        if ((t) + 1 < NT) { VMW(); SWRITE_V(SB); SWRITE_K(SB); }                                                              \
        RESC(alX); __syncthreads(); } while (0)
    for (int t = 1; t + 1 < NT; t += 2) {
        HALF_STEP(pB0, pB1, mnB, alB, pA0, pA1, alA, t, 1, 0, 0);
        HALF_STEP(pA0, pA1, mnA, alA, pB0, pB1, alB, t + 1, 0, 1, 1);
    }
    constexpr bool even = false;
    if (even) { SBAR(); qkt<1>(pB0, pB1, K_lds, r32, hi, S.qr, bias_l); SBAR(); }
    sload(S, nxt, nxt.jlo, sr, sc, wid, lane); SBAR();
#pragma unroll
    for (int d0 = 0; d0 < 8; ++d0) S.qr[d0] = load8o(nxt.Q, (unsigned)((wid * QBLK + r32) * PKV + d0 * 16 + hi * 8) * 2u);
    SBAR();
    finishSM(pA0, pA1, alA, l_reg, pa0, pa1, pa2, pa3); SBAR();
    pv_tile<0>(o, vb0, pa0, pa1, pa2, pa3);
    if (even) { MASKT(pB0, pB1, NT - 1); partialSM(pB0, pB1, m_reg, mnB, alB); __syncthreads(); RESC(alB);
        finishSM(pB0, pB1, alB, l_reg, pa0, pa1, pa2, pa3); SBAR(); pv_tile<1>(o, vb0, pa0, pa1, pa2, pa3); }
    SBAR(); VMWN(8); SWRITE_K(0); SBAR();
    if (hi == 0) li_l[r32] = l_reg; asm volatile("s_waitcnt lgkmcnt(0)" ::: "memory");
    float rli[16];
#pragma unroll
    for (int r = 0; r < 16; ++r) rli[r] = __builtin_amdgcn_rcpf(li_l[crow(r, hi)]);
    bf16_t* Ow = cur.O + (size_t)(wid * QBLK) * PO;
    bf16_t* stg = (bf16_t*)(lds + OFF_OST + wid * OST_WAVE);
#pragma unroll
    for (int r = 0; r < 16; ++r) { const int orow = crow(r, hi);
#pragma unroll
        for (int d0 = 0; d0 < 4; ++d0) { const float v = o[d0][r] * rli[r];
            const float vn = __int_as_float(__builtin_amdgcn_mov_dpp(__float_as_int(v), 0xB1, 0xF, 0xF, true));
            if ((r32 & 1) == 0) *(unsigned*)(stg + orow * OST_PITCH + d0 * 32 + r32) = cvtpk(v, vn); } }
    asm volatile("s_waitcnt lgkmcnt(0)" ::: "memory");
#pragma unroll
    for (int i = 0; i < 8; ++i) { const int row = i * 4 + (lane >> 4), ch = lane & 15;
        const u32x4 v = *(const u32x4*)(stg + row * OST_PITCH + ch * 8);
        *(u32x4*)(Ow + (size_t)row * PO + ch * 8) = v; }
    __syncthreads();
#undef RESC
#undef MASKT
#undef HALF_STEP
}
#undef VMW
#undef VMWN
#undef SWRITE_K
#undef SWRITE_V
#undef KSWZ
#undef SBAR
}
constexpr int NWAVES = 8;
constexpr int DM = 4096, NB = 4, SEQ = 4096, NMETA = 16, DFF = 11008;
constexpr int MR = NB * SEQ;
constexpr int MT = MR + 256;
constexpr int NGU = 2 * DFF;
constexpr int NIN = 20736;
constexpr int PQKV = 12288, PGATE = 8192, PAO = 6144;
#ifndef GU_F8
#define GU_F8 1
#endif
#ifndef GATES_F8
#define GATES_F8 1
#endif
#ifndef PU_PAD
#define PU_PAD 0
#endif
constexpr int PU = DM + PU_PAD;
constexpr size_t WD_PSTR = (size_t)4096 * 4096;
constexpr int EKV = 4160;
constexpr float RMS_EPS = 1e-6f;
constexpr float LOG2E = 1.4426950408889634f;
constexpr float ISCALE = 11.313708498984761f;
constexpr float LAMBDA_INIT = 0.2f;

constexpr size_t MiB = 1u << 20;
constexpr size_t WS_CTL = 0, CTL_ZERO_BYTES = 1 * MiB;
constexpr size_t WS_KB = 1 * MiB;
constexpr size_t WS_FLOG = 3 * MiB;
constexpr size_t WS_JLO = 5 * MiB;
constexpr size_t WS_RS0 = 6 * MiB, WS_RS1 = WS_RS0 + 128 * 1024, WS_RS2 = WS_RS1 + 128 * 1024;
constexpr size_t WS_WGU = 8 * MiB;
constexpr size_t WS_WD = 180 * MiB;
constexpr size_t WS_P = WS_WGU;
constexpr size_t WS_WIN = 276 * MiB;
constexpr size_t WS_WGU8 = WS_WIN;
constexpr int GU8_TILES = 22, GU8_ROW0 = (86 - GU8_TILES) * 256;
constexpr size_t WS_WIN8 = WS_WIN + 96 * MiB;
constexpr size_t WS_U8 = 1412 * MiB;
constexpr size_t WS_WO = 438 * MiB;
constexpr size_t WS_WOUT = 470 * MiB;
constexpr size_t WS_U = 502 * MiB;
constexpr size_t WS_Y = 632 * MiB;
constexpr size_t WS_BIG = 762 * MiB;
constexpr size_t WS_GATES = WS_BIG + 390 * MiB;
constexpr size_t WS_AO = 1412 * MiB;
constexpr size_t WS_MG = 1604 * MiB;
constexpr size_t WS_END = 1732 * MiB;
static_assert((size_t)NGU * DM * 2 <= 172 * MiB && (size_t)3 * DM * 4096 * 2 <= 96 * MiB && (size_t)NIN * DM * 2 <= 162 * MiB && (size_t)MT * DM * 2 <= 130 * MiB && (size_t)MT * PU * 2 <= 130 * MiB, "ws map");
static_assert((size_t)MT * DFF * 2 <= 650 * MiB && (size_t)MT * PQKV * 2 <= 390 * MiB && (size_t)MT * PGATE * 2 <= 260 * MiB && (size_t)MR * DM * 4 <= 258 * MiB, "ws map");
static_assert((size_t)NB * 16 * EKV * 4 <= 2 * MiB && (size_t)MT * 16 * 4 <= 2 * MiB, "ws map");
constexpr int CW_BAR = 4096;
constexpr int CW_CQ2 = 8448;
constexpr int CW_CQ = 8320;
constexpr int CW_Q = 8192;
constexpr float SKIP_TH = 44.0f;

constexpr int RING_OFF = 0, RING_BYTES = 131072;
constexpr int LDSCTL_OFF = 139264, MISC_OFF = LDSCTL_OFF + 320;
constexpr int LDS_BYTES = 147456;
static_assert(MISC_OFF + 128 <= LDS_BYTES && att::LDS_BYTES <= LDSCTL_OFF && RING_BYTES <= LDSCTL_OFF, "LDS map");

#define GAS __attribute__((address_space(1)))
#define LAS __attribute__((address_space(3)))
typedef unsigned short bf16;
typedef unsigned v4u __attribute__((ext_vector_type(4)));
typedef unsigned v2u __attribute__((ext_vector_type(2)));
typedef float f32x4 __attribute__((ext_vector_type(4)));
typedef GAS unsigned gu32;
#define RLX_AGENT __ATOMIC_RELAXED, __HIP_MEMORY_SCOPE_AGENT
#define LDS_WAIT() asm volatile("s_waitcnt lgkmcnt(0)" ::: "memory")
#define VM_WAIT() asm volatile("s_waitcnt vmcnt(0)" ::: "memory")
__device__ __forceinline__ unsigned f2bf(float f) { unsigned u = __builtin_bit_cast(unsigned, f); return (u + 0x7fffu + ((u >> 16) & 1u)) >> 16; }
__device__ __forceinline__ unsigned pk2(float lo, float hi) { return f2bf(lo) | (f2bf(hi) << 16); }
__device__ __forceinline__ float bflo(unsigned w) { return __uint_as_float(w << 16); }
__device__ __forceinline__ float bfhi(unsigned w) { return __uint_as_float(w & 0xffff0000u); }

#define XB_TMO      128
#define XB_XCNT(j)  (256  + 64 * (j))
#define XB_XSUB(j)  (1280 + 64 * (j))
#define XB_XGEN(j)  (2304 + 64 * (j))
#define XB_TOP      3328
#define XB_TOPGEN   3392
#define XCD_BAR_WORDS 3456
#define XB_SPIN_CAP (1u << 22)

__device__ __forceinline__ unsigned xb_ld(unsigned* p)              { return __hip_atomic_load(p, __ATOMIC_RELAXED, __HIP_MEMORY_SCOPE_AGENT); }
__device__ __forceinline__ unsigned xb_add(unsigned* p, unsigned v) { return __hip_atomic_fetch_add(p, v, __ATOMIC_RELAXED, __HIP_MEMORY_SCOPE_AGENT); }
__device__ __forceinline__ unsigned xb_xcc_id() { return (unsigned)__builtin_amdgcn_s_getreg((3 << 11) | 20) & 0xFu; }
#define XB_SPIN(cond, bar) do { unsigned _sp = 0; while (cond) { __builtin_amdgcn_s_sleep(1); \
    if ((++_sp & 255u) == 0u) { if (xb_ld(&(bar)[XB_TMO])) break; if (_sp > XB_SPIN_CAP) { atomicAdd(&(bar)[XB_TMO], 1u); break; } } } } while (0)

struct XcdBarrier {
    unsigned* bar; unsigned x;
    volatile LAS unsigned* st;
};
__device__ __forceinline__ XcdBarrier xcd_barrier_post(unsigned* bar, volatile LAS unsigned* st, int tid) {
    XcdBarrier b; b.bar = bar; b.x = xb_xcc_id(); b.st = st;
    if (tid == 0) (void)xb_add(&bar[XB_XCNT(b.x)], 1u);
    return b;
}
__device__ __forceinline__ void xcd_barrier_complete(unsigned* bar, unsigned x, unsigned& nloc, unsigned& nx) {
    const unsigned G = gridDim.x * gridDim.y * gridDim.z;
    unsigned sum, cnt, mine, sp = 0u;
    for (;;) {
        sum = 0u; cnt = 0u; mine = 0u;
#pragma unroll
        for (unsigned j = 0; j < 16; ++j) { const unsigned c = xb_ld(&bar[XB_XCNT(j)]); sum += c; cnt += (c > 0u) ? 1u : 0u; mine = (j == x) ? c : mine; }
        if (sum == G) break;
        __builtin_amdgcn_s_sleep(1);
        if ((++sp & 255u) == 0u) { if (xb_ld(&bar[XB_TMO])) break; if (sp > XB_SPIN_CAP) { atomicAdd(&bar[XB_TMO], 1u); break; } }
    }
    nloc = mine > 0u ? mine : 1u; nx = cnt > 0u ? cnt : 1u;
}
__device__ __forceinline__ void xcd_barrier(const XcdBarrier& b, int tid) {
    asm volatile("s_waitcnt vmcnt(0)" ::: "memory");
    __syncthreads();
    if (tid == 0) {
        unsigned* bar = b.bar;
        __builtin_amdgcn_s_waitcnt(0);
        unsigned nloc = b.st[0], nx = b.st[1];
        if (nloc == 0u) { xcd_barrier_complete(bar, b.x, nloc, nx); b.st[0] = nloc; b.st[1] = nx; }
        const unsigned old = xb_add(&bar[XB_XSUB(b.x)], 1u);
        const unsigned gen = old / nloc;
        if (old + 1u == (gen + 1u) * nloc) {
            __builtin_amdgcn_fence(__ATOMIC_RELEASE, "agent");
            asm volatile("s_waitcnt vmcnt(0)" ::: "memory");
            const unsigned og = xb_add(&bar[XB_TOP], 1u);
            const unsigned tg = og / nx;
            if (og + 1u == (tg + 1u) * nx) {
#pragma unroll
                for (unsigned j = 0; j < 16; ++j) xb_add(&bar[XB_XGEN(j)], 1u);
            }
        }
        XB_SPIN(xb_ld(&bar[XB_XGEN(b.x)]) == gen, bar);
        __builtin_amdgcn_fence(__ATOMIC_ACQUIRE, "agent");
        asm volatile("s_waitcnt vmcnt(0)" ::: "memory");
    }
    __syncthreads();
}

typedef const __attribute__((address_space(4))) char* KP;
__device__ __forceinline__ KP kargs() { KP p = (KP)__builtin_amdgcn_kernarg_segment_ptr(); asm volatile("" : "+s"(p)); return p; }
template <class T> __device__ __forceinline__ T* karg(KP kp, int i) { return *(T* const __attribute__((address_space(4)))*)(kp + 8 * i); }
enum { A_X = 0, A_META, A_G_FF1_PRE, A_W_GATE1, A_W_UP1, A_W_DOWN1, A_G_FF1_POST, A_G_MIX_PRE, A_W_IN, A_B_FORGET, A_LQ1, A_LK1, A_LQ2, A_LK2, A_G_SUBLN, A_W_O_FOX, A_W_O_DIFF, A_W_OUT,
       A_G_MIX_POST, A_G_FF2_PRE, A_W_GATE2, A_W_UP2, A_W_DOWN2, A_G_FF2_POST, A_OUT, A_WS };
struct Frame {
    LAS unsigned char* lds;
    int tid, lane, wave;
    int vcu, G;
};
__device__ __forceinline__ void frame_refresh(Frame& F) {
    int l; asm volatile("v_mbcnt_lo_u32_b32 %0, -1, 0\n\tv_mbcnt_hi_u32_b32 %0, -1, %0" : "=v"(l));
    F.lane = l; F.tid = F.wave * 64 + l;
}
template <class T> __device__ __forceinline__ T* wsp(KP kp, size_t off) { return (T*)(karg<unsigned char>(kp, A_WS) + off); }

__device__ __forceinline__ float wave_sum(float v) {
#pragma unroll
    for (int o = 1; o < 64; o <<= 1) v += __shfl_xor(v, o);
    return v;
}
struct OnesTab { float v[DFF]; };
constexpr OnesTab make_ones() { OnesTab t{}; for (int i = 0; i < DFF; ++i) t.v[i] = 1.0f; return t; }
__device__ const OnesTab ONES = make_ones();
struct TrDesc { const float* W; unsigned char* WT; const float* gk; int N, k0, ns, nd, kd; unsigned ldt; float sc;
    __device__ __forceinline__ void set(const float* W_, unsigned char* WT_, const float* gk_, int N_, int k0_, int ns_, int nd_, int kd_, unsigned ldt_, float sc_) { W = W_; WT = WT_; gk = gk_; N = N_; k0 = k0_; ns = ns_; nd = nd_; kd = kd_; ldt = ldt_; sc = sc_; } };
__device__ __forceinline__ void tr_load(const TrDesc& d, int lane, float (&r)[32], f32x4 (&g)[2]) {
    g[0] = *(const GAS f32x4*)(d.gk + d.k0 + 8 * (lane & 7)); g[1] = *(const GAS f32x4*)(d.gk + d.k0 + 8 * (lane & 7) + 4);
    const GAS float* p = (const GAS float*)d.W + (size_t)(d.k0 + (lane >> 5)) * d.N + d.ns + (lane & 31);
#pragma unroll
    for (int i = 0; i < 32; ++i) r[i] = p[(size_t)(2 * i) * d.N];
}
__device__ __forceinline__ void tr_finish(const TrDesc& d, LAS float* scr, int lane, const float (&r)[32], const f32x4 (&g)[2]) {
#pragma unroll
    for (int i = 0; i < 32; ++i) scr[(2 * i + (lane >> 5)) * 33 + (lane & 31)] = r[i];
    const int c = lane & 7;
    f32x4 ga = g[0], gb = g[1];
    LDS_WAIT(); asm volatile("" ::: "memory");
    if (d.sc != 0.f) { ga = ga * d.sc; gb = gb * d.sc;
#pragma unroll
        for (int j = 0; j < 4; ++j) { const int n = (lane >> 3) + 8 * j; const LAS float* s = scr + (8 * c) * 33 + n;
            v2u o; o.x = pg8::pack_fp8x4(s[0 * 33] * ga.x, s[1 * 33] * ga.y, s[2 * 33] * ga.z, s[3 * 33] * ga.w); o.y = pg8::pack_fp8x4(s[4 * 33] * gb.x, s[5 * 33] * gb.y, s[6 * 33] * gb.z, s[7 * 33] * gb.w);
            *(GAS v2u*)(d.WT + (size_t)(d.nd + n) * d.ldt + d.kd + 8 * c) = o; } }
    else {
#pragma unroll
        for (int j = 0; j < 4; ++j) { const int n = (lane >> 3) + 8 * j; const LAS float* s = scr + (8 * c) * 33 + n;
            v4u o; o.x = pk2(s[0 * 33] * ga.x, s[1 * 33] * ga.y); o.y = pk2(s[2 * 33] * ga.z, s[3 * 33] * ga.w); o.z = pk2(s[4 * 33] * gb.x, s[5 * 33] * gb.y); o.w = pk2(s[6 * 33] * gb.z, s[7 * 33] * gb.w);
            *(GAS v4u*)(d.WT + (size_t)(d.nd + n) * d.ldt + (size_t)(d.kd + 8 * c) * 2) = o; } }
    LDS_WAIT(); asm volatile("" ::: "memory");
}
struct GenStride { int it, hi, step; __device__ __forceinline__ bool next(int& o) { if (it >= hi) return false; o = it; it += step; return true; } };
struct GenQueue { unsigned* qhead; int total, lane, cur = 0, end = 0;
    __device__ __forceinline__ bool next(int& o) {
        if (cur >= end) { unsigned base = 0u; if (lane == 0) base = __hip_atomic_fetch_add(qhead, 16u, __ATOMIC_RELAXED, __HIP_MEMORY_SCOPE_AGENT);
            base = (unsigned)__builtin_amdgcn_readfirstlane((int)base); if (base >= (unsigned)total) return false;
            cur = (int)base; end = (int)base + 16 < total ? (int)base + 16 : total; }
        o = cur++; return true; } };
template <class Gen, class Dec>
__device__ __forceinline__ void tr_stream(Frame& F, Gen gen, const Dec& dec) {
    LAS float* scr = (LAS float*)(F.lds + RING_OFF + F.wave * 16384);
    float ra[32], rb[32]; f32x4 gA[2], gB[2]; TrDesc da, db; int it;
    if (!gen.next(it)) return;
    dec(it, da); tr_load(da, F.lane, ra, gA);
    bool hb = gen.next(it); if (hb) dec(it, db); else db = da;
    tr_load(db, F.lane, rb, gB); tr_finish(da, scr, F.lane, ra, gA);
    while (hb) {
        const bool ha = gen.next(it); if (ha) dec(it, da); else da = db;
        tr_load(da, F.lane, ra, gA); tr_finish(db, scr, F.lane, rb, gB);
        if (!ha) break;
        hb = gen.next(it); if (hb) dec(it, db); else db = da;
        tr_load(db, F.lane, rb, gB); tr_finish(da, scr, F.lane, ra, gA);
    }
}
template <int WHICH  >
struct DecFfn { const float* wg; const float* wu; const float* wd; const float* gk; unsigned char* WGU; unsigned char* WD; unsigned char* WGU8;
    static constexpr int NBG = NGU / 32, I_GU = (DM / 64) * NBG, I_D = (DFF / 64) * (DM / 32);
    __device__ __forceinline__ void operator()(int it, TrDesc& d) const {
        if (it < I_GU) { const int kb = it / NBG, nb = it % NBG, pn = nb >> 3, w8 = nb & 7; const float* wa = wg; const float* wb = wu; asm volatile("" : "+s"(wa), "+s"(wb));
            const float* W = w8 < 4 ? wa : wb; const int ns = 128 * pn + 32 * (w8 & 3);
            if ((WHICH & 4) && 32 * nb >= GU8_ROW0) { d.set(W, WGU8, gk, DFF, 64 * kb, ns, 32 * nb - GU8_ROW0, 64 * kb, 4096u, pg8::F8_WINSCALE); return; }
            { d.set(W, WGU, gk, DFF, 64 * kb, ns, 32 * nb, 64 * kb, (unsigned)DM * 2u, 0.f); return; } }
        const int r = it - I_GU, kb = r / (DM / 32), nb = r % (DM / 32);
        { d.set(wd, WD + (size_t)(kb >> 6) * WD_PSTR * 2, ONES.v, DM, 64 * kb, 32 * nb, 32 * nb, (64 * kb) & 4095, 8192u, 0.f); return; } } };
template <int WHICH>
__device__ __forceinline__ void convert_ffn(Frame& F, KP kp, int a_gate, int a_up, int a_down, int a_gain) {
    DecFfn<WHICH> D{karg<const float>(kp, a_gate), karg<const float>(kp, a_up), karg<const float>(kp, a_down), karg<const float>(kp, a_gain), wsp<unsigned char>(kp, WS_WGU), wsp<unsigned char>(kp, WS_WD), wsp<unsigned char>(kp, WS_WGU8)};
    const int gw = F.vcu * NWAVES + F.wave, NGW = F.G * NWAVES;
    constexpr int LO = (WHICH & 1) ? 0 : DecFfn<WHICH>::I_GU, HI = (WHICH & 2) ? DecFfn<WHICH>::I_GU + DecFfn<WHICH>::I_D : DecFfn<WHICH>::I_GU;
    tr_stream(F, GenStride{LO + gw, HI, NGW}, D);
}
struct DecDown8 { const float* wd; unsigned char* WD8;
    __device__ __forceinline__ void operator()(int r, TrDesc& d) const { const int kb = r / (DM / 32), nb = r % (DM / 32);
        { d.set(wd, WD8 + (size_t)(kb >> 6) * WD_PSTR, ONES.v, DM, 64 * kb, 32 * nb, 32 * nb, (64 * kb) & 4095, 4096u, pg8::F8_WSCALE); return; } } };
__device__ __forceinline__ void convert_down_queue8(Frame& F, KP kp, int a_down, int cw) {
    DecDown8 D{karg<const float>(kp, a_down), wsp<unsigned char>(kp, WS_WD)};
    tr_stream(F, GenQueue{wsp<unsigned>(kp, WS_CTL) + cw, (DFF / 64) * (DM / 32), F.lane}, D);
}
__device__ __forceinline__ int win_src_col(int nd) {
    if (nd < 2048) return nd;
    if (nd < 4096) return 6160 + (nd - 2048);
    if (nd < 6144) return 2048 + (nd - 4096);
    if (nd < 8192) return 4096 + (nd - 6144);
    if (nd < 10240) return 8208 + (nd - 8192);
    if (nd < 12288) return 10256 + (nd - 10240);
    if (nd < 16384) return 12304 + (nd - 12288);
    if (nd < 20480) return 16400 + (nd - 16384);
    return 6144;
}
struct DecMixer { const float* w_in; const float* w_o_fox; const float* w_o_diff; const float* w_out; const float* gk; unsigned char* WIN; unsigned char* WO; unsigned char* WOUT; unsigned char* WIN8;
    static constexpr int NBI = 641;
    static constexpr int I_IN = (DM / 64) * NBI, I_OF = (2048 / 64) * (DM / 32), I_OUT = (DM / 64) * (DM / 32), TOTAL = I_IN + 2 * I_OF + I_OUT;
    __device__ __forceinline__ void operator()(int it, TrDesc& d) const {
        int r = it;
        if (r < I_IN) { const int kb = r / NBI, nb = r % NBI, nd = 32 * nb;
            if (GATES_F8 && nd >= 12288 && nd < 20480) { d.set(w_in, WIN8, gk, 20496, 64 * kb, win_src_col(nd), nd - 12288, 64 * kb, 4096u, pg8::F8_WINSCALE); return; }
            { d.set(w_in, WIN, gk, 20496, 64 * kb, win_src_col(nd), nd, 64 * kb, (unsigned)DM * 2u, 0.f); return; } }
        r -= I_IN;
        if (r < I_OF) { const int kb = r / (DM / 32), nb = r % (DM / 32); { d.set(w_o_fox, WO, ONES.v, DM, 64 * kb, 32 * nb, 32 * nb, 64 * kb, 8192u, 0.f); return; } }
        r -= I_OF;
        if (r < I_OF) { const int kb = r / (DM / 32), nb = r % (DM / 32); { d.set(w_o_diff, WO, ONES.v, DM, 64 * kb, 32 * nb, 32 * nb, 2048 + 64 * kb, 8192u, 0.f); return; } }
        r -= I_OF;
        const int kb = r / (DM / 32), nb = r % (DM / 32); { d.set(w_out, WOUT, ONES.v, DM, 64 * kb, 32 * nb, 32 * nb, 64 * kb, (unsigned)DM * 2u, 0.f); return; } } };
__device__ __forceinline__ void convert_mixer_queue(Frame& F, KP kp) {
    DecMixer D{karg<const float>(kp, A_W_IN), karg<const float>(kp, A_W_O_FOX), karg<const float>(kp, A_W_O_DIFF), karg<const float>(kp, A_W_OUT), karg<const float>(kp, A_G_MIX_PRE),
               wsp<unsigned char>(kp, WS_WIN), wsp<unsigned char>(kp, WS_WO), wsp<unsigned char>(kp, WS_WOUT), wsp<unsigned char>(kp, WS_WIN8)};
    tr_stream(F, GenQueue{wsp<unsigned>(kp, WS_CTL) + CW_CQ, DecMixer::TOTAL, F.lane}, D);
}
__device__ __forceinline__ void gain_to_lds(Frame& F, const float* g, int off) {
    const GAS f32x4* s = (const GAS f32x4*)g; LAS f32x4* d = (LAS f32x4*)(F.lds + off);
    for (int i = F.tid; i < DM / 4; i += NWAVES * 64) d[i] = s[i];
}
__device__ __forceinline__ void row_load_f32(const float* p, int lane, f32x4 (&v)[16]) {
    const GAS f32x4* r = (const GAS f32x4*)p + lane;
#pragma unroll
    for (int j = 0; j < 16; ++j) v[j] = r[64 * j];
}
__device__ __forceinline__ void row_load_bf16p(const bf16* p, int lane, v2u (&w)[16]) {
    const GAS v2u* r = (const GAS v2u*)p + lane;
#pragma unroll
    for (int j = 0; j < 16; ++j) w[j] = r[64 * j];
}
__device__ __forceinline__ f32x4 unpack4(v2u w) { return (f32x4){bflo(w.x), bfhi(w.x), bflo(w.y), bfhi(w.y)}; }
__device__ __forceinline__ float row_rstd_p(const v2u (&w)[16]) {
    float s = 0.f;
#pragma unroll
    for (int j = 0; j < 16; ++j) { const f32x4 v = unpack4(w[j]); s += (v.x * v.x + v.y * v.y) + (v.z * v.z + v.w * v.w); }
    return 1.0f / sqrtf(wave_sum(s) * (1.0f / DM) + RMS_EPS);
}
__device__ __forceinline__ void row_store_f32(float* p, int lane, const f32x4 (&v)[16]) {
    GAS f32x4* r = (GAS f32x4*)p + lane;
#pragma unroll
    for (int j = 0; j < 16; ++j) r[64 * j] = v[j];
}
__device__ __forceinline__ void row_store_bf16(bf16* p, int lane, const f32x4 (&v)[16]) {
    GAS v2u* o = (GAS v2u*)p + lane;
#pragma unroll
    for (int j = 0; j < 16; ++j) { v2u w; w.x = pk2(v[j].x, v[j].y); w.y = pk2(v[j].z, v[j].w); o[64 * j] = w; }
}
__device__ __forceinline__ float row_rstd(const f32x4 (&v)[16]) {
    float s = 0.f;
#pragma unroll
    for (int j = 0; j < 16; ++j) s += (v[j].x * v[j].x + v[j].y * v[j].y) + (v[j].z * v[j].z + v[j].w * v[j].w);
    return 1.0f / sqrtf(wave_sum(s) * (1.0f / DM) + RMS_EPS);
}
__device__ __forceinline__ void row_norm_store_both(bf16* orow, unsigned char* o8row, int lane, const f32x4 (&v)[16], float rstd, const LAS f32x4* g) {
    GAS v2u* o = (GAS v2u*)orow + lane; GAS unsigned* o8 = (GAS unsigned*)o8row + lane;
#pragma unroll
    for (int j = 0; j < 16; ++j) { const f32x4 gg = g[lane + 64 * j]; const float a = v[j].x * rstd * gg.x, b = v[j].y * rstd * gg.y, c = v[j].z * rstd * gg.z, d = v[j].w * rstd * gg.w;
        v2u w; w.x = pk2(a, b); w.y = pk2(c, d); o[64 * j] = w;
        o8[64 * j] = pg8::pack_fp8x4(a * pg8::F8_USCALE, b * pg8::F8_USCALE, c * pg8::F8_USCALE, d * pg8::F8_USCALE); }
}
__device__ __forceinline__ void row_store_bf16_fp8(bf16* orow, unsigned char* o8row, int lane, const f32x4 (&v)[16]) {
    GAS v2u* o = (GAS v2u*)orow + lane; GAS unsigned* o8 = (GAS unsigned*)o8row + lane;
#pragma unroll
    for (int j = 0; j < 16; ++j) { v2u w; w.x = pk2(v[j].x, v[j].y); w.y = pk2(v[j].z, v[j].w); o[64 * j] = w;
        o8[64 * j] = pg8::pack_fp8x4(v[j].x * pg8::F8_USCALE, v[j].y * pg8::F8_USCALE, v[j].z * pg8::F8_USCALE, v[j].w * pg8::F8_USCALE); }
}
__device__ __forceinline__ void row_norm_store_bf16(bf16* orow, int lane, const f32x4 (&v)[16], float rstd, const LAS f32x4* g) {
    GAS v2u* o = (GAS v2u*)orow + lane;
#pragma unroll
    for (int j = 0; j < 16; ++j) { const f32x4 gg = g[lane + 64 * j]; v2u w; w.x = pk2(v[j].x * rstd * gg.x, v[j].y * rstd * gg.y); w.y = pk2(v[j].z * rstd * gg.z, v[j].w * rstd * gg.w); o[64 * j] = w; }
}

typedef short s_bf16x8 __attribute__((ext_vector_type(8)));
template <int NX, class Task>
__device__ __forceinline__ void skinny16(Frame& F, int K, int ntasks, const Task& T) {
    const int wid = F.wave, lane = F.lane, fr = lane & 15, fq = lane >> 4;
    LAS f32x4* part = (LAS f32x4*)(F.lds + RING_OFF);
    const int spw = K / 256;
    for (int task = blockIdx.x; task < ntasks; task += F.G) {
        const bf16* xp[NX]; const bf16* yp; int ldx, ldy; T.ptrs(task, xp, yp, ldx, ldy);
        f32x4 acc[NX];
#pragma unroll
        for (int n = 0; n < NX; ++n) acc[n] = (f32x4){0.f, 0.f, 0.f, 0.f};
        const unsigned koff = (unsigned)(wid * spw * 32 + 8 * fq);
        const unsigned ylane = (unsigned)(fr * ldy), xlane = (unsigned)(fr * ldx);
        for (int s = 0; s < spw; s += 8) {
            s_bf16x8 yv[8], xv[NX][8];
#pragma unroll
            for (int i = 0; i < 8; ++i) if (s + i < spw) { const unsigned k = koff + 32u * (unsigned)(s + i);
                yv[i] = *(const GAS s_bf16x8*)((const GAS char*)yp + (size_t)((ylane + T.ykoff(k)) * 2u));
#pragma unroll
                for (int n = 0; n < NX; ++n) xv[n][i] = *(const GAS s_bf16x8*)((const GAS char*)xp[n] + (size_t)((xlane + T.xkoff(k)) * 2u)); }
#pragma unroll
            for (int i = 0; i < 8; ++i) if (s + i < spw) {
#pragma unroll
                for (int n = 0; n < NX; ++n) acc[n] = __builtin_amdgcn_mfma_f32_16x16x32_bf16(xv[n][i], yv[i], acc[n], 0, 0, 0); }
        }
#pragma unroll
        for (int n = 0; n < NX; ++n) part[(wid * NX + n) * 64 + lane] = acc[n];
        LDS_WAIT(); __syncthreads();
        if (wid == 0) { f32x4 v[NX];
#pragma unroll
            for (int n = 0; n < NX; ++n) { v[n] = part[n * 64 + lane];
#pragma unroll
                for (int w = 1; w < NWAVES; ++w) v[n] = v[n] + part[(w * NX + n) * 64 + lane]; }
            T.store(task, fr, fq, v); }
        LDS_WAIT(); __syncthreads();
    }
}
__device__ __forceinline__ float sigm_f(float x) { return __builtin_amdgcn_rcpf(1.0f + __builtin_amdgcn_exp2f(-LOG2E * x)); }
constexpr size_t HID_PSTR = (size_t)MT * 4096;
struct SkGateUp {
    const bf16* WGU; const bf16* U; bf16* HID; const float* rs;
    __device__ __forceinline__ unsigned ykoff(unsigned k) const { return k; }
    __device__ __forceinline__ unsigned xkoff(unsigned k) const { return k; }
    __device__ __forceinline__ void ptrs(int t, const bf16* (&xp)[2], const bf16*& yp, int& ldx, int& ldy) const { xp[0] = WGU + (size_t)(256 * (t >> 3) + 16 * (t & 7)) * DM; xp[1] = xp[0] + (size_t)128 * DM; yp = U + (size_t)MR * PU; ldx = DM; ldy = PU; }
    __device__ __forceinline__ void store(int t, int fr, int fq, const f32x4 (&vv)[2]) const {
        const float r = rs[MR + fr]; const f32x4 v[2] = {vv[0] * r, vv[1] * r};
        v2u w; w.x = pk2(v[0][0] * sigm_f(v[0][0]) * v[1][0], v[0][1] * sigm_f(v[0][1]) * v[1][1]); w.y = pk2(v[0][2] * sigm_f(v[0][2]) * v[1][2], v[0][3] * sigm_f(v[0][3]) * v[1][3]);
        const int c = 16 * t + 4 * fq; *(GAS v2u*)(HID + (size_t)(c >> 12) * HID_PSTR + (size_t)(MR + fr) * 4096 + (c & 4095)) = w; }
};
struct SkDown {
    const bf16* WD; const bf16* HID; bf16* Y;
    __device__ __forceinline__ unsigned ykoff(unsigned k) const { return (k >> 12) * (unsigned)HID_PSTR + (k & 4095u); }
    __device__ __forceinline__ unsigned xkoff(unsigned k) const { return (k >> 12) * (unsigned)WD_PSTR + (k & 4095u); }
    __device__ __forceinline__ void ptrs(int t, const bf16* (&xp)[1], const bf16*& yp, int& ldx, int& ldy) const { xp[0] = WD + (size_t)(16 * t) * 4096; yp = HID + (size_t)MR * 4096; ldx = 4096; ldy = 4096; }
    __device__ __forceinline__ void store(int t, int fr, int fq, const f32x4 (&v)[1]) const {
        v2u w; w.x = pk2(v[0][0], v[0][1]); w.y = pk2(v[0][2], v[0][3]); *(GAS v2u*)(Y + (size_t)(MR + fr) * DM + 16 * t + 4 * fq) = w; }
};
struct SkWin {
    const bf16* WIN; const bf16* U; bf16* QKV; float* FLOG; const float* rs;
    __device__ __forceinline__ unsigned ykoff(unsigned k) const { return k; }
    __device__ __forceinline__ unsigned xkoff(unsigned k) const { return k; }
    __device__ __forceinline__ void ptrs(int t, const bf16* (&xp)[1], const bf16*& yp, int& ldx, int& ldy) const { ldx = DM; ldy = PU;
        if (t < 1025) { xp[0] = WIN + (size_t)20480 * DM; yp = U + (size_t)(16 * t) * PU; } else { xp[0] = WIN + (size_t)(4096 + 16 * (t - 1025)) * DM; yp = U + (size_t)MR * PU; } }
    __device__ __forceinline__ void store(int t, int fr, int fq, const f32x4 (&vv)[1]) const {
        const f32x4 v[1] = {vv[0] * rs[t < 1025 ? 16 * t + fr : MR + fr]};
        if (t < 1025) { *(GAS f32x4*)(FLOG + (size_t)(16 * t + fr) * 16 + 4 * fq) = v[0]; }
        else { v2u w; w.x = pk2(v[0][0], v[0][1]); w.y = pk2(v[0][2], v[0][3]); *(GAS v2u*)(QKV + (size_t)(MR + fr) * PQKV + 4096 + 16 * (t - 1025) + 4 * fq) = w; } }
};
constexpr int G0_OFF = 0, G1_OFF = 16384;

__device__ __forceinline__ void norm0_row(bf16* U, float* RS, int m, int lane, const f32x4 (&v)[16]) {
    const float rstd = row_rstd(v);
    row_store_bf16(U + (size_t)m * PU, lane, v);
    if (lane == 0) RS[m] = rstd;
}
__device__ __forceinline__ void phase_norm0(Frame& F, KP kp) {
    const float* x = karg<const float>(kp, A_X); const float* meta = karg<const float>(kp, A_META); bf16* U = wsp<bf16>(kp, WS_U); float* RS = wsp<float>(kp, WS_RS0);
    const int gw = F.vcu * NWAVES + F.wave, NGW = F.G * NWAVES;
    constexpr int M = MR + NMETA;
    int m = gw;
    f32x4 va[16], vb[16];
    if (m < M) row_load_f32(m < MR ? x + (size_t)m * DM : meta + (size_t)(m - MR) * DM, F.lane, va);
    while (m < M) {
        const int m1 = m + NGW;
        if (m1 < M) row_load_f32(m1 < MR ? x + (size_t)m1 * DM : meta + (size_t)(m1 - MR) * DM, F.lane, vb);
        norm0_row(U, RS, m, F.lane, va);
        if (m1 >= M) break;
        const int m2 = m1 + NGW;
        if (m2 < M) row_load_f32(m2 < MR ? x + (size_t)m2 * DM : meta + (size_t)(m2 - MR) * DM, F.lane, va);
        norm0_row(U, RS, m1, F.lane, vb);
        m = m2;
    }
    __syncthreads();
}
template <int STEP>
__device__ __forceinline__ void post_row(float* out, bf16* U, unsigned char* U8, float* RS, const LAS f32x4* g0, int m, int lane, const v2u (&y)[16], const v2u (&hp)[16]) {
    asm volatile("" ::: "memory");
    const float ry = (STEP == 2 ? 1.0f : 0.5f) * row_rstd_p(y);
    GAS f32x4* of = (GAS f32x4*)(out + (size_t)m * DM) + lane; GAS v2u* ob = (GAS v2u*)(U + (size_t)m * PU) + lane; GAS unsigned* o8 = (GAS unsigned*)(U8 + (size_t)m * DM) + lane;
    float ss = 0.f;
#pragma unroll
    for (int j = 0; j < 16; ++j) { const f32x4 gg = g0[lane + 64 * j]; const f32x4 h = unpack4(hp[j]) + unpack4(y[j]) * ry * gg;
        if (STEP == 3) of[64 * j] = h;
        else { ss += (h.x * h.x + h.y * h.y) + (h.z * h.z + h.w * h.w);
            v2u w; w.x = pk2(h.x, h.y); w.y = pk2(h.z, h.w); ob[64 * j] = w;
            if (m < MR) o8[64 * j] = pg8::pack_fp8x4(h.x * pg8::F8_USCALE, h.y * pg8::F8_USCALE, h.z * pg8::F8_USCALE, h.w * pg8::F8_USCALE); } }
    if (STEP != 3) { const float rh = 1.0f / sqrtf(wave_sum(ss) * (1.0f / DM) + RMS_EPS); if (lane == 0) RS[m] = rh; }
}
template <int STEP>
__device__ __forceinline__ void phase_post(Frame& F, KP kp) {
    float* out = karg<float>(kp, A_OUT); bf16* U = wsp<bf16>(kp, WS_U); const bf16* Y = wsp<bf16>(kp, WS_Y); unsigned char* U8 = wsp<unsigned char>(kp, WS_U8);
    float* RS = wsp<float>(kp, STEP == 1 ? WS_RS1 : WS_RS2);
    gain_to_lds(F, karg<const float>(kp, STEP == 1 ? A_G_FF1_POST : STEP == 2 ? A_G_MIX_POST : A_G_FF2_POST), G0_OFF); LDS_WAIT(); __syncthreads();
    const LAS f32x4* g0 = (const LAS f32x4*)(F.lds + G0_OFF);
    const int gw = F.vcu * NWAVES + F.wave, NGW = F.G * NWAVES;
    constexpr int M = (STEP == 1 ? MR + NMETA : MR);
    int m = gw;
    v2u ya[16], ha[16], yb[16], hb[16];
    if (m < M) { row_load_bf16p(Y + (size_t)m * DM, F.lane, ya); row_load_bf16p(U + (size_t)m * PU, F.lane, ha); }
    while (m < M) {
        const int m1 = m + NGW;
        if (m1 < M) { row_load_bf16p(Y + (size_t)m1 * DM, F.lane, yb); row_load_bf16p(U + (size_t)m1 * PU, F.lane, hb); }
        post_row<STEP>(out, U, U8, RS, g0, m, F.lane, ya, ha);
        if (m1 >= M) break;
        const int m2 = m1 + NGW;
        if (m2 < M) { row_load_bf16p(Y + (size_t)m2 * DM, F.lane, ya); row_load_bf16p(U + (size_t)m2 * PU, F.lane, ha); }
        post_row<STEP>(out, U, U8, RS, g0, m1, F.lane, yb, hb);
        m = m2;
    }
    __syncthreads();
}
__device__ __forceinline__ void phase_scan(Frame& F, KP kp) {
    const float* b_forget = karg<const float>(kp, A_B_FORGET); const float* FLOG = wsp<float>(kp, WS_FLOG); float* KB = wsp<float>(kp, WS_KB); int* JLO = wsp<int>(kp, WS_JLO);
    const int gw = F.vcu * NWAVES + F.wave, NGW = F.G * NWAVES;
    for (int task = gw; task < NB * 16; task += NGW) {
        const int b = task >> 4, h = task & 15; const float bf = b_forget[h];
        float v[65];
        const int dbase = 65 * F.lane - 64, sel = MR + 16 - b * SEQ;
#pragma unroll
        for (int k = 0; k < 65; ++k) { const int d = dbase + k; const int row = d + b * SEQ + ((d >> 31) & sel);
            v[k] = FLOG[(size_t)(unsigned)row * 16 + h]; }
        float run = 0.f;
#pragma unroll
        for (int k = 0; k < 65; ++k) { const int e = 65 * F.lane + k; const float z = v[k] + bf;
            const float ez = __builtin_amdgcn_exp2f(-LOG2E * fabsf(z));
            const float ls = fminf(z, 0.f) - 0.6931471805599453f * __builtin_amdgcn_logf(1.0f + ez);
            const unsigned keep = ~(unsigned)((e - 48) >> 31);
            run += __uint_as_float(__float_as_uint(ls) & keep); v[k] = run; }
        float incl = run;
#pragma unroll
        for (int d = 1; d < 64; d <<= 1) { const float o = __shfl_up(incl, d); if (F.lane >= d) incl += o; }
        const float off = incl - run;
        float* kb = KB + (size_t)task * EKV + 65 * F.lane;
#pragma unroll
        for (int k = 0; k < 65; ++k) kb[k] = -ISCALE * (off + v[k]);
        asm volatile("s_waitcnt vmcnt(0)" ::: "memory");
        const float* kbrow = KB + (size_t)task * EKV;
        const float tend = __hip_atomic_load(kbrow + 64 * F.lane + 63, __ATOMIC_RELAXED, __HIP_MEMORY_SCOPE_AGENT);
        int* jlo = JLO + task * 16;
        const float q0l = __hip_atomic_load(kbrow + 64 + 256 * (F.lane & 15), __ATOMIC_RELAXED, __HIP_MEMORY_SCOPE_AGENT);
#pragma unroll
        for (int qb = 0; qb < 16; ++qb) {
            const float q0 = __builtin_amdgcn_readlane(q0l, qb);
            const unsigned long long keepm = __ballot(q0 - tend < SKIP_TH * ISCALE);
            int j = keepm ? __builtin_ctzll(keepm) : 0; j = (j > 4 * qb ? 4 * qb : j) & ~1;
            if (F.lane == 0) jlo[qb] = j;
        }
    }
}
template <bool PROBE_OUT> __device__ __forceinline__ void phase_diffnorm(Frame& F, KP kp) {
    const float* lq1 = karg<const float>(kp, A_LQ1); const float* lk1 = karg<const float>(kp, A_LK1); const float* lq2 = karg<const float>(kp, A_LQ2); const float* lk2 = karg<const float>(kp, A_LK2);
    const float* g_subln = karg<const float>(kp, A_G_SUBLN); bf16* AO = wsp<bf16>(kp, WS_AO);
    const int gw = F.vcu * NWAVES + F.wave, NGW = F.G * NWAVES;
    const float s1 = wave_sum(lq1[F.lane] * lk1[F.lane] + lq1[F.lane + 64] * lk1[F.lane + 64]);
    const float s2 = wave_sum(lq2[F.lane] * lk2[F.lane] + lq2[F.lane + 64] * lk2[F.lane + 64]);
    const float lam = expf(s1) - expf(s2) + LAMBDA_INIT;
    const int h = F.lane >> 3, sub = F.lane & 7;
    float gsub[32];
#pragma unroll
    for (int i = 0; i < 32; ++i) gsub[i] = g_subln[sub * 32 + i] * (1.0f - LAMBDA_INIT);
    for (int m = gw; m < MR; m += NGW) {
        const GAS v4u* p1 = (const GAS v4u*)(AO + (size_t)m * PAO + 2048 + h * 512 + sub * 32);
        const GAS v4u* p2 = (const GAS v4u*)(AO + (size_t)m * PAO + 2048 + h * 512 + 256 + sub * 32);
        float d[32]; float ss = 0.f;
#pragma unroll
        for (int q = 0; q < 4; ++q) { const v4u a = p1[q], b = p2[q];
            const unsigned aw[4] = {a.x, a.y, a.z, a.w}, bw[4] = {b.x, b.y, b.z, b.w};
#pragma unroll
            for (int i = 0; i < 4; ++i) { const float d0 = bflo(aw[i]) - lam * bflo(bw[i]), d1 = bfhi(aw[i]) - lam * bfhi(bw[i]); d[8 * q + 2 * i] = d0; d[8 * q + 2 * i + 1] = d1; ss += d0 * d0 + d1 * d1; } }
        ss += __shfl_xor(ss, 1); ss += __shfl_xor(ss, 2); ss += __shfl_xor(ss, 4);
        const float rstd = 1.0f / sqrtf(ss * (1.0f / 256.0f) + RMS_EPS);
        asm volatile("s_waitcnt vmcnt(0)" ::: "memory");
        GAS v4u* o = PROBE_OUT ? (GAS v4u*)(wsp<bf16>(kp, WS_MG) + (size_t)m * 4096 + h * 256 + sub * 32) : (GAS v4u*)(AO + (size_t)m * PAO + 2048 + h * 256 + sub * 32);
#pragma unroll
        for (int q = 0; q < 4; ++q) { v4u w;
            w.x = pk2(d[8 * q + 0] * rstd * gsub[8 * q + 0], d[8 * q + 1] * rstd * gsub[8 * q + 1]); w.y = pk2(d[8 * q + 2] * rstd * gsub[8 * q + 2], d[8 * q + 3] * rstd * gsub[8 * q + 3]);
            w.z = pk2(d[8 * q + 4] * rstd * gsub[8 * q + 4], d[8 * q + 5] * rstd * gsub[8 * q + 5]); w.w = pk2(d[8 * q + 6] * rstd * gsub[8 * q + 6], d[8 * q + 7] * rstd * gsub[8 * q + 7]);
            o[q] = w; }
    }
}
constexpr int est_nt(int vh, int qb) {
    const int ntabs = 4 * qb + 5;
    if (vh < 16) return ntabs < 17 ? ntabs : 17;
    const int h = (vh - 16) >> 2, W = 44 << (h + 1);
    int jlo = 64 + 256 * qb - W; jlo = jlo < 0 ? 0 : jlo / 64; jlo &= ~1;
    return ntabs - jlo;
}
struct ItemTab { unsigned short v[3072]; };
constexpr ItemTab make_items() {
    ItemTab t{}; int n = 0;
    for (int key = 65; key >= 1; --key)
        for (int vh = 0; vh < 48; ++vh) for (int qb = 0; qb < 16; ++qb) if (est_nt(vh, qb) == key)
            for (int b = 0; b < 4; ++b) t.v[n++] = (unsigned short)((b << 10) | (vh << 4) | qb);
    return t;
}
__device__ const ItemTab ITEMS = make_items();
template <int PROBE> __device__ __forceinline__ att::BlockRef attn_ref(const bf16* QKV, bf16* AO, const float* KB, const int* JLO, int idx) {
    const unsigned it = ITEMS.v[idx];
    const int b = it >> 10, vh = (it >> 4) & 63, qb = it & 15;
    att::BlockRef r; r.rowb = b * SEQ; r.P0 = 64 + 256 * qb; r.probe = PROBE == 2;
    const bf16* rowq = QKV + (size_t)(b * SEQ + 256 * qb) * PQKV; bf16* rowo = AO + (size_t)(b * SEQ + 256 * qb) * PAO;
    if (vh < 16) { const int h = vh; r.Q = rowq + h * 128; r.K = QKV + 4096 + h * 128; r.V = QKV + 6144 + h * 128; r.O = rowo + h * 128;
        r.kb = KB + (size_t)(b * 16 + h) * EKV; r.sl2 = 0.f; r.jlo = JLO[(b * 16 + h) * 16 + qb]; }
    else { const int dv = vh - 16, h = dv >> 2, c = (dv >> 1) & 1, jv = dv & 1;
        r.Q = rowq + 2048 + h * 256 + c * 128; r.K = QKV + 8192 + h * 256 + c * 128; r.V = QKV + 10240 + h * 256 + jv * 128;
        r.O = rowo + 2048 + h * 512 + c * 256 + jv * 128;
        r.kb = nullptr; r.sl2 = ISCALE * __builtin_amdgcn_exp2f(-(float)(h + 1));
        const int W = (int)SKIP_TH << (h + 1);
        int j = r.P0 - W; j = j < 0 ? 0 : j >> 6; r.jlo = j & ~1; }
    return r;
}
template <int PROBE> __device__ __forceinline__ void phase_attn(Frame& F, KP kp, char* lds) {
    constexpr int TOTAL = 3072;
    const bf16* QKV = wsp<bf16>(kp, WS_BIG); bf16* AO = wsp<bf16>(kp, WS_AO); const float* KB = wsp<float>(kp, WS_KB); const int* JLO = wsp<int>(kp, WS_JLO);
    unsigned* qhead = wsp<unsigned>(kp, WS_CTL) + CW_Q + (PROBE ? 64 : 0);
    volatile int* qs = (volatile int*)(lds + att::OFF_Q);
    if (F.tid == 0) { qs[0] = (int)__hip_atomic_fetch_add(qhead, 1u, __ATOMIC_RELAXED, __HIP_MEMORY_SCOPE_AGENT); qs[1] = (int)__hip_atomic_fetch_add(qhead, 1u, __ATOMIC_RELAXED, __HIP_MEMORY_SCOPE_AGENT); }
    __syncthreads();
    int icur = __builtin_amdgcn_readfirstlane(qs[0]), inxt = __builtin_amdgcn_readfirstlane(qs[1]);
    if (icur >= TOTAL) return;
    att::BlockRef cur = attn_ref<PROBE>(QKV, AO, KB, JLO, icur);
    att::Seam S;
    att::attn_prime(F.tid, cur, lds, S);
    for (;;) {
        unsigned claim = 0u; if (F.tid == 0) claim = __hip_atomic_fetch_add(qhead, 1u, __ATOMIC_RELAXED, __HIP_MEMORY_SCOPE_AGENT);
        const bool last = inxt >= TOTAL;
        const att::BlockRef nxt = last ? cur : attn_ref<PROBE>(QKV, AO, KB, JLO, inxt);
        att::attn_block(F.tid, cur, nxt, lds, S);
        if (last) break;
        if (F.tid == 0) qs[0] = (int)claim;
        __syncthreads();
        cur = nxt; inxt = __builtin_amdgcn_readfirstlane(qs[0]);
    }
}

#ifndef Y_NT
#define Y_NT 1
#endif
#ifndef PROBE_NT
#define PROBE_NT 1
#endif
#ifndef PROBE_ROWS
#define PROBE_ROWS 4096
#endif
#ifndef PROBE_DUP
#define PROBE_DUP 0
#endif
#ifndef PH
#define PH 0xFFFFF
#endif
#ifndef DUP
#define DUP 0
#endif
#ifndef DUP_ROWS
#define DUP_ROWS 4096
#endif
#ifndef ATT_PROBE
#define ATT_PROBE 1
#endif
#ifndef WGM_DOWN
#define WGM_DOWN 2
#endif
#ifndef ALIGN_SWIGLU
#define ALIGN_SWIGLU 1
#endif
#ifndef FFN2_F8
#define FFN2_F8 1
#endif
#ifndef TR_BIG
#define TR_BIG 0
#endif
#ifndef WGM_BIG
#define WGM_BIG 8
#endif
struct Args { const float* in[24]; float* out; unsigned char* ws; };
__global__ void __launch_bounds__(NWAVES * 64, 2) mega_fwd(Args args) {
    extern __shared__ __attribute__((aligned(16))) unsigned char lds[];
    Frame F;
    F.lds = (LAS unsigned char*)lds;
    F.wave = __builtin_amdgcn_readfirstlane((int)threadIdx.x >> 6);
    F.G = gridDim.x; { const int bx = blockIdx.x; F.vcu = (F.G % 8 == 0) ? (bx % 8) * (F.G / 8) + bx / 8 : bx; }
    frame_refresh(F);
    for (int u = F.tid; u < (LDS_BYTES - LDSCTL_OFF) / 4; u += NWAVES * 64) ((LAS unsigned*)(F.lds + LDSCTL_OFF))[u] = 0u;
    __syncthreads();
    (void)xcd_barrier_post(wsp<unsigned>(kargs(), WS_CTL) + CW_BAR, (volatile LAS unsigned*)(F.lds + MISC_OFF) + 8, F.tid);
    if (args.ws == nullptr) return;
#define GRID_BAR() do { frame_refresh(F); XcdBarrier b_; b_.bar = wsp<unsigned>(kargs(), WS_CTL) + CW_BAR; b_.x = xb_xcc_id(); b_.st = (volatile LAS unsigned*)(F.lds + MISC_OFF) + 8; xcd_barrier(b_, F.tid); } while (0)
#define GEMM_PHASE(EPI) do { frame_refresh(F); pg8::gemm_phase<EPI, pg8::StaticOrder, true>(F.lds + RING_OFF, F.tid, g, S, E); } while (0)
#define GEMM_PHASE_SW(EPI) do { frame_refresh(F); pg8::gemm_phase<EPI, pg8::StaticOrder, (ALIGN_SWIGLU != 0)>(F.lds + RING_OFF, F.tid, g, S, E); } while (0)

    { KP kp = kargs(); frame_refresh(F);
      convert_ffn<3>(F, kp, A_W_GATE1, A_W_UP1, A_W_DOWN1, A_G_FF1_PRE);
      __syncthreads();
      phase_norm0(F, kp); }
#if PROBE_DUP & 1
    GRID_BAR();
    { KP kp = kargs(); frame_refresh(F);
      convert_ffn<3>(F, kp, A_W_GATE1, A_W_UP1, A_W_DOWN1, A_G_FF1_PRE);
      __syncthreads();
      phase_norm0(F, kp); }
#endif
    GRID_BAR();
    { KP kp = kargs(); frame_refresh(F); SkGateUp T{wsp<bf16>(kp, WS_WGU), wsp<bf16>(kp, WS_U), wsp<bf16>(kp, WS_BIG), wsp<float>(kp, WS_RS0)}; skinny16<2>(F, DM, DFF / 16, T); }
    { KP kp = kargs(); pg8::Gemm g{wsp<bf16>(kp, WS_U), wsp<bf16>(kp, WS_WGU), MR, NGU, DM, PU, DM}; pg8::StaticOrder S; S.init(MR, NGU, F.G, (int)blockIdx.x, WGM_BIG, TR_BIG);
      pg8::EpiSwiGLU E{wsp<bf16>(kp, WS_BIG), HID_PSTR, wsp<float>(kp, WS_RS0)}; GEMM_PHASE_SW(pg8::EpiSwiGLU); }
    { KP kp = kargs(); frame_refresh(F); convert_mixer_queue(F, kp); __syncthreads(); }
    GRID_BAR();
    { KP kp = kargs(); frame_refresh(F); SkDown T{wsp<bf16>(kp, WS_WD), wsp<bf16>(kp, WS_BIG), wsp<bf16>(kp, WS_Y)}; skinny16<1>(F, DFF, DM / 16, T); }
    { KP kp = kargs(); pg8::Gemm g{wsp<bf16>(kp, WS_BIG), wsp<bf16>(kp, WS_WD), MR, DM, DFF, 4096, 4096, 6, 6, HID_PSTR * 2, WD_PSTR * 2}; pg8::StaticOrder S; S.init(MR, DM, F.G, (int)blockIdx.x, WGM_DOWN);
      pg8::EpiPlain E{wsp<bf16>(kp, WS_Y), DM, 1.0f, Y_NT}; GEMM_PHASE(pg8::EpiPlain); }
    GRID_BAR();
    { KP kp = kargs(); frame_refresh(F); phase_post<1>(F, kp); }
    GRID_BAR();
#if PROBE_DUP & 16
    GRID_BAR(); GRID_BAR(); GRID_BAR(); GRID_BAR(); GRID_BAR(); GRID_BAR(); GRID_BAR(); GRID_BAR(); GRID_BAR(); GRID_BAR();
#endif
#if PROBE_DUP & 32
#endif
    { KP kp = kargs(); frame_refresh(F); SkWin T{wsp<bf16>(kp, WS_WIN), wsp<bf16>(kp, WS_U), wsp<bf16>(kp, WS_BIG), wsp<float>(kp, WS_FLOG), wsp<float>(kp, WS_RS1)}; skinny16<1>(F, DM, 1025 + 512, T); }
    { KP kp = kargs(); pg8::Gemm g{wsp<bf16>(kp, WS_U), wsp<bf16>(kp, WS_WIN), MR, 12288, DM, PU, DM}; pg8::StaticOrder S; S.init(MR, 12288, F.G, (int)blockIdx.x, WGM_BIG, TR_BIG);
      pg8::EpiWin E{wsp<bf16>(kp, WS_BIG), wsp<bf16>(kp, WS_GATES), wsp<float>(kp, WS_RS1)}; GEMM_PHASE(pg8::EpiWin); }
    { KP kp = kargs(); pg8::Gemm g{wsp<bf16>(kp, WS_U8), wsp<bf16>(kp, WS_WIN8), MR, 8192, DM / 2, 2048, 2048}; pg8::StaticOrder S; S.init(MR, 8192, F.G, (int)blockIdx.x, WGM_BIG, TR_BIG);
      pg8::EpiPlainRS E{wsp<bf16>(kp, WS_GATES), 8192, 1.0f / (pg8::F8_USCALE * pg8::F8_WINSCALE), wsp<float>(kp, WS_RS1)};
      frame_refresh(F); pg8::gemm_phase<pg8::EpiPlainRS, pg8::StaticOrder, true, pg8::MidNone, true>(F.lds + RING_OFF, F.tid, g, S, E); }
    GRID_BAR();
    { KP kp = kargs(); frame_refresh(F); phase_scan(F, kp); }
    GRID_BAR();
#if PROBE_DUP & 4
    { KP kp = kargs(); frame_refresh(F); phase_attn<1>(F, kp, (char*)lds + RING_OFF); }
    GRID_BAR();
#endif
    { KP kp = kargs(); frame_refresh(F); phase_attn<0>(F, kp, (char*)lds + RING_OFF); }
    GRID_BAR();
    { KP kp = kargs(); frame_refresh(F); phase_diffnorm<false>(F, kp); }
    GRID_BAR();
    { KP kp = kargs(); pg8::Gemm g{wsp<bf16>(kp, WS_AO), wsp<bf16>(kp, WS_WO), MR, DM, 4096, PAO, 4096}; pg8::StaticOrder S; S.init(MR, DM, F.G, (int)blockIdx.x);
      pg8::EpiGateOut E{wsp<bf16>(kp, WS_MG), wsp<bf16>(kp, WS_GATES)}; pg8::MidGate MH{32, wsp<bf16>(kp, WS_GATES)};
      frame_refresh(F); pg8::gemm_phase<pg8::EpiGateOut, pg8::StaticOrder, true, pg8::MidGate>(F.lds + RING_OFF, F.tid, g, S, E, MH); }
    GRID_BAR();
    { KP kp = kargs(); pg8::Gemm g{wsp<bf16>(kp, WS_MG), wsp<bf16>(kp, WS_WOUT), MR, DM, DM, DM, DM}; pg8::StaticOrder S; S.init(MR, DM, F.G, (int)blockIdx.x);
      pg8::EpiPlain E{wsp<bf16>(kp, WS_Y), DM, 1.0f, Y_NT}; GEMM_PHASE(pg8::EpiPlain); }
#if PROBE_DUP & 8
    GRID_BAR();
    { KP kp = kargs(); pg8::Gemm g{wsp<bf16>(kp, WS_MG), wsp<bf16>(kp, WS_WOUT), PROBE_ROWS, DM, DM, DM, DM}; pg8::StaticOrder S; S.init(PROBE_ROWS, DM, F.G, (int)blockIdx.x);
      pg8::EpiPlain E{wsp<bf16>(kp, WS_Y), DM, 1.0f, PROBE_NT}; GEMM_PHASE(pg8::EpiPlain); }
#endif
    { KP kp = kargs(); frame_refresh(F); convert_ffn<5>(F, kp, A_W_GATE2, A_W_UP2, A_W_DOWN2, A_G_FF2_PRE); __syncthreads(); }
    GRID_BAR();
    { KP kp = kargs(); frame_refresh(F); phase_post<2>(F, kp); }
    GRID_BAR();
    { KP kp = kargs(); pg8::Gemm g{wsp<bf16>(kp, WS_U), wsp<bf16>(kp, WS_WGU), MR, GU8_ROW0, DM, PU, DM}; pg8::StaticOrder S; S.init(MR, GU8_ROW0, F.G, (int)blockIdx.x, WGM_BIG, TR_BIG);
      pg8::EpiSwiGLU8 E{wsp<unsigned char>(kp, WS_BIG), (size_t)MT * 4096, wsp<float>(kp, WS_RS2)}; GEMM_PHASE_SW(pg8::EpiSwiGLU8); }
    { KP kp = kargs(); pg8::Gemm g{wsp<bf16>(kp, WS_U8), wsp<bf16>(kp, WS_WGU8), MR, GU8_TILES * 256, DM / 2, 2048, 2048}; pg8::StaticOrder S; S.init(MR, GU8_TILES * 256, F.G, (int)blockIdx.x, WGM_BIG, TR_BIG);
      pg8::EpiSwiGLU8 E{wsp<unsigned char>(kp, WS_BIG), (size_t)MT * 4096, wsp<float>(kp, WS_RS2), 86 - GU8_TILES, 1.0f / (pg8::F8_USCALE * pg8::F8_WINSCALE)};
      frame_refresh(F); pg8::gemm_phase<pg8::EpiSwiGLU8, pg8::StaticOrder, true, pg8::MidNone, true>(F.lds + RING_OFF, F.tid, g, S, E); }
    { KP kp = kargs(); frame_refresh(F); convert_down_queue8(F, kp, A_W_DOWN2, CW_CQ2); __syncthreads(); }
    GRID_BAR();
    { KP kp = kargs(); pg8::Gemm g{wsp<bf16>(kp, WS_BIG), wsp<bf16>(kp, WS_WD), MR, DM, DFF / 2, 2048, 2048, 5, 5, (size_t)MT * 4096, WD_PSTR}; pg8::StaticOrder S; S.init(MR, DM, F.G, (int)blockIdx.x, WGM_DOWN);
      pg8::EpiPlain E{wsp<bf16>(kp, WS_Y), DM, 1.0f / (pg8::F8_HSCALE * pg8::F8_WSCALE), Y_NT};
      frame_refresh(F); pg8::gemm_phase<pg8::EpiPlain, pg8::StaticOrder, true, pg8::MidNone, true>(F.lds + RING_OFF, F.tid, g, S, E); }
    GRID_BAR();
    { KP kp = kargs(); frame_refresh(F); phase_post<3>(F, kp); }
#if PROBE_DUP & 2
    GRID_BAR();
    { KP kp = kargs(); frame_refresh(F); phase_post<3>(F, kp); }
#endif
#undef GRID_BAR
#undef GEMM_PHASE
#undef GEMM_PHASE_SW
}

extern "C" void kernel_launch(void* const* d_in, const int* in_sizes, int n_in, void* d_out, int out_size, void* d_ws, size_t ws_size, hipStream_t stream) {
    static int grid = 0;
    if (grid == 0) {
        if (n_in != 24 || in_sizes[0] != MR * DM || out_size != MR * DM || ws_size < WS_END) { fprintf(stderr, "kernel_launch: shape/workspace mismatch (n_in %d, in0 %d, out %d, ws %zu, need %zu)\n", n_in, n_in > 0 ? in_sizes[0] : -1, out_size, ws_size, (size_t)WS_END); grid = -1; return; }
        int dev = 0, cus = 0;
        if (hipGetDevice(&dev) != hipSuccess || hipDeviceGetAttribute(&cus, hipDeviceAttributeMultiprocessorCount, dev) != hipSuccess) { grid = -1; return; }
        if (hipFuncSetAttribute((const void*)mega_fwd, hipFuncAttributeMaxDynamicSharedMemorySize, LDS_BYTES) != hipSuccess) { fprintf(stderr, "kernel_launch: hipFuncSetAttribute failed\n"); grid = -1; return; }
        int per_cu = 0;
        if (hipOccupancyMaxActiveBlocksPerMultiprocessor(&per_cu, (const void*)mega_fwd, NWAVES * 64, LDS_BYTES) != hipSuccess || per_cu < 1) { fprintf(stderr, "kernel_launch: occupancy query reports %d\n", per_cu); }
        (void)hipGetLastError();
        grid = cus;
    }
    if (grid < 0) return;
    if (hipMemsetAsync((char*)d_ws + WS_CTL, 0, CTL_ZERO_BYTES, stream) != hipSuccess) return;
    Args a{};
    for (int i = 0; i < 24; ++i) a.in[i] = (const float*)d_in[i];
    a.out = (float*)d_out; a.ws = (unsigned char*)d_ws;
    hipLaunchKernelGGL(mega_fwd, dim3(grid), dim3(NWAVES * 64), LDS_BYTES, stream, a);
}
```

```cpp
#include <hip/hip_runtime.h>
#include <cstdio>
#include <cstdint>
#ifndef EPI_NT
#define EPI_NT 1
#endif
#ifndef PG8_PRIO
#define PG8_PRIO 3
#endif
namespace pg8 {
#define PG8_LAS __attribute__((address_space(3)))
typedef unsigned short bf16_t;
typedef short bf16x8 __attribute__((ext_vector_type(8)));
typedef float f32x4 __attribute__((ext_vector_type(4)));
typedef unsigned u32x4 __attribute__((ext_vector_type(4)));
constexpr int BM = 256, BK = 64, HALF = 128, HTB = HALF * BK * 2  , STAGE_BYTES = 8 * HTB, NXCD = 8, WGM = 8;

__host__ __device__ __forceinline__ int lds_byte(int r, int c) { const int st = (r >> 4) * 2 + (c >> 5), rr = r & 15, cc = c & 31, ob = rr * 64 + cc * 2; return st * 1024 + (ob ^ (((ob >> 9) & 1) << 5)); }
__host__ __device__ __forceinline__ void stage_rc(int b, int& R, int& C) { const int st = b / 1024, sb = b % 1024, swz = sb ^ (((sb >> 9) & 1) << 5); R = (st >> 1) * 16 + swz / 64; C = (st & 1) * 32 + (swz % 64) / 2; }
__host__ __device__ __forceinline__ int perm32(int rho) { const int n = rho >> 4, i = rho & 15; return 8 * (i >> 2) + 4 * n + (i & 3); }

struct Unit { int pm, pn; };
struct Gemm { const bf16_t* A; const bf16_t* Bt; int M, N, K, lda, ldb; int pshA = 30, pshB = 30; size_t pstrA = 0, pstrB = 0; };

struct StaticOrder {
    int nM, nN, nwg, G, c, wgm, tr;
    __host__ __device__ void init(int M, int N, int G_, int c_, int wgm_ = WGM, int tr_ = 0) { nM = M / BM; nN = N / BM; nwg = nM * nN; G = G_; c = c_; wgm = wgm_; tr = tr_; }
    __host__ __device__ bool next(int i, Unit& u) const {
        const long L = (long)i * G + c; if (L >= nwg) return false;
        int wgid = (int)L; { const int q = nwg / NXCD, r = nwg % NXCD, xcd = wgid % NXCD, off = wgid / NXCD; wgid = (xcd < r ? xcd * (q + 1) : r * (q + 1) + (xcd - r) * q) + off; }
        const int nA = tr ? nN : nM, nB = tr ? nM : nN;
        const int nig = wgm * nB, gid = wgid / nig, fm = gid * wgm, gsz = (nA - fm) < wgm ? (nA - fm) : wgm;
        const int a = fm + ((wgid % nig) % gsz), b = (wgid % nig) / gsz;
        u.pm = tr ? b : a; u.pn = tr ? a : b; return true;
    }
    __device__ __forceinline__ void a_ready(const Unit&) const {}
    __device__ __forceinline__ void done(const Unit&) const {}
};

__device__ __forceinline__ unsigned cvt_pk_bf16(float lo, float hi) { unsigned r; asm volatile("v_cvt_pk_bf16_f32 %0, %1, %2" : "=v"(r) : "v"(lo), "v"(hi)); return r; }
__device__ __forceinline__ float sigm(float x) { return __builtin_amdgcn_rcpf(1.0f + __builtin_amdgcn_exp2f(-1.4426950408889634f * x)); }
__device__ __forceinline__ float bf_lo(unsigned w) { return __uint_as_float(w << 16); }
__device__ __forceinline__ float bf_hi(unsigned w) { return __uint_as_float(w & 0xffff0000u); }

struct EpiPlain {
    static constexpr bool PERM = true, AFTER_DRAIN = false, ROWSCALE = false;
    bf16_t* O; int ldc; float scale = 1.0f; int nt = 0;
    __device__ __forceinline__ void operator()(const f32x4 (&acc)[2][2][4][2], const Unit& u, int wr, int wc, int fr, int fq, const PG8_LAS float*) const {
        const int row0 = u.pm * BM + wr * 64 + fr; const int col0 = u.pn * BM + wc * 32 + 8 * fq;
#pragma unroll
        for (int ai = 0; ai < 2; ++ai)
#pragma unroll
            for (int m = 0; m < 4; ++m) { bf16_t* rowp = O + (size_t)(row0 + ai * HALF + m * 16) * ldc + col0;
#pragma unroll
                for (int bj = 0; bj < 2; ++bj) { const f32x4 v0 = acc[ai][bj][m][0] * scale, v1 = acc[ai][bj][m][1] * scale;
                    u32x4 w; w.x = cvt_pk_bf16(v0[0], v0[1]); w.y = cvt_pk_bf16(v0[2], v0[3]); w.z = cvt_pk_bf16(v1[0], v1[1]); w.w = cvt_pk_bf16(v1[2], v1[3]);
                    if (nt == 1) __builtin_nontemporal_store(w, (u32x4*)(rowp + bj * HALF));
                    else if (nt == 2) asm volatile("global_store_dwordx4 %0, %1, off sc1\n\ts_nop 2" :: "v"(rowp + bj * HALF), "v"(w) : "memory");
                    else if (nt == 3) asm volatile("global_store_dwordx4 %0, %1, off sc0 sc1\n\ts_nop 2" :: "v"(rowp + bj * HALF), "v"(w) : "memory");
                    else *(u32x4*)(rowp + bj * HALF) = w; } }
    }
};
struct EpiPlainRS {
    static constexpr bool PERM = true, AFTER_DRAIN = false, ROWSCALE = true;
    bf16_t* O; int ldc; float scale; const float* rs;
    __device__ __forceinline__ void operator()(const f32x4 (&acc)[2][2][4][2], const Unit& u, int wr, int wc, int fr, int fq, const PG8_LAS float* rsl) const {
        const int row0 = u.pm * BM + wr * 64 + fr; const int col0 = u.pn * BM + wc * 32 + 8 * fq;
#pragma unroll
        for (int ai = 0; ai < 2; ++ai)
#pragma unroll
            for (int m = 0; m < 4; ++m) { bf16_t* rowp = O + (size_t)(row0 + ai * HALF + m * 16) * ldc + col0; const float r = rsl[wr * 64 + ai * HALF + m * 16 + fr] * scale;
#pragma unroll
                for (int bj = 0; bj < 2; ++bj) { const f32x4 v0 = acc[ai][bj][m][0] * r, v1 = acc[ai][bj][m][1] * r;
                    u32x4 w; w.x = cvt_pk_bf16(v0[0], v0[1]); w.y = cvt_pk_bf16(v0[2], v0[3]); w.z = cvt_pk_bf16(v1[0], v1[1]); w.w = cvt_pk_bf16(v1[2], v1[3]);
                    *(u32x4*)(rowp + bj * HALF) = w; } }
    }
};
struct EpiSwiGLU {
    static constexpr bool PERM = true, AFTER_DRAIN = false, ROWSCALE = true;
    bf16_t* O; size_t pstr; const float* rs;
    __device__ __forceinline__ void operator()(const f32x4 (&acc)[2][2][4][2], const Unit& u, int wr, int wc, int fr, int fq, const PG8_LAS float* rsl) const {
        const int row0 = u.pm * BM + wr * 64 + fr; const int col0 = ((u.pn * HALF) & 4095) + wc * 32 + 8 * fq; bf16_t* Op = O + (size_t)(u.pn >> 5) * pstr;
#pragma unroll
        for (int ai = 0; ai < 2; ++ai)
#pragma unroll
            for (int m = 0; m < 4; ++m) { bf16_t* rowp = Op + (size_t)(row0 + ai * HALF + m * 16) * 4096 + col0; const float r = rsl[wr * 64 + ai * HALF + m * 16 + fr];
                const f32x4 g0 = acc[ai][0][m][0] * r, g1 = acc[ai][0][m][1] * r, u0 = acc[ai][1][m][0] * r, u1 = acc[ai][1][m][1] * r;
                f32x4 h0, h1;
#pragma unroll
                for (int i = 0; i < 4; ++i) { h0[i] = g0[i] * sigm(g0[i]) * u0[i]; h1[i] = g1[i] * sigm(g1[i]) * u1[i]; }
                u32x4 w; w.x = cvt_pk_bf16(h0[0], h0[1]); w.y = cvt_pk_bf16(h0[2], h0[3]); w.z = cvt_pk_bf16(h1[0], h1[1]); w.w = cvt_pk_bf16(h1[2], h1[3]);
                if (EPI_NT) __builtin_nontemporal_store(w, (u32x4*)rowp); else *(u32x4*)rowp = w; }
    }
};
constexpr float F8_HSCALE = 8.0f, F8_WSCALE = 1024.0f, F8_MAX = 416.0f, F8_USCALE = 16.0f, F8_WINSCALE = 512.0f;
__device__ __forceinline__ unsigned pack_fp8x4(float a, float b, float c, float d) {
    a = __builtin_fminf(__builtin_fmaxf(a, -F8_MAX), F8_MAX); b = __builtin_fminf(__builtin_fmaxf(b, -F8_MAX), F8_MAX); c = __builtin_fminf(__builtin_fmaxf(c, -F8_MAX), F8_MAX); d = __builtin_fminf(__builtin_fmaxf(d, -F8_MAX), F8_MAX);
    int w = 0; w = __builtin_amdgcn_cvt_pk_fp8_f32(a, b, w, false); w = __builtin_amdgcn_cvt_pk_fp8_f32(c, d, w, true); return (unsigned)w; }
struct EpiSwiGLU8 {
    static constexpr bool PERM = true, AFTER_DRAIN = false, ROWSCALE = true;
    unsigned char* O; size_t pstr; const float* rs; int pn_off = 0; float ascale = 1.0f;
    __device__ __forceinline__ void operator()(const f32x4 (&acc)[2][2][4][2], const Unit& u, int wr, int wc, int fr, int fq, const PG8_LAS float* rsl) const {
        const int pn = u.pn + pn_off;
        const int row0 = u.pm * BM + wr * 64 + fr; const int col0 = ((pn * HALF) & 4095) + wc * 32 + 8 * fq; unsigned char* Op = O + (size_t)(pn >> 5) * pstr;
#pragma unroll
        for (int ai = 0; ai < 2; ++ai)
#pragma unroll
            for (int m = 0; m < 4; ++m) { unsigned char* rowp = Op + (size_t)(row0 + ai * HALF + m * 16) * 4096 + col0; const float r = rsl[wr * 64 + ai * HALF + m * 16 + fr] * ascale;
                const f32x4 g0 = acc[ai][0][m][0] * r, g1 = acc[ai][0][m][1] * r, u0 = acc[ai][1][m][0] * r, u1 = acc[ai][1][m][1] * r;
                f32x4 h0, h1;
#pragma unroll
                for (int i = 0; i < 4; ++i) { h0[i] = g0[i] * sigm(g0[i]) * u0[i] * F8_HSCALE; h1[i] = g1[i] * sigm(g1[i]) * u1[i] * F8_HSCALE; }
                typedef unsigned u32x2 __attribute__((ext_vector_type(2)));
                u32x2 w; w.x = pack_fp8x4(h0[0], h0[1], h0[2], h0[3]); w.y = pack_fp8x4(h1[0], h1[1], h1[2], h1[3]);
                *(u32x2*)rowp = w; }
    }
};
struct EpiWin {
    static constexpr bool PERM = true, AFTER_DRAIN = false, ROWSCALE = true;
    bf16_t* QKV; bf16_t* GATES; const float* rs;
    __device__ __forceinline__ void operator()(const f32x4 (&acc)[2][2][4][2], const Unit& u, int wr, int wc, int fr, int fq, const PG8_LAS float* rsl) const {
        const int row0 = u.pm * BM + wr * 64 + fr;
        bf16_t* base; int ldc, colt;
        if (u.pn < 48) { base = QKV; ldc = 12288; colt = u.pn * BM; } else { base = GATES; ldc = 8192; colt = (u.pn - 48) * BM; }
        const int col0 = colt + wc * 32 + 8 * fq;
#pragma unroll
        for (int ai = 0; ai < 2; ++ai)
#pragma unroll
            for (int m = 0; m < 4; ++m) { bf16_t* rowp = base + (size_t)(row0 + ai * HALF + m * 16) * ldc + col0; const float r = rsl[wr * 64 + ai * HALF + m * 16 + fr];
#pragma unroll
                for (int bj = 0; bj < 2; ++bj) { const f32x4 v0 = acc[ai][bj][m][0] * r, v1 = acc[ai][bj][m][1] * r;
                    u32x4 w; w.x = cvt_pk_bf16(v0[0], v0[1]); w.y = cvt_pk_bf16(v0[2], v0[3]); w.z = cvt_pk_bf16(v1[0], v1[1]); w.w = cvt_pk_bf16(v1[2], v1[3]);
                    if (EPI_NT) __builtin_nontemporal_store(w, (u32x4*)(rowp + bj * HALF)); else *(u32x4*)(rowp + bj * HALF) = w; } }
    }
};
struct MidNone { static constexpr bool ON = false; int tmid; __device__ __forceinline__ void operator()(f32x4 (&)[2][2][4][2], const Unit&, int, int, int, int) const {} };
struct MidGate {
    static constexpr bool ON = true;
    int tmid; const bf16_t* G;
    __device__ __forceinline__ void operator()(f32x4 (&acc)[2][2][4][2], const Unit& u, int wr, int wc, int fr, int fq) const {
        asm volatile("" : "+v"(fr), "+v"(fq));
        const int row0 = u.pm * BM + wr * 64 + fr; const int col0 = u.pn * BM + wc * 32 + 8 * fq;
#pragma unroll
        for (int ai = 0; ai < 2; ++ai)
#pragma unroll
            for (int m = 0; m < 4; ++m) { const bf16_t* grow = G + (size_t)(row0 + ai * HALF + m * 16) * 8192 + col0;
#pragma unroll
                for (int bj = 0; bj < 2; ++bj) {
                    const u32x4 gf = *(const u32x4*)(grow + bj * HALF), gd = *(const u32x4*)(grow + 4096 + bj * HALF);
                    const unsigned fw[4] = {gf.x, gf.y, gf.z, gf.w}, dw[4] = {gd.x, gd.y, gd.z, gd.w};
#pragma unroll
                    for (int q = 0; q < 4; ++q) {
                        const float r0 = (1.0f + __builtin_amdgcn_exp2f(-1.4426950408889634f * bf_lo(dw[q]))) * __builtin_amdgcn_rcpf(1.0f + __builtin_amdgcn_exp2f(-1.4426950408889634f * bf_lo(fw[q])));
                        const float r1 = (1.0f + __builtin_amdgcn_exp2f(-1.4426950408889634f * bf_hi(dw[q]))) * __builtin_amdgcn_rcpf(1.0f + __builtin_amdgcn_exp2f(-1.4426950408889634f * bf_hi(fw[q])));
                        acc[ai][bj][m][q >> 1][2 * (q & 1)] *= r0; acc[ai][bj][m][q >> 1][2 * (q & 1) + 1] *= r1; } }
                asm volatile("" : "+v"(acc[ai][0][m][0]), "+v"(acc[ai][0][m][1]), "+v"(acc[ai][1][m][0]), "+v"(acc[ai][1][m][1]) :: "memory"); }
    }
};
struct EpiGateOut {
    static constexpr bool PERM = true, AFTER_DRAIN = false, ROWSCALE = false;
    bf16_t* O; const bf16_t* G;
    __device__ __forceinline__ void operator()(const f32x4 (&acc)[2][2][4][2], const Unit& u, int wr, int wc, int fr, int fq, const PG8_LAS float*) const {
        const int row0 = u.pm * BM + wr * 64 + fr; const int col0 = u.pn * BM + wc * 32 + 8 * fq;
#pragma unroll
        for (int ai = 0; ai < 2; ++ai)
#pragma unroll
            for (int m = 0; m < 4; ++m) { const size_t row = (size_t)(row0 + ai * HALF + m * 16);
#pragma unroll
                for (int bj = 0; bj < 2; ++bj) { const int col = col0 + bj * HALF;
                    const u32x4 gw = *(const u32x4*)(G + row * 8192 + 4096 + col);
                    f32x4 v0 = acc[ai][bj][m][0], v1 = acc[ai][bj][m][1];
                    v0[0] *= sigm(bf_lo(gw.x)); v0[1] *= sigm(bf_hi(gw.x)); v0[2] *= sigm(bf_lo(gw.y)); v0[3] *= sigm(bf_hi(gw.y));
                    v1[0] *= sigm(bf_lo(gw.z)); v1[1] *= sigm(bf_hi(gw.z)); v1[2] *= sigm(bf_lo(gw.w)); v1[3] *= sigm(bf_hi(gw.w));
                    u32x4 w; w.x = cvt_pk_bf16(v0[0], v0[1]); w.y = cvt_pk_bf16(v0[2], v0[3]); w.z = cvt_pk_bf16(v1[0], v1[1]); w.w = cvt_pk_bf16(v1[2], v1[3]);
                    *(u32x4*)(O + row * 4096 + col) = w; } }
    }
};

typedef int i32x4 __attribute__((ext_vector_type(4)));
typedef int i32x8 __attribute__((ext_vector_type(8)));
__device__ __forceinline__ i32x8 cat8(bf16x8 a, bf16x8 b) { const i32x4 x = __builtin_bit_cast(i32x4, a), y = __builtin_bit_cast(i32x4, b); return __builtin_shufflevector(x, y, 0, 1, 2, 3, 4, 5, 6, 7); }
template <class Epi, class Sched, bool ALIGN_EPI, class Mid = MidNone, bool F8 = false>
__device__ __forceinline__ void gemm_phase(PG8_LAS unsigned char* lds, const int tid, const Gemm g, const Sched& S, const Epi& E, const Mid MH = Mid{}) {
    const int wid = __builtin_amdgcn_readfirstlane(tid >> 6), lane = tid & 63, wr = wid >> 2, wc = wid & 3, fr = lane & 15, fq = lane >> 4;
    const int K = g.K, nt = K / BK;
    unsigned voffA[2], voffB[2];
#pragma unroll
    for (int i = 0; i < 2; ++i) { int R, C; stage_rc(tid * 16 + i * 8192, R, C); const int Rb = Epi::PERM ? ((R & ~31) + perm32(R & 31)) : R;
        voffA[i] = (unsigned)(R * g.lda + C) * 2u; voffB[i] = (unsigned)(Rb * g.ldb + C) * 2u; }
    const size_t kstep = (size_t)(BK * 2);
    const size_t hstepA = (size_t)HALF * g.lda * 2, hstepB = (size_t)HALF * g.ldb * 2;
    const size_t tstepA = 2 * hstepA, tstepB = 2 * hstepB;
    const unsigned ldsw = (unsigned)wid * 1024u;
    const int aoff = lds_byte(wr * 64 + fr, fq * 8), boff = lds_byte(wc * 32 + fr, fq * 8);
#define PG8_SA(b, h) (((b) * 2 + (h)) * HTB)
#define PG8_SB(b, h) ((4 + (b) * 2 + (h)) * HTB)
#define PG8_STAGE(bufoff, gbase, voff) do { _Pragma("unroll") for (int _i = 0; _i < 2; ++_i) \
        __builtin_amdgcn_global_load_lds((const unsigned*)((const char*)(gbase) + (voff)[_i]), (PG8_LAS unsigned*)(lds + (bufoff) + ldsw + _i * 8192), 16, 0, 0); } while (0)
#define PG8_LDA(dst, b, h) do { _Pragma("unroll") for (int m = 0; m < 4; ++m) _Pragma("unroll") for (int k = 0; k < 2; ++k) dst[m][k] = *(const PG8_LAS bf16x8*)(lds + PG8_SA(b, h) + aoff + m * 2048 + k * 1024); } while (0)
#define PG8_LDB(dst, b, h) do { _Pragma("unroll") for (int n = 0; n < 2; ++n) _Pragma("unroll") for (int k = 0; k < 2; ++k) dst[n][k] = *(const PG8_LAS bf16x8*)(lds + PG8_SB(b, h) + boff + n * 2048 + k * 1024); } while (0)
#define PG8_MMA(ai, bj, At, Bt) do { if (PG8_PRIO) __builtin_amdgcn_s_setprio(PG8_PRIO); _Pragma("unroll") for (int m = 0; m < 4; ++m) _Pragma("unroll") for (int n = 0; n < 2; ++n) { \
        if constexpr (F8) { asm volatile("v_mfma_scale_f32_16x16x128_f8f6f4 %0, %1, %2, %0, %3, %3 op_sel_hi:[0,0,0]" : "+v"(acc[ai][bj][m][n]) : "v"(cat8(Bt[n][0], Bt[n][1])), "v"(cat8(At[m][0], At[m][1])), "v"(f8one)); }   \
        else { _Pragma("unroll") for (int k = 0; k < 2; ++k) acc[ai][bj][m][n] = __builtin_amdgcn_mfma_f32_16x16x32_bf16(Bt[n][k], At[m][k], acc[ai][bj][m][n], 0, 0, 0); } } \
        if (PG8_PRIO) __builtin_amdgcn_s_setprio(0); } while (0)
#define PG8_WAIT_V(n) asm volatile("s_waitcnt vmcnt(" #n ")" ::: "memory")
#define PG8_WAIT_L(n) asm volatile("s_waitcnt lgkmcnt(" #n ")" ::: "memory")
#define PG8_BAR __builtin_amdgcn_s_barrier()
#define PG8_SCHED __builtin_amdgcn_sched_barrier(0)
    Unit cur, nxt; int ui = 0;
    if (!S.next(0, cur)) return;
    constexpr int RSL_OFF = STAGE_BYTES; int rpar = 0;
#define PG8_RSPF(uu, par) do { if constexpr (Epi::ROWSCALE) { if (wid == 0) __builtin_amdgcn_global_load_lds((const unsigned*)(E.rs + (size_t)(uu).pm * BM + lane * 4), (PG8_LAS unsigned*)(lds + RSL_OFF + (par) * 1024), 16, 0, 0); } } while (0)
    PG8_RSPF(cur, 0);
    f32x4 acc[2][2][4][2];
#pragma unroll
    for (int a = 0; a < 2; ++a)
#pragma unroll
        for (int b = 0; b < 2; ++b)
#pragma unroll
            for (int m = 0; m < 4; ++m)
#pragma unroll
                for (int n = 0; n < 2; ++n) acc[a][b][m][n] = (f32x4){0.f, 0.f, 0.f, 0.f};
    bf16x8 At[4][2], B0[2][2], B1[2][2];
    int f8one = 0x7F7F7F7F; if constexpr (F8) asm volatile("" : "+v"(f8one));
    const char* cA = (const char*)g.A + (size_t)cur.pm * tstepA; const char* cB = (const char*)g.Bt + (size_t)cur.pn * tstepB;
    S.a_ready(cur);
    PG8_STAGE(PG8_SB(0, 0), cB, voffB); PG8_STAGE(PG8_SB(0, 1), cB + hstepB, voffB); PG8_STAGE(PG8_SA(0, 0), cA, voffA); PG8_STAGE(PG8_SA(0, 1), cA + hstepA, voffA);
    if (wr == 1) PG8_BAR;
    PG8_WAIT_V(2); PG8_BAR;
    PG8_STAGE(PG8_SB(1, 0), cB + kstep, voffB); PG8_STAGE(PG8_SA(1, 0), cA + kstep, voffA); PG8_STAGE(PG8_SB(1, 1), cB + hstepB + kstep, voffB);
    PG8_WAIT_V(6); PG8_BAR;
    for (;;) {
        const bool has_next = S.next(ui + 1, nxt);
        const char* nA = has_next ? (const char*)g.A + (size_t)nxt.pm * tstepA : cA; const char* nB = has_next ? (const char*)g.Bt + (size_t)nxt.pn * tstepB : cB;
        for (int t = 0; t < nt; t += 2) {
            const bool last = (t == nt - 2);
            const char* a1 = cA + (size_t)(t >> g.pshA) * g.pstrA + (size_t)((t & ((1 << g.pshA) - 1)) + 1) * kstep;
            const int t2 = t + 2;
            const char* a2 = last ? nA : cA + (size_t)(t2 >> g.pshA) * g.pstrA + (size_t)(t2 & ((1 << g.pshA) - 1)) * kstep;
            const char* b2 = last ? nB : cB + (size_t)(t2 >> g.pshB) * g.pstrB + (size_t)(t2 & ((1 << g.pshB) - 1)) * kstep;
            const char* a3 = a2 + kstep; const char* b3 = b2 + kstep;
            if (last && has_next) S.a_ready(nxt);
            if constexpr (Mid::ON) { if (t == MH.tmid) MH(acc, cur, wr, wc, fr, fq); }
            PG8_LDB(B0, 0, 0); PG8_LDB(B1, 0, 1); PG8_SCHED; PG8_LDA(At, 0, 0); PG8_STAGE(PG8_SA(1, 1), a1 + hstepA, voffA);
            PG8_WAIT_V(8); PG8_WAIT_L(0); PG8_BAR; PG8_MMA(0, 0, At, B0); PG8_MMA(0, 1, At, B1); PG8_BAR; PG8_SCHED;
            PG8_LDA(At, 0, 1); PG8_STAGE(PG8_SB(0, 0), b2, voffB); PG8_STAGE(PG8_SB(0, 1), b2 + hstepB, voffB); PG8_STAGE(PG8_SA(0, 0), a2, voffA);
            PG8_WAIT_V(8); PG8_WAIT_L(0); PG8_BAR; PG8_MMA(1, 0, At, B0); PG8_MMA(1, 1, At, B1); PG8_BAR; PG8_SCHED;
            PG8_LDB(B0, 1, 0); PG8_LDB(B1, 1, 1); PG8_SCHED; PG8_LDA(At, 1, 0); PG8_STAGE(PG8_SA(0, 1), a2 + hstepA, voffA);
            PG8_WAIT_V(8); PG8_WAIT_L(0); PG8_BAR; PG8_MMA(0, 0, At, B0); PG8_MMA(0, 1, At, B1); PG8_BAR; PG8_SCHED;
            PG8_LDA(At, 1, 1); PG8_STAGE(PG8_SB(1, 0), b3, voffB); PG8_STAGE(PG8_SB(1, 1), b3 + hstepB, voffB); PG8_STAGE(PG8_SA(1, 0), a3, voffA);
            PG8_WAIT_V(8); PG8_WAIT_L(0); PG8_BAR; PG8_MMA(1, 0, At, B0); PG8_MMA(1, 1, At, B1); PG8_BAR; PG8_SCHED;
        }
        if constexpr (ALIGN_EPI) { if (wr == 0) PG8_BAR; }
        if constexpr (F8) {
            asm volatile("s_nop 15\n\ts_nop 15" : "+v"(acc[0][0][0][0]), "+v"(acc[0][0][0][1]), "+v"(acc[0][0][1][0]), "+v"(acc[0][0][1][1]), "+v"(acc[0][0][2][0]), "+v"(acc[0][0][2][1]), "+v"(acc[0][0][3][0]), "+v"(acc[0][0][3][1]),
                                                   "+v"(acc[0][1][0][0]), "+v"(acc[0][1][0][1]), "+v"(acc[0][1][1][0]), "+v"(acc[0][1][1][1]), "+v"(acc[0][1][2][0]), "+v"(acc[0][1][2][1]), "+v"(acc[0][1][3][0]), "+v"(acc[0][1][3][1]) :: "memory");
            asm volatile("" : "+v"(acc[1][0][0][0]), "+v"(acc[1][0][0][1]), "+v"(acc[1][0][1][0]), "+v"(acc[1][0][1][1]), "+v"(acc[1][0][2][0]), "+v"(acc[1][0][2][1]), "+v"(acc[1][0][3][0]), "+v"(acc[1][0][3][1]),
                              "+v"(acc[1][1][0][0]), "+v"(acc[1][1][0][1]), "+v"(acc[1][1][1][0]), "+v"(acc[1][1][1][1]), "+v"(acc[1][1][2][0]), "+v"(acc[1][1][2][1]), "+v"(acc[1][1][3][0]), "+v"(acc[1][1][3][1]) :: "memory"); }
        E(acc, cur, wr, wc, fr, fq, (const PG8_LAS float*)(lds + RSL_OFF + rpar * 1024)); S.done(cur); rpar ^= 1;
        if (!has_next) break;
#pragma unroll
        for (int a = 0; a < 2; ++a)
#pragma unroll
            for (int b = 0; b < 2; ++b)
#pragma unroll
                for (int m = 0; m < 4; ++m)
#pragma unroll
                    for (int n = 0; n < 2; ++n) acc[a][b][m][n] = (f32x4){0.f, 0.f, 0.f, 0.f};
        cur = nxt; cA = nA; cB = nB; ++ui;
        PG8_RSPF(cur, rpar);
        if constexpr (ALIGN_EPI) { if (wr == 1) PG8_BAR; }
    }
    PG8_WAIT_V(0);
    if constexpr (!ALIGN_EPI) { if (wr == 0) PG8_BAR; }
    PG8_BAR;
#undef PG8_SA
#undef PG8_SB
#undef PG8_STAGE
#undef PG8_LDA
#undef PG8_LDB
#undef PG8_MMA
#undef PG8_WAIT_V
#undef PG8_WAIT_L
#undef PG8_BAR
#undef PG8_SCHED
#undef PG8_RSPF
}
}
#ifndef ATT_PRIO
#define ATT_PRIO 2
#endif
#ifndef ATT_STAGGER
#define ATT_STAGGER 0
#endif
namespace att {
typedef unsigned short bf16_t;
typedef short bf16x8 __attribute__((ext_vector_type(8)));
typedef short s16x4 __attribute__((ext_vector_type(4)));
typedef float f32x16 __attribute__((ext_vector_type(16)));
typedef float f32x4 __attribute__((ext_vector_type(4)));
typedef unsigned u32x4 __attribute__((ext_vector_type(4)));
constexpr int D = 128, NW = 8, QBLK = 32, KVBLK = 64, QB = NW * QBLK;
constexpr int SHM_V = KVBLK * D * 2, SHM_K = KVBLK * D * 2;
constexpr int OFF_WS = 2 * SHM_V + 2 * SHM_K;
constexpr int OFF_BIAS = OFF_WS + NW * 64 * 4;
constexpr int OFF_Q = OFF_BIAS + 2 * 64 * 4;
constexpr int OFF_OST = 69632;
constexpr int OST_PITCH = 136, OST_WAVE = 32 * OST_PITCH * 2;
constexpr int LDS_BYTES = OFF_OST + NW * OST_WAVE;
static_assert(OFF_Q + 16 <= OFF_OST, "attention LDS map");
constexpr int PKV = 12288;
constexpr int PO = 6144;
constexpr int META_ROW0 = 16384;
constexpr float SCALE = 0.08838834764831845f;
constexpr float C2 = 1.4426950408889634f * SCALE;
constexpr float THR = 8.f;
constexpr unsigned WBIG = 0x40000000u;

#define KSWZ(row, colB) ((row) * 256 + ((colB) ^ (((row) & 7) << 4)))
#define SBAR() __builtin_amdgcn_sched_barrier(0)
__device__ __forceinline__ int v_st(int k, int c) { const int kk = (k & ~0xC) | ((k & 4) << 1) | ((k & 8) >> 1); return ((kk >> 3) * 4 + (c >> 5)) * 512 + ((kk & 7) * 32 + (c & 31)) * 2; }
__device__ __forceinline__ int v_rd_base(int lane) { return ((lane & 3) << 3) | (((lane >> 2) & 3) << 6) | (((lane >> 4) & 1) << 5) | (((lane >> 5) & 1) << 8); }
constexpr int v_rd_off(int d0, int ks, int half) { return d0 * 512 + ks * 4096 + half * 2048; }
__device__ __forceinline__ int crow(int r, int hi) { return (r & 3) + 8 * (r >> 2) + 4 * hi; }
__device__ __forceinline__ unsigned cvtpk(float lo, float hi) { unsigned r; asm volatile("v_cvt_pk_bf16_f32 %0, %1, %2" : "=v"(r) : "v"(lo), "v"(hi)); return r; }
__device__ __forceinline__ bf16x8 load8(const bf16_t* p) { return *reinterpret_cast<const bf16x8*>(p); }

__device__ __forceinline__ void mask_tile(f32x16& p0, f32x16& p1, int dq) {
    const float NEG = -__builtin_inff();
#pragma unroll
    for (int r = 0; r < 16; ++r) {
        const int c = (r & 3) + 8 * (r >> 2);
        if ((unsigned)(dq - c) >= WBIG) p0[r] = NEG;
        if ((unsigned)(dq - c - 32) >= WBIG) p1[r] = NEG;
    }
}
__device__ __forceinline__ void mask_tile0(f32x16& p0, f32x16& p1) {
    const float NEG = -__builtin_inff();
#pragma unroll
    for (int r = 0; r < 16; ++r) { p0[r] = NEG; if (r < 8) p1[r] = NEG; }
}
__device__ __forceinline__ void partialSM(f32x16& p0, f32x16& p1, float& m_reg, float& mn, float& alpha) {
    float pmax = p0[0]; for (int r = 1; r < 16; ++r) pmax = fmaxf(pmax, p0[r]); for (int r = 0; r < 16; ++r) pmax = fmaxf(pmax, p1[r]);
    { auto rr = __builtin_amdgcn_permlane32_swap(__float_as_uint(pmax), __float_as_uint(pmax), false, false);
      pmax = fmaxf(__uint_as_float(rr[0]), __uint_as_float(rr[1])); }
    if (__builtin_expect(__all((pmax - m_reg) * SCALE <= THR), 1)) { mn = m_reg; alpha = 1.f; }
    else { mn = fmaxf(m_reg, pmax); alpha = __builtin_amdgcn_exp2f((m_reg - mn) * C2); m_reg = mn; }
    const float mnL = -mn * C2;
    for (int r = 0; r < 16; ++r) p0[r] = fmaf(p0[r], C2, mnL); for (int r = 0; r < 16; ++r) p1[r] = fmaf(p1[r], C2, mnL);
    for (int r = 0; r < 16; ++r) p0[r] = __builtin_amdgcn_exp2f(p0[r]);
}
__device__ __forceinline__ void finishSM(f32x16& p0, f32x16& p1, float alpha, float& l_reg, bf16x8& pa0, bf16x8& pa1, bf16x8& pa2, bf16x8& pa3) {
    for (int r = 0; r < 16; ++r) p1[r] = __builtin_amdgcn_exp2f(p1[r]);
    float ps = 0; for (int r = 0; r < 16; ++r) ps += p0[r]; for (int r = 0; r < 16; ++r) ps += p1[r];
    { auto rr = __builtin_amdgcn_permlane32_swap(__float_as_uint(ps), __float_as_uint(ps), false, false);
      ps = __uint_as_float(rr[0]) + __uint_as_float(rr[1]); }
    l_reg = l_reg * alpha + ps;
#define PK4(P, B_, OUT) do { unsigned a0 = cvtpk(P[B_+0], P[B_+1]), a1 = cvtpk(P[B_+2], P[B_+3]);                          \
        unsigned b0 = cvtpk(P[B_+4], P[B_+5]), b1 = cvtpk(P[B_+6], P[B_+7]);                                             \
        auto r0 = __builtin_amdgcn_permlane32_swap(a0, b0, false, false); auto r1 = __builtin_amdgcn_permlane32_swap(a1, b1, false, false); \
        u32x4 w = {r0[0], r1[0], r0[1], r1[1]}; OUT = *reinterpret_cast<bf16x8*>(&w); } while (0)
    PK4(p0, 0, pa0); PK4(p0, 8, pa1); PK4(p1, 0, pa2); PK4(p1, 8, pa3);
#undef PK4
}
template <int KB>
__device__ __forceinline__ void qkt(f32x16& p0, f32x16& p1, const char* K_lds, int r32, int hi, const bf16x8* qr, const float* bias_l) {
    { const f32x4* bb = (const f32x4*)(bias_l + KB * 64 + 4 * hi);
#pragma unroll
      for (int g = 0; g < 4; ++g) { const f32x4 b0 = bb[2 * g], b1 = bb[8 + 2 * g];
#pragma unroll
          for (int i = 0; i < 4; ++i) { p0[4 * g + i] = b0[i]; p1[4 * g + i] = b1[i]; } } }
    const char* kb[4];
#pragma unroll
    for (int dd = 0; dd < 4; ++dd) kb[dd] = K_lds + KB * SHM_K + KSWZ(r32, (dd * 16 + hi * 8) * 2);
    if (ATT_PRIO & 1) __builtin_amdgcn_s_setprio(1);
#pragma unroll
    for (int d0 = 0; d0 < 8; ++d0) { const char* a = kb[d0 & 3] + (d0 >> 2) * 128;
        bf16x8 b0 = *reinterpret_cast<const bf16x8*>(a);
        bf16x8 b1 = *reinterpret_cast<const bf16x8*>(a + 32 * 256);
        p0 = __builtin_amdgcn_mfma_f32_32x32x16_bf16(b0, qr[d0], p0, 0, 0, 0);
        p1 = __builtin_amdgcn_mfma_f32_32x32x16_bf16(b1, qr[d0], p1, 0, 0, 0); }
    if (ATT_PRIO & 1) __builtin_amdgcn_s_setprio(0);
}
template <int VB>
__device__ __forceinline__ void pv_tile(f32x16* o, int vb0, bf16x8 pa0, bf16x8 pa1, bf16x8 pa2, bf16x8 pa3) {
#define TRRD(dst, off) asm volatile("ds_read_b64_tr_b16 %0, %1 offset:%2" : "=&v"(dst) : "v"(vb0), "i"(off) : "memory")
#define PV_D0(d0) do { s16x4 l0, l1, l2, l3, h0, h1, h2, h3; constexpr int b_ = VB * SHM_V + v_rd_off(d0, 0, 0);     \
        TRRD(l0, b_); TRRD(h0, b_ + 2048); TRRD(l1, b_ + 4096); TRRD(h1, b_ + 6144); TRRD(l2, b_ + 8192); TRRD(h2, b_ + 10240); TRRD(l3, b_ + 12288); TRRD(h3, b_ + 14336); \
        asm volatile("s_waitcnt lgkmcnt(0)" ::: "memory"); SBAR();   \
        o[d0] = __builtin_amdgcn_mfma_f32_32x32x16_bf16(pa0, (bf16x8){l0[0], l0[1], l0[2], l0[3], h0[0], h0[1], h0[2], h0[3]}, o[d0], 0, 0, 0);   \
        o[d0] = __builtin_amdgcn_mfma_f32_32x32x16_bf16(pa1, (bf16x8){l1[0], l1[1], l1[2], l1[3], h1[0], h1[1], h1[2], h1[3]}, o[d0], 0, 0, 0);   \
        o[d0] = __builtin_amdgcn_mfma_f32_32x32x16_bf16(pa2, (bf16x8){l2[0], l2[1], l2[2], l2[3], h2[0], h2[1], h2[2], h2[3]}, o[d0], 0, 0, 0);   \
        o[d0] = __builtin_amdgcn_mfma_f32_32x32x16_bf16(pa3, (bf16x8){l3[0], l3[1], l3[2], l3[3], h3[0], h3[1], h3[2], h3[3]}, o[d0], 0, 0, 0); } while (0)
    if (ATT_PRIO & 2) __builtin_amdgcn_s_setprio(1);
    PV_D0(0); PV_D0(1); PV_D0(2); PV_D0(3);
    if (ATT_PRIO & 2) __builtin_amdgcn_s_setprio(0);
#undef PV_D0
#undef TRRD
}

struct BlockRef { const bf16_t* Q; const bf16_t* K; const bf16_t* V; bf16_t* O; const float* kb; float sl2; int rowb; int P0; int jlo; int probe; };
struct Seam { bf16x8 qr[8]; bf16x8 st_v0, st_v1, st_k0, st_k1; float st_b; };

#define VMW() asm volatile("s_waitcnt vmcnt(0)" ::: "memory")
#define VMWN(n) asm volatile("s_waitcnt vmcnt(%0)" :: "i"(n) : "memory")
__device__ __forceinline__ bf16x8 load8o(const bf16_t* base, unsigned byteoff) { return *reinterpret_cast<const bf16x8*>((const char*)base + byteoff); }
__device__ __forceinline__ void sload(Seam& S, const BlockRef& R, int j, int sr, int sc, int wid, int lane) {
    if (R.probe) j = R.jlo;
    const int rb = (j == 0) ? (META_ROW0 - 48) : (R.rowb + 64 * (j - 1));
    const unsigned o0 = (unsigned)((rb + sr) * PKV + sc) * 2u, o1 = (unsigned)((rb + 32 + sr) * PKV + sc) * 2u;
    S.st_v0 = load8o(R.V, o0); S.st_v1 = load8o(R.V, o1);
    S.st_k0 = load8o(R.K, o0); S.st_k1 = load8o(R.K, o1);
    if (wid == 0) { const int e = 64 * j + lane; S.st_b = R.kb ? R.kb[e] : R.sl2 * (float)(e - (R.P0 + QB)); }
}
__device__ __forceinline__ float row_bias(const BlockRef& R, int wid, int r32) { const int rr = wid * QBLK + r32; return R.kb ? R.kb[R.P0 + rr] : R.sl2 * (float)(rr - QB); }
#define SWRITE_K(bf) do { *(bf16x8*)(K_lds + (bf) * SHM_K + kws) = S.st_k0; *(bf16x8*)(K_lds + (bf) * SHM_K + kws + 32 * 256) = S.st_k1; \
                          if (wid == 0) bias_l[(bf) * 64 + lane] = S.st_b; } while (0)
#define SWRITE_V(bf) do { *(bf16x8*)(V_lds + (bf) * SHM_V + vst0) = S.st_v0; *(bf16x8*)(V_lds + (bf) * SHM_V + vst0 + 8192) = S.st_v1; } while (0)

__device__ __forceinline__ void attn_prime(const int tid, const BlockRef& cur, char* lds, Seam& S) {
    const int wid = __builtin_amdgcn_readfirstlane(tid >> 6), lane = tid & 63, r32 = lane & 31, hi = lane >> 5;
    const int sr = tid >> 4, sc = (tid & 15) * 8, kws = KSWZ(sr, sc * 2); char* K_lds = lds + 2 * SHM_V; float* bias_l = (float*)(lds + OFF_BIAS);
#pragma unroll
    for (int d0 = 0; d0 < 8; ++d0) S.qr[d0] = load8o(cur.Q, (unsigned)((wid * QBLK + r32) * PKV + d0 * 16 + hi * 8) * 2u);
    sload(S, cur, cur.jlo, sr, sc, wid, lane); VMW(); SWRITE_K(0);
    __syncthreads();
}
__device__ __forceinline__ void attn_block(const int tid, const BlockRef& cur, const BlockRef& nxt, char* lds, Seam& S) {
    const int wid = __builtin_amdgcn_readfirstlane(tid >> 6), lane = tid & 63, r32 = lane & 31, hi = lane >> 5;
    const int j0 = cur.jlo, NT = (cur.P0 + QB - 1) / KVBLK + 1 - j0;
    const int qlo = cur.P0 + wid * QBLK, qm = qlo + r32 - 4 * hi;
    char* V_lds = lds; char* K_lds = lds + 2 * SHM_V;
    float* ws = (float*)(lds + OFF_WS) + wid * 64; float* li_l = ws, * al_l = ws + 32;
    float* bias_l = (float*)(lds + OFF_BIAS);
    float m_reg = -1e30f, l_reg = 0; f32x16 o[4] = {};
    const int sr = tid >> 4, sc = (tid & 15) * 8, vst0 = v_st(sr, sc), kws = KSWZ(sr, sc * 2);
    const int vb0 = (int)(uintptr_t)V_lds + v_rd_base(lane);
#define RESC(a) do { if (__any((a) < 1.f)) { if (hi == 0) al_l[r32] = (a); asm volatile("s_waitcnt lgkmcnt(0)" ::: "memory");              \
                     for (int d_ = 0; d_ < 4; ++d_) for (int r = 0; r < 16; ++r) o[d_][r] *= al_l[crow(r, hi)]; } } while (0)
#define MASKT(P0_, P1_, t) do { const int kb_ = (j0 + (t)) * KVBLK; if (kb_ + KVBLK - 1 > qlo) mask_tile(P0_, P1_, qm - kb_); } while (0)
    f32x16 pA0, pA1, pB0, pB1; float mnA, mnB, alA, alB; bf16x8 pa0, pa1, pa2, pa3;
    SWRITE_V(0); SBAR();
    if (NT > 1) sload(S, cur, j0 + 1, sr, sc, wid, lane);
    SBAR(); qkt<0>(pA0, pA1, K_lds, r32, hi, S.qr, bias_l);
    if (j0 == 0) mask_tile0(pA0, pA1);
    partialSM(pA0, pA1, m_reg, mnA, alA);
    if (NT > 1) { VMW(); SWRITE_V(1); SWRITE_K(1); }
    __syncthreads();
#define HALF_STEP(PX0, PX1, mnX, alX, PY0, PY1, alY, t, KB, VB, SB) do {                                                      \
        SBAR(); if (ATT_STAGGER && wid >= 4) __builtin_amdgcn_s_sleep(ATT_STAGGER); SBAR(); if ((t) + 1 < NT) { sload(S, cur, j0 + (t) + 1, sr, sc, wid, lane); SBAR(); }     \
        qkt<KB>(PX0, PX1, K_lds, r32, hi, S.qr, bias_l);                                                                      \
        finishSM(PY0, PY1, alY, l_reg, pa0, pa1, pa2, pa3); SBAR();                                                           \
        pv_tile<VB>(o, vb0, pa0, pa1, pa2, pa3); MASKT(PX0, PX1, (t)); partialSM(PX0, PX1, m_reg, mnX, alX);       \
        __syncthreads();                                                                                                      \
        if ((t) + 1 < NT) { VMW(); SWRITE_V(SB); SWRITE_K(SB); }                                                              \
        RESC(alX); __syncthreads(); } while (0)
    for (int t = 1; t + 1 < NT; t += 2) {
        HALF_STEP(pB0, pB1, mnB, alB, pA0, pA1, alA, t, 1, 0, 0);
        HALF_STEP(pA0, pA1, mnA, alA, pB0, pB1, alB, t + 1, 0, 1, 1);
    }
    constexpr bool even = false;
    if (even) { SBAR(); qkt<1>(pB0, pB1, K_lds, r32, hi, S.qr, bias_l); SBAR(); }
    sload(S, nxt, nxt.jlo, sr, sc, wid, lane); SBAR();
#pragma unroll
    for (int d0 = 0; d0 < 8; ++d0) S.qr[d0] = load8o(nxt.Q, (unsigned)((wid * QBLK + r32) * PKV + d0 * 16 + hi * 8) * 2u);
    SBAR();
    finishSM(pA0, pA1, alA, l_reg, pa0, pa1, pa2, pa3); SBAR();
    pv_tile<0>(o, vb0, pa0, pa1, pa2, pa3);
    if (even) { MASKT(pB0, pB1, NT - 1); partialSM(pB0, pB1, m_reg, mnB, alB); __syncthreads(); RESC(alB);
        finishSM(pB0, pB1, alB, l_reg, pa0, pa1, pa2, pa3); SBAR(); pv_tile<1>(o, vb0, pa0, pa1, pa2, pa3); }
    SBAR(); VMWN(8); SWRITE_K(0); SBAR();
    if (hi == 0) li_l[r32] = l_reg; asm volatile("s_waitcnt lgkmcnt(0)" ::: "memory");
    float rli[16];
#pragma unroll
    for (int r = 0; r < 16; ++r) rli[r] = __builtin_amdgcn_rcpf(li_l[crow(r, hi)]);
    bf16_t* Ow = cur.O + (size_t)(wid * QBLK) * PO;
    bf16_t* stg = (bf16_t*)(lds + OFF_OST + wid * OST_WAVE);
#pragma unroll
    for (int r = 0; r < 16; ++r) { const int orow = crow(r, hi);
#pragma unroll
        for (int d0 = 0; d0 < 4; ++d0) { const float v = o[d0][r] * rli[r];
            const float vn = __int_as_float(__builtin_amdgcn_mov_dpp(__float_as_int(v), 0xB1, 0xF, 0xF, true));
            if ((r32 & 1) == 0) *(unsigned*)(stg + orow * OST_PITCH + d0 * 32 + r32) = cvtpk(v, vn); } }
    asm volatile("s_waitcnt lgkmcnt(0)" ::: "memory");
#pragma unroll
    for (int i = 0; i < 8; ++i) { const int row = i * 4 + (lane >> 4), ch = lane & 15;
        const u32x4 v = *(const u32x4*)(stg + row * OST_PITCH + ch * 8);
        *(u32x4*)(Ow + (size_t)row * PO + ch * 8) = v; }
    __syncthreads();
#undef RESC
#undef MASKT
#undef HALF_STEP
}
#undef VMW
#undef VMWN
#undef SWRITE_K
#undef SWRITE_V
#undef KSWZ
#undef SBAR
}
constexpr int NWAVES = 8;
constexpr int DM = 4096, NB = 4, SEQ = 4096, NMETA = 16, DFF = 11008;
constexpr int MR = NB * SEQ;
constexpr int MT = MR + 256;
constexpr int NGU = 2 * DFF;
constexpr int NIN = 20736;
constexpr int PQKV = 12288, PGATE = 8192, PAO = 6144;
#ifndef GU_F8
#define GU_F8 1
#endif
#ifndef GATES_F8
#define GATES_F8 1
#endif
#ifndef PU_PAD
#define PU_PAD 0
#endif
constexpr int PU = DM + PU_PAD;
constexpr size_t WD_PSTR = (size_t)4096 * 4096;
constexpr int EKV = 4160;
constexpr float RMS_EPS = 1e-6f;
constexpr float LOG2E = 1.4426950408889634f;
constexpr float ISCALE = 11.313708498984761f;
constexpr float LAMBDA_INIT = 0.2f;

constexpr size_t MiB = 1u << 20;
constexpr size_t WS_CTL = 0, CTL_ZERO_BYTES = 1 * MiB;
constexpr size_t WS_KB = 1 * MiB;
constexpr size_t WS_FLOG = 3 * MiB;
constexpr size_t WS_JLO = 5 * MiB;
constexpr size_t WS_RS0 = 6 * MiB, WS_RS1 = WS_RS0 + 128 * 1024, WS_RS2 = WS_RS1 + 128 * 1024;
constexpr size_t WS_WGU = 8 * MiB;
constexpr size_t WS_WD = 180 * MiB;
constexpr size_t WS_P = WS_WGU;
constexpr size_t WS_WIN = 276 * MiB;
constexpr size_t WS_WGU8 = WS_WIN;
constexpr int GU8_TILES = 22, GU8_ROW0 = (86 - GU8_TILES) * 256;
constexpr size_t WS_WIN8 = WS_WIN + 96 * MiB;
constexpr size_t WS_U8 = 1412 * MiB;
constexpr size_t WS_WO = 438 * MiB;
constexpr size_t WS_WOUT = 470 * MiB;
constexpr size_t WS_U = 502 * MiB;
constexpr size_t WS_Y = 632 * MiB;
constexpr size_t WS_BIG = 762 * MiB;
constexpr size_t WS_GATES = WS_BIG + 390 * MiB;
constexpr size_t WS_AO = 1412 * MiB;
constexpr size_t WS_MG = 1604 * MiB;
constexpr size_t WS_END = 1732 * MiB;
static_assert((size_t)NGU * DM * 2 <= 172 * MiB && (size_t)3 * DM * 4096 * 2 <= 96 * MiB && (size_t)NIN * DM * 2 <= 162 * MiB && (size_t)MT * DM * 2 <= 130 * MiB && (size_t)MT * PU * 2 <= 130 * MiB, "ws map");
static_assert((size_t)MT * DFF * 2 <= 650 * MiB && (size_t)MT * PQKV * 2 <= 390 * MiB && (size_t)MT * PGATE * 2 <= 260 * MiB && (size_t)MR * DM * 4 <= 258 * MiB, "ws map");
static_assert((size_t)NB * 16 * EKV * 4 <= 2 * MiB && (size_t)MT * 16 * 4 <= 2 * MiB, "ws map");
constexpr int CW_BAR = 4096;
constexpr int CW_CQ3 = 8576;
constexpr int CW_CQ2 = 8448;
constexpr int CW_CQ = 8320;
constexpr int CW_Q = 8192;
constexpr float SKIP_TH = 44.0f;

constexpr int RING_OFF = 0, RING_BYTES = 131072;
constexpr int LDSCTL_OFF = 139264, MISC_OFF = LDSCTL_OFF + 320;
constexpr int LDS_BYTES = 147456;
static_assert(MISC_OFF + 128 <= LDS_BYTES && att::LDS_BYTES <= LDSCTL_OFF && RING_BYTES <= LDSCTL_OFF, "LDS map");

#define GAS __attribute__((address_space(1)))
#define LAS __attribute__((address_space(3)))
typedef unsigned short bf16;
typedef unsigned v4u __attribute__((ext_vector_type(4)));
typedef unsigned v2u __attribute__((ext_vector_type(2)));
typedef float f32x4 __attribute__((ext_vector_type(4)));
typedef GAS unsigned gu32;
#define RLX_AGENT __ATOMIC_RELAXED, __HIP_MEMORY_SCOPE_AGENT
#define LDS_WAIT() asm volatile("s_waitcnt lgkmcnt(0)" ::: "memory")
#define VM_WAIT() asm volatile("s_waitcnt vmcnt(0)" ::: "memory")
__device__ __forceinline__ unsigned f2bf(float f) { unsigned u = __builtin_bit_cast(unsigned, f); return (u + 0x7fffu + ((u >> 16) & 1u)) >> 16; }
__device__ __forceinline__ unsigned pk2(float lo, float hi) { return f2bf(lo) | (f2bf(hi) << 16); }
__device__ __forceinline__ float bflo(unsigned w) { return __uint_as_float(w << 16); }
__device__ __forceinline__ float bfhi(unsigned w) { return __uint_as_float(w & 0xffff0000u); }

#define XB_TMO      128
#define XB_XCNT(j)  (256  + 64 * (j))
#define XB_XSUB(j)  (1280 + 64 * (j))
#define XB_XGEN(j)  (2304 + 64 * (j))
#define XB_TOP      3328
#define XB_TOPGEN   3392
#define XCD_BAR_WORDS 3456
#define XB_SPIN_CAP (1u << 22)

__device__ __forceinline__ unsigned xb_ld(unsigned* p)              { return __hip_atomic_load(p, __ATOMIC_RELAXED, __HIP_MEMORY_SCOPE_AGENT); }
__device__ __forceinline__ unsigned xb_add(unsigned* p, unsigned v) { return __hip_atomic_fetch_add(p, v, __ATOMIC_RELAXED, __HIP_MEMORY_SCOPE_AGENT); }
__device__ __forceinline__ unsigned xb_xcc_id() { return (unsigned)__builtin_amdgcn_s_getreg((3 << 11) | 20) & 0xFu; }
#define XB_SPIN(cond, bar) do { unsigned _sp = 0; while (cond) { __builtin_amdgcn_s_sleep(1); \
    if ((++_sp & 255u) == 0u) { if (xb_ld(&(bar)[XB_TMO])) break; if (_sp > XB_SPIN_CAP) { atomicAdd(&(bar)[XB_TMO], 1u); break; } } } } while (0)

struct XcdBarrier {
    unsigned* bar; unsigned x;
    volatile LAS unsigned* st;
};
__device__ __forceinline__ XcdBarrier xcd_barrier_post(unsigned* bar, volatile LAS unsigned* st, int tid) {
    XcdBarrier b; b.bar = bar; b.x = xb_xcc_id(); b.st = st;
    if (tid == 0) (void)xb_add(&bar[XB_XCNT(b.x)], 1u);
    return b;
}
__device__ __forceinline__ void xcd_barrier_complete(unsigned* bar, unsigned x, unsigned& nloc, unsigned& nx) {
    const unsigned G = gridDim.x * gridDim.y * gridDim.z;
    unsigned sum, cnt, mine, sp = 0u;
    for (;;) {
        sum = 0u; cnt = 0u; mine = 0u;
#pragma unroll
        for (unsigned j = 0; j < 16; ++j) { const unsigned c = xb_ld(&bar[XB_XCNT(j)]); sum += c; cnt += (c > 0u) ? 1u : 0u; mine = (j == x) ? c : mine; }
        if (sum == G) break;
        __builtin_amdgcn_s_sleep(1);
        if ((++sp & 255u) == 0u) { if (xb_ld(&bar[XB_TMO])) break; if (sp > XB_SPIN_CAP) { atomicAdd(&bar[XB_TMO], 1u); break; } }
    }
    nloc = mine > 0u ? mine : 1u; nx = cnt > 0u ? cnt : 1u;
}
__device__ __forceinline__ void xcd_barrier(const XcdBarrier& b, int tid) {
    asm volatile("s_waitcnt vmcnt(0)" ::: "memory");
    __syncthreads();
    if (tid == 0) {
        unsigned* bar = b.bar;
        __builtin_amdgcn_s_waitcnt(0);
        unsigned nloc = b.st[0], nx = b.st[1];
        if (nloc == 0u) { xcd_barrier_complete(bar, b.x, nloc, nx); b.st[0] = nloc; b.st[1] = nx; }
        const unsigned old = xb_add(&bar[XB_XSUB(b.x)], 1u);
        const unsigned gen = old / nloc;
        if (old + 1u == (gen + 1u) * nloc) {
            __builtin_amdgcn_fence(__ATOMIC_RELEASE, "agent");
            asm volatile("s_waitcnt vmcnt(0)" ::: "memory");
            const unsigned og = xb_add(&bar[XB_TOP], 1u);
            const unsigned tg = og / nx;
            if (og + 1u == (tg + 1u) * nx) {
#pragma unroll
                for (unsigned j = 0; j < 16; ++j) xb_add(&bar[XB_XGEN(j)], 1u);
            }
        }
        XB_SPIN(xb_ld(&bar[XB_XGEN(b.x)]) == gen, bar);
        __builtin_amdgcn_fence(__ATOMIC_ACQUIRE, "agent");
        asm volatile("s_waitcnt vmcnt(0)" ::: "memory");
    }
    __syncthreads();
}

typedef const __attribute__((address_space(4))) char* KP;
__device__ __forceinline__ KP kargs() { KP p = (KP)__builtin_amdgcn_kernarg_segment_ptr(); asm volatile("" : "+s"(p)); return p; }
template <class T> __device__ __forceinline__ T* karg(KP kp, int i) { return *(T* const __attribute__((address_space(4)))*)(kp + 8 * i); }
enum { A_X = 0, A_META, A_G_FF1_PRE, A_W_GATE1, A_W_UP1, A_W_DOWN1, A_G_FF1_POST, A_G_MIX_PRE, A_W_IN, A_B_FORGET, A_LQ1, A_LK1, A_LQ2, A_LK2, A_G_SUBLN, A_W_O_FOX, A_W_O_DIFF, A_W_OUT,
       A_G_MIX_POST, A_G_FF2_PRE, A_W_GATE2, A_W_UP2, A_W_DOWN2, A_G_FF2_POST, A_OUT, A_WS };
struct Frame {
    LAS unsigned char* lds;
    int tid, lane, wave;
    int vcu, G;
};
__device__ __forceinline__ void frame_refresh(Frame& F) {
    int l; asm volatile("v_mbcnt_lo_u32_b32 %0, -1, 0\n\tv_mbcnt_hi_u32_b32 %0, -1, %0" : "=v"(l));
    F.lane = l; F.tid = F.wave * 64 + l;
}
template <class T> __device__ __forceinline__ T* wsp(KP kp, size_t off) { return (T*)(karg<unsigned char>(kp, A_WS) + off); }

__device__ __forceinline__ float wave_sum(float v) {
#pragma unroll
    for (int o = 1; o < 64; o <<= 1) v += __shfl_xor(v, o);
    return v;
}
struct OnesTab { float v[DFF]; };
constexpr OnesTab make_ones() { OnesTab t{}; for (int i = 0; i < DFF; ++i) t.v[i] = 1.0f; return t; }
__device__ const OnesTab ONES = make_ones();
struct TrDesc { const float* W; unsigned char* WT; const float* gk; int N, k0, ns, nd, kd; unsigned ldt; float sc;
    __device__ __forceinline__ void set(const float* W_, unsigned char* WT_, const float* gk_, int N_, int k0_, int ns_, int nd_, int kd_, unsigned ldt_, float sc_) { W = W_; WT = WT_; gk = gk_; N = N_; k0 = k0_; ns = ns_; nd = nd_; kd = kd_; ldt = ldt_; sc = sc_; } };
__device__ __forceinline__ void tr_load(const TrDesc& d, int lane, float (&r)[32], f32x4 (&g)[2]) {
    g[0] = *(const GAS f32x4*)(d.gk + d.k0 + 8 * (lane & 7)); g[1] = *(const GAS f32x4*)(d.gk + d.k0 + 8 * (lane & 7) + 4);
    const GAS float* p = (const GAS float*)d.W + (size_t)(d.k0 + (lane >> 5)) * d.N + d.ns + (lane & 31);
#pragma unroll
    for (int i = 0; i < 32; ++i) r[i] = p[(size_t)(2 * i) * d.N];
}
__device__ __forceinline__ void tr_finish(const TrDesc& d, LAS float* scr, int lane, const float (&r)[32], const f32x4 (&g)[2]) {
#pragma unroll
    for (int i = 0; i < 32; ++i) scr[(2 * i + (lane >> 5)) * 33 + (lane & 31)] = r[i];
    const int c = lane & 7;
    f32x4 ga = g[0], gb = g[1];
    LDS_WAIT(); asm volatile("" ::: "memory");
    if (d.sc != 0.f) { ga = ga * d.sc; gb = gb * d.sc;
#pragma unroll
        for (int j = 0; j < 4; ++j) { const int n = (lane >> 3) + 8 * j; const LAS float* s = scr + (8 * c) * 33 + n;
            v2u o; o.x = pg8::pack_fp8x4(s[0 * 33] * ga.x, s[1 * 33] * ga.y, s[2 * 33] * ga.z, s[3 * 33] * ga.w); o.y = pg8::pack_fp8x4(s[4 * 33] * gb.x, s[5 * 33] * gb.y, s[6 * 33] * gb.z, s[7 * 33] * gb.w);
            *(GAS v2u*)(d.WT + (size_t)(d.nd + n) * d.ldt + d.kd + 8 * c) = o; } }
    else {
#pragma unroll
        for (int j = 0; j < 4; ++j) { const int n = (lane >> 3) + 8 * j; const LAS float* s = scr + (8 * c) * 33 + n;
            v4u o; o.x = pk2(s[0 * 33] * ga.x, s[1 * 33] * ga.y); o.y = pk2(s[2 * 33] * ga.z, s[3 * 33] * ga.w); o.z = pk2(s[4 * 33] * gb.x, s[5 * 33] * gb.y); o.w = pk2(s[6 * 33] * gb.z, s[7 * 33] * gb.w);
            *(GAS v4u*)(d.WT + (size_t)(d.nd + n) * d.ldt + (size_t)(d.kd + 8 * c) * 2) = o; } }
    LDS_WAIT(); asm volatile("" ::: "memory");
}
struct GenStride { int it, hi, step; __device__ __forceinline__ bool next(int& o) { if (it >= hi) return false; o = it; it += step; return true; } };
struct GenQueue { unsigned* qhead; int total, lane, cur = 0, end = 0;
    __device__ __forceinline__ bool next(int& o) {
        if (cur >= end) { unsigned base = 0u; if (lane == 0) base = __hip_atomic_fetch_add(qhead, 16u, __ATOMIC_RELAXED, __HIP_MEMORY_SCOPE_AGENT);
            base = (unsigned)__builtin_amdgcn_readfirstlane((int)base); if (base >= (unsigned)total) return false;
            cur = (int)base; end = (int)base + 16 < total ? (int)base + 16 : total; }
        o = cur++; return true; } };
template <class Gen, class Dec>
__device__ __forceinline__ void tr_stream(Frame& F, Gen gen, const Dec& dec) {
    LAS float* scr = (LAS float*)(F.lds + RING_OFF + F.wave * 16384);
    float ra[32], rb[32]; f32x4 gA[2], gB[2]; TrDesc da, db; int it;
    if (!gen.next(it)) return;
    dec(it, da); tr_load(da, F.lane, ra, gA);
    bool hb = gen.next(it); if (hb) dec(it, db); else db = da;
    tr_load(db, F.lane, rb, gB); tr_finish(da, scr, F.lane, ra, gA);
    while (hb) {
        const bool ha = gen.next(it); if (ha) dec(it, da); else da = db;
        tr_load(da, F.lane, ra, gA); tr_finish(db, scr, F.lane, rb, gB);
        if (!ha) break;
        hb = gen.next(it); if (hb) dec(it, db); else db = da;
        tr_load(db, F.lane, rb, gB); tr_finish(da, scr, F.lane, ra, gA);
    }
}
template <int WHICH  >
struct DecFfn { const float* wg; const float* wu; const float* wd; const float* gk; unsigned char* WGU; unsigned char* WD; unsigned char* WGU8;
    static constexpr int NBG = NGU / 32, I_GU = (DM / 64) * NBG, I_D = (DFF / 64) * (DM / 32);
    __device__ __forceinline__ void operator()(int it, TrDesc& d) const {
        if (it < I_GU) { const int kb = it / NBG, nb = it % NBG, pn = nb >> 3, w8 = nb & 7; const float* wa = wg; const float* wb = wu; asm volatile("" : "+s"(wa), "+s"(wb));
            const float* W = w8 < 4 ? wa : wb; const int ns = 128 * pn + 32 * (w8 & 3);
            if ((WHICH & 4) && 32 * nb >= GU8_ROW0) { d.set(W, WGU8, gk, DFF, 64 * kb, ns, 32 * nb - GU8_ROW0, 64 * kb, 4096u, pg8::F8_WINSCALE); return; }
            { d.set(W, WGU, gk, DFF, 64 * kb, ns, 32 * nb, 64 * kb, (unsigned)DM * 2u, 0.f); return; } }
        const int r = it - I_GU, kb = r / (DM / 32), nb = r % (DM / 32);
        { d.set(wd, WD + (size_t)(kb >> 6) * WD_PSTR * 2, ONES.v, DM, 64 * kb, 32 * nb, 32 * nb, (64 * kb) & 4095, 8192u, 0.f); return; } } };
template <int WHICH>
__device__ __forceinline__ void convert_ffn(Frame& F, KP kp, int a_gate, int a_up, int a_down, int a_gain) {
    DecFfn<WHICH> D{karg<const float>(kp, a_gate), karg<const float>(kp, a_up), karg<const float>(kp, a_down), karg<const float>(kp, a_gain), wsp<unsigned char>(kp, WS_WGU), wsp<unsigned char>(kp, WS_WD), wsp<unsigned char>(kp, WS_WGU8)};
    const int gw = F.vcu * NWAVES + F.wave, NGW = F.G * NWAVES;
    constexpr int LO = (WHICH & 1) ? 0 : DecFfn<WHICH>::I_GU, HI = (WHICH & 2) ? DecFfn<WHICH>::I_GU + DecFfn<WHICH>::I_D : DecFfn<WHICH>::I_GU;
    tr_stream(F, GenStride{LO + gw, HI, NGW}, D);
}
struct DecDown8 { const float* wd; unsigned char* WD8;
    __device__ __forceinline__ void operator()(int r, TrDesc& d) const { const int kb = r / (DM / 32), nb = r % (DM / 32);
        { d.set(wd, WD8 + (size_t)(kb >> 6) * WD_PSTR, ONES.v, DM, 64 * kb, 32 * nb, 32 * nb, (64 * kb) & 4095, 4096u, pg8::F8_WSCALE); return; } } };
__device__ __forceinline__ void convert_down_queue8(Frame& F, KP kp, int a_down, int cw) {
    DecDown8 D{karg<const float>(kp, a_down), wsp<unsigned char>(kp, WS_WD)};
    tr_stream(F, GenQueue{wsp<unsigned>(kp, WS_CTL) + cw, (DFF / 64) * (DM / 32), F.lane}, D);
}
__device__ __forceinline__ int win_src_col(int nd) {
    if (nd < 2048) return nd;
    if (nd < 4096) return 6160 + (nd - 2048);
    if (nd < 6144) return 2048 + (nd - 4096);
    if (nd < 8192) return 4096 + (nd - 6144);
    if (nd < 10240) return 8208 + (nd - 8192);
    if (nd < 12288) return 10256 + (nd - 10240);
    if (nd < 16384) return 12304 + (nd - 12288);
    if (nd < 20480) return 16400 + (nd - 16384);
    return 6144;
}
struct DecMixer { const float* w_in; const float* w_o_fox; const float* w_o_diff; const float* w_out; const float* gk; unsigned char* WIN; unsigned char* WO; unsigned char* WOUT; unsigned char* WIN8;
    static constexpr int NBI = 641;
    static constexpr int I_IN = (DM / 64) * NBI, I_OF = (2048 / 64) * (DM / 32), I_OUT = (DM / 64) * (DM / 32), TOTAL = I_IN + 2 * I_OF + I_OUT;
    __device__ __forceinline__ void operator()(int it, TrDesc& d) const {
        const float* w_in = this->w_in; const float* w_o_fox = this->w_o_fox; const float* w_o_diff = this->w_o_diff; const float* w_out = this->w_out;
        unsigned char* WIN = this->WIN; unsigned char* WO = this->WO; unsigned char* WOUT = this->WOUT; unsigned char* WIN8 = this->WIN8;
        asm volatile("" : "+s"(w_in), "+s"(w_o_fox), "+s"(w_o_diff), "+s"(w_out), "+s"(WIN), "+s"(WO), "+s"(WOUT), "+s"(WIN8));
        int r = it;
        if (r < I_IN) { const int kb = r / NBI, nb = r % NBI, nd = 32 * nb;
            if (GATES_F8 && nd >= 12288 && nd < 20480) { d.set(w_in, WIN8, gk, 20496, 64 * kb, win_src_col(nd), nd - 12288, 64 * kb, 4096u, pg8::F8_WINSCALE); return; }
            { d.set(w_in, WIN, gk, 20496, 64 * kb, win_src_col(nd), nd, 64 * kb, (unsigned)DM * 2u, 0.f); return; } }
        r -= I_IN;
        if (r < I_OF) { const int kb = r / (DM / 32), nb = r % (DM / 32); { d.set(w_o_fox, WO, ONES.v, DM, 64 * kb, 32 * nb, 32 * nb, 64 * kb, 8192u, 0.f); return; } }
        r -= I_OF;
        if (r < I_OF) { const int kb = r / (DM / 32), nb = r % (DM / 32); { d.set(w_o_diff, WO, ONES.v, DM, 64 * kb, 32 * nb, 32 * nb, 2048 + 64 * kb, 8192u, 0.f); return; } }
        r -= I_OF;
        const int kb = r / (DM / 32), nb = r % (DM / 32); { d.set(w_out, WOUT, ONES.v, DM, 64 * kb, 32 * nb, 32 * nb, 64 * kb, (unsigned)DM * 2u, 0.f); return; } } };
__device__ __forceinline__ void convert_mixer_queue(Frame& F, KP kp) {
    DecMixer D{karg<const float>(kp, A_W_IN), karg<const float>(kp, A_W_O_FOX), karg<const float>(kp, A_W_O_DIFF), karg<const float>(kp, A_W_OUT), karg<const float>(kp, A_G_MIX_PRE),
               wsp<unsigned char>(kp, WS_WIN), wsp<unsigned char>(kp, WS_WO), wsp<unsigned char>(kp, WS_WOUT), wsp<unsigned char>(kp, WS_WIN8)};
    tr_stream(F, GenQueue{wsp<unsigned>(kp, WS_CTL) + CW_CQ, DecMixer::I_IN, F.lane}, D);
}
struct DecLate { DecFfn<5> a; DecMixer b;
    static constexpr int TOTAL = DecFfn<5>::I_GU + 2 * DecMixer::I_OF + DecMixer::I_OUT;
    __device__ __forceinline__ void operator()(int it, TrDesc& d) const { if (it < DecFfn<5>::I_GU) a(it, d); else b(it - DecFfn<5>::I_GU + DecMixer::I_IN, d); } };
__device__ __forceinline__ void convert_late_queue(Frame& F, KP kp) {
    DecLate D{ DecFfn<5>{karg<const float>(kp, A_W_GATE2), karg<const float>(kp, A_W_UP2), karg<const float>(kp, A_W_DOWN2), karg<const float>(kp, A_G_FF2_PRE), wsp<unsigned char>(kp, WS_WGU), wsp<unsigned char>(kp, WS_WD), wsp<unsigned char>(kp, WS_WGU8)},
               DecMixer{karg<const float>(kp, A_W_IN), karg<const float>(kp, A_W_O_FOX), karg<const float>(kp, A_W_O_DIFF), karg<const float>(kp, A_W_OUT), karg<const float>(kp, A_G_MIX_PRE),
                        wsp<unsigned char>(kp, WS_WIN), wsp<unsigned char>(kp, WS_WO), wsp<unsigned char>(kp, WS_WOUT), wsp<unsigned char>(kp, WS_WIN8)} };
    tr_stream(F, GenQueue{wsp<unsigned>(kp, WS_CTL) + CW_CQ3, DecLate::TOTAL, F.lane}, D);
}
__device__ __forceinline__ void gain_to_lds(Frame& F, const float* g, int off) {
    const GAS f32x4* s = (const GAS f32x4*)g; LAS f32x4* d = (LAS f32x4*)(F.lds + off);
    for (int i = F.tid; i < DM / 4; i += NWAVES * 64) d[i] = s[i];
}
__device__ __forceinline__ void row_load_f32(const float* p, int lane, f32x4 (&v)[16]) {
    const GAS f32x4* r = (const GAS f32x4*)p + lane;
#pragma unroll
    for (int j = 0; j < 16; ++j) v[j] = r[64 * j];
}
__device__ __forceinline__ void row_load_bf16p(const bf16* p, int lane, v2u (&w)[16]) {
    const GAS v2u* r = (const GAS v2u*)p + lane;
#pragma unroll
    for (int j = 0; j < 16; ++j) w[j] = r[64 * j];
}
__device__ __forceinline__ f32x4 unpack4(v2u w) { return (f32x4){bflo(w.x), bfhi(w.x), bflo(w.y), bfhi(w.y)}; }
__device__ __forceinline__ float row_rstd_p(const v2u (&w)[16]) {
    float s = 0.f;
#pragma unroll
    for (int j = 0; j < 16; ++j) { const f32x4 v = unpack4(w[j]); s += (v.x * v.x + v.y * v.y) + (v.z * v.z + v.w * v.w); }
    return 1.0f / sqrtf(wave_sum(s) * (1.0f / DM) + RMS_EPS);
}
__device__ __forceinline__ void row_store_f32(float* p, int lane, const f32x4 (&v)[16]) {
    GAS f32x4* r = (GAS f32x4*)p + lane;
#pragma unroll
    for (int j = 0; j < 16; ++j) r[64 * j] = v[j];
}
__device__ __forceinline__ void row_store_bf16(bf16* p, int lane, const f32x4 (&v)[16]) {
    GAS v2u* o = (GAS v2u*)p + lane;
#pragma unroll
    for (int j = 0; j < 16; ++j) { v2u w; w.x = pk2(v[j].x, v[j].y); w.y = pk2(v[j].z, v[j].w); o[64 * j] = w; }
}
__device__ __forceinline__ float row_rstd(const f32x4 (&v)[16]) {
    float s = 0.f;
#pragma unroll
    for (int j = 0; j < 16; ++j) s += (v[j].x * v[j].x + v[j].y * v[j].y) + (v[j].z * v[j].z + v[j].w * v[j].w);
    return 1.0f / sqrtf(wave_sum(s) * (1.0f / DM) + RMS_EPS);
}
__device__ __forceinline__ void row_norm_store_both(bf16* orow, unsigned char* o8row, int lane, const f32x4 (&v)[16], float rstd, const LAS f32x4* g) {
    GAS v2u* o = (GAS v2u*)orow + lane; GAS unsigned* o8 = (GAS unsigned*)o8row + lane;
#pragma unroll
    for (int j = 0; j < 16; ++j) { const f32x4 gg = g[lane + 64 * j]; const float a = v[j].x * rstd * gg.x, b = v[j].y * rstd * gg.y, c = v[j].z * rstd * gg.z, d = v[j].w * rstd * gg.w;
        v2u w; w.x = pk2(a, b); w.y = pk2(c, d); o[64 * j] = w;
        o8[64 * j] = pg8::pack_fp8x4(a * pg8::F8_USCALE, b * pg8::F8_USCALE, c * pg8::F8_USCALE, d * pg8::F8_USCALE); }
}
__device__ __forceinline__ void row_store_bf16_fp8(bf16* orow, unsigned char* o8row, int lane, const f32x4 (&v)[16]) {
    GAS v2u* o = (GAS v2u*)orow + lane; GAS unsigned* o8 = (GAS unsigned*)o8row + lane;
#pragma unroll
    for (int j = 0; j < 16; ++j) { v2u w; w.x = pk2(v[j].x, v[j].y); w.y = pk2(v[j].z, v[j].w); o[64 * j] = w;
        o8[64 * j] = pg8::pack_fp8x4(v[j].x * pg8::F8_USCALE, v[j].y * pg8::F8_USCALE, v[j].z * pg8::F8_USCALE, v[j].w * pg8::F8_USCALE); }
}
__device__ __forceinline__ void row_norm_store_bf16(bf16* orow, int lane, const f32x4 (&v)[16], float rstd, const LAS f32x4* g) {
    GAS v2u* o = (GAS v2u*)orow + lane;
#pragma unroll
    for (int j = 0; j < 16; ++j) { const f32x4 gg = g[lane + 64 * j]; v2u w; w.x = pk2(v[j].x * rstd * gg.x, v[j].y * rstd * gg.y); w.y = pk2(v[j].z * rstd * gg.z, v[j].w * rstd * gg.w); o[64 * j] = w; }
}

typedef short s_bf16x8 __attribute__((ext_vector_type(8)));
template <int NX, class Task>
__device__ __forceinline__ void skinny16(Frame& F, int K, int ntasks, const Task& T) {
    const int wid = F.wave, lane = F.lane, fr = lane & 15, fq = lane >> 4;
    LAS f32x4* part = (LAS f32x4*)(F.lds + RING_OFF);
    const int spw = K / 256;
    for (int task = blockIdx.x; task < ntasks; task += F.G) {
        const bf16* xp[NX]; const bf16* yp; int ldx, ldy; T.ptrs(task, xp, yp, ldx, ldy);
        f32x4 acc[NX];
#pragma unroll
        for (int n = 0; n < NX; ++n) acc[n] = (f32x4){0.f, 0.f, 0.f, 0.f};
        const unsigned koff = (unsigned)(wid * spw * 32 + 8 * fq);
        const unsigned ylane = (unsigned)(fr * ldy), xlane = (unsigned)(fr * ldx);
        for (int s = 0; s < spw; s += 8) {
            s_bf16x8 yv[8], xv[NX][8];
#pragma unroll
            for (int i = 0; i < 8; ++i) if (s + i < spw) { const unsigned k = koff + 32u * (unsigned)(s + i);
                yv[i] = *(const GAS s_bf16x8*)((const GAS char*)yp + (size_t)((ylane + T.ykoff(k)) * 2u));
#pragma unroll
                for (int n = 0; n < NX; ++n) xv[n][i] = *(const GAS s_bf16x8*)((const GAS char*)xp[n] + (size_t)((xlane + T.xkoff(k)) * 2u)); }
#pragma unroll
            for (int i = 0; i < 8; ++i) if (s + i < spw) {
#pragma unroll
                for (int n = 0; n < NX; ++n) acc[n] = __builtin_amdgcn_mfma_f32_16x16x32_bf16(xv[n][i], yv[i], acc[n], 0, 0, 0); }
        }
#pragma unroll
        for (int n = 0; n < NX; ++n) part[(wid * NX + n) * 64 + lane] = acc[n];
        LDS_WAIT(); __syncthreads();
        if (wid == 0) { f32x4 v[NX];
#pragma unroll
            for (int n = 0; n < NX; ++n) { v[n] = part[n * 64 + lane];
#pragma unroll
                for (int w = 1; w < NWAVES; ++w) v[n] = v[n] + part[(w * NX + n) * 64 + lane]; }
            T.store(task, fr, fq, v); }
        LDS_WAIT(); __syncthreads();
    }
}
__device__ __forceinline__ float sigm_f(float x) { return __builtin_amdgcn_rcpf(1.0f + __builtin_amdgcn_exp2f(-LOG2E * x)); }
constexpr size_t HID_PSTR = (size_t)MT * 4096;
struct SkGateUp {
    const bf16* WGU; const bf16* U; bf16* HID; const float* rs;
    __device__ __forceinline__ unsigned ykoff(unsigned k) const { return k; }
    __device__ __forceinline__ unsigned xkoff(unsigned k) const { return k; }
    __device__ __forceinline__ void ptrs(int t, const bf16* (&xp)[2], const bf16*& yp, int& ldx, int& ldy) const { xp[0] = WGU + (size_t)(256 * (t >> 3) + 16 * (t & 7)) * DM; xp[1] = xp[0] + (size_t)128 * DM; yp = U + (size_t)MR * PU; ldx = DM; ldy = PU; }
    __device__ __forceinline__ void store(int t, int fr, int fq, const f32x4 (&vv)[2]) const {
        const float r = rs[MR + fr]; const f32x4 v[2] = {vv[0] * r, vv[1] * r};
        v2u w; w.x = pk2(v[0][0] * sigm_f(v[0][0]) * v[1][0], v[0][1] * sigm_f(v[0][1]) * v[1][1]); w.y = pk2(v[0][2] * sigm_f(v[0][2]) * v[1][2], v[0][3] * sigm_f(v[0][3]) * v[1][3]);
        const int c = 16 * t + 4 * fq; *(GAS v2u*)(HID + (size_t)(c >> 12) * HID_PSTR + (size_t)(MR + fr) * 4096 + (c & 4095)) = w; }
};
struct SkDown {
    const bf16* WD; const bf16* HID; bf16* Y;
    __device__ __forceinline__ unsigned ykoff(unsigned k) const { return (k >> 12) * (unsigned)HID_PSTR + (k & 4095u); }
    __device__ __forceinline__ unsigned xkoff(unsigned k) const { return (k >> 12) * (unsigned)WD_PSTR + (k & 4095u); }
    __device__ __forceinline__ void ptrs(int t, const bf16* (&xp)[1], const bf16*& yp, int& ldx, int& ldy) const { xp[0] = WD + (size_t)(16 * t) * 4096; yp = HID + (size_t)MR * 4096; ldx = 4096; ldy = 4096; }
    __device__ __forceinline__ void store(int t, int fr, int fq, const f32x4 (&v)[1]) const {
        v2u w; w.x = pk2(v[0][0], v[0][1]); w.y = pk2(v[0][2], v[0][3]); *(GAS v2u*)(Y + (size_t)(MR + fr) * DM + 16 * t + 4 * fq) = w; }
};
struct SkWin {
    const bf16* WIN; const bf16* U; bf16* QKV; float* FLOG; const float* rs;
    __device__ __forceinline__ unsigned ykoff(unsigned k) const { return k; }
    __device__ __forceinline__ unsigned xkoff(unsigned k) const { return k; }
    __device__ __forceinline__ void ptrs(int t, const bf16* (&xp)[1], const bf16*& yp, int& ldx, int& ldy) const { ldx = DM; ldy = PU;
        if (t < 1025) { xp[0] = WIN + (size_t)20480 * DM; yp = U + (size_t)(16 * t) * PU; } else { xp[0] = WIN + (size_t)(4096 + 16 * (t - 1025)) * DM; yp = U + (size_t)MR * PU; } }
    __device__ __forceinline__ void store(int t, int fr, int fq, const f32x4 (&vv)[1]) const {
        const f32x4 v[1] = {vv[0] * rs[t < 1025 ? 16 * t + fr : MR + fr]};
        if (t < 1025) { *(GAS f32x4*)(FLOG + (size_t)(16 * t + fr) * 16 + 4 * fq) = v[0]; }
        else { v2u w; w.x = pk2(v[0][0], v[0][1]); w.y = pk2(v[0][2], v[0][3]); *(GAS v2u*)(QKV + (size_t)(MR + fr) * PQKV + 4096 + 16 * (t - 1025) + 4 * fq) = w; } }
};
constexpr int G0_OFF = 0, G1_OFF = 16384;

__device__ __forceinline__ void norm0_row(bf16* U, float* RS, int m, int lane, const f32x4 (&v)[16]) {
    const float rstd = row_rstd(v);
    row_store_bf16(U + (size_t)m * PU, lane, v);
    if (lane == 0) RS[m] = rstd;
}
__device__ __forceinline__ void phase_norm0(Frame& F, KP kp) {
    const float* x = karg<const float>(kp, A_X); const float* meta = karg<const float>(kp, A_META); bf16* U = wsp<bf16>(kp, WS_U); float* RS = wsp<float>(kp, WS_RS0);
    const int gw = F.vcu * NWAVES + F.wave, NGW = F.G * NWAVES;
    constexpr int M = MR + NMETA;
    int m = gw;
    f32x4 va[16], vb[16];
    if (m < M) row_load_f32(m < MR ? x + (size_t)m * DM : meta + (size_t)(m - MR) * DM, F.lane, va);
    while (m < M) {
        const int m1 = m + NGW;
        if (m1 < M) row_load_f32(m1 < MR ? x + (size_t)m1 * DM : meta + (size_t)(m1 - MR) * DM, F.lane, vb);
        norm0_row(U, RS, m, F.lane, va);
        if (m1 >= M) break;
        const int m2 = m1 + NGW;
        if (m2 < M) row_load_f32(m2 < MR ? x + (size_t)m2 * DM : meta + (size_t)(m2 - MR) * DM, F.lane, va);
        norm0_row(U, RS, m1, F.lane, vb);
        m = m2;
    }
    __syncthreads();
}
template <int STEP>
__device__ __forceinline__ void post_row(float* out, bf16* U, unsigned char* U8, float* RS, const LAS f32x4* g0, int m, int lane, const v2u (&y)[16], const v2u (&hp)[16]) {
    asm volatile("" ::: "memory");
    const float ry = (STEP == 2 ? 1.0f : 0.5f) * row_rstd_p(y);
    GAS f32x4* of = (GAS f32x4*)(out + (size_t)m * DM) + lane; GAS v2u* ob = (GAS v2u*)(U + (size_t)m * PU) + lane; GAS unsigned* o8 = (GAS unsigned*)(U8 + (size_t)m * DM) + lane;
    float ss = 0.f;
#pragma unroll
    for (int j = 0; j < 16; ++j) { const f32x4 gg = g0[lane + 64 * j]; const f32x4 h = unpack4(hp[j]) + unpack4(y[j]) * ry * gg;
        if (STEP == 3) of[64 * j] = h;
        else { ss += (h.x * h.x + h.y * h.y) + (h.z * h.z + h.w * h.w);
            v2u w; w.x = pk2(h.x, h.y); w.y = pk2(h.z, h.w); ob[64 * j] = w;
            if (m < MR) o8[64 * j] = pg8::pack_fp8x4(h.x * pg8::F8_USCALE, h.y * pg8::F8_USCALE, h.z * pg8::F8_USCALE, h.w * pg8::F8_USCALE); } }
    if (STEP != 3) { const float rh = 1.0f / sqrtf(wave_sum(ss) * (1.0f / DM) + RMS_EPS); if (lane == 0) RS[m] = rh; }
}
template <int STEP>
__device__ __forceinline__ void phase_post(Frame& F, KP kp) {
    float* out = karg<float>(kp, A_OUT); bf16* U = wsp<bf16>(kp, WS_U); const bf16* Y = wsp<bf16>(kp, WS_Y); unsigned char* U8 = wsp<unsigned char>(kp, WS_U8);
    float* RS = wsp<float>(kp, STEP == 1 ? WS_RS1 : WS_RS2);
    gain_to_lds(F, karg<const float>(kp, STEP == 1 ? A_G_FF1_POST : STEP == 2 ? A_G_MIX_POST : A_G_FF2_POST), G0_OFF); LDS_WAIT(); __syncthreads();
    const LAS f32x4* g0 = (const LAS f32x4*)(F.lds + G0_OFF);
    const int gw = F.vcu * NWAVES + F.wave, NGW = F.G * NWAVES;
    constexpr int M = (STEP == 1 ? MR + NMETA : MR);
    int m = gw;
    v2u ya[16], ha[16], yb[16], hb[16];
    if (m < M) { row_load_bf16p(Y + (size_t)m * DM, F.lane, ya); row_load_bf16p(U + (size_t)m * PU, F.lane, ha); }
    while (m < M) {
        const int m1 = m + NGW;
        if (m1 < M) { row_load_bf16p(Y + (size_t)m1 * DM, F.lane, yb); row_load_bf16p(U + (size_t)m1 * PU, F.lane, hb); }
        post_row<STEP>(out, U, U8, RS, g0, m, F.lane, ya, ha);
        if (m1 >= M) break;
        const int m2 = m1 + NGW;
        if (m2 < M) { row_load_bf16p(Y + (size_t)m2 * DM, F.lane, ya); row_load_bf16p(U + (size_t)m2 * PU, F.lane, ha); }
        post_row<STEP>(out, U, U8, RS, g0, m1, F.lane, yb, hb);
        m = m2;
    }
    __syncthreads();
}
__device__ __forceinline__ void phase_scan(Frame& F, KP kp) {
    const float* b_forget = karg<const float>(kp, A_B_FORGET); const float* FLOG = wsp<float>(kp, WS_FLOG); float* KB = wsp<float>(kp, WS_KB); int* JLO = wsp<int>(kp, WS_JLO);
    const int gw = F.vcu * NWAVES + F.wave, NGW = F.G * NWAVES;
    for (int task = gw; task < NB * 16; task += NGW) {
        const int b = task >> 4, h = task & 15; const float bf = b_forget[h];
        float v[65];
        const int dbase = 65 * F.lane - 64, sel = MR + 16 - b * SEQ;
#pragma unroll
        for (int k = 0; k < 65; ++k) { const int d = dbase + k; const int row = d + b * SEQ + ((d >> 31) & sel);
            v[k] = FLOG[(size_t)(unsigned)row * 16 + h]; }
        float run = 0.f;
#pragma unroll
        for (int k = 0; k < 65; ++k) { const int e = 65 * F.lane + k; const float z = v[k] + bf;
            const float ez = __builtin_amdgcn_exp2f(-LOG2E * fabsf(z));
            const float ls = fminf(z, 0.f) - 0.6931471805599453f * __builtin_amdgcn_logf(1.0f + ez);
            const unsigned keep = ~(unsigned)((e - 48) >> 31);
            run += __uint_as_float(__float_as_uint(ls) & keep); v[k] = run; }
        float incl = run;
#pragma unroll
        for (int d = 1; d < 64; d <<= 1) { const float o = __shfl_up(incl, d); if (F.lane >= d) incl += o; }
        const float off = incl - run;
        float* kb = KB + (size_t)task * EKV + 65 * F.lane;
#pragma unroll
        for (int k = 0; k < 65; ++k) kb[k] = -ISCALE * (off + v[k]);
        asm volatile("s_waitcnt vmcnt(0)" ::: "memory");
        const float* kbrow = KB + (size_t)task * EKV;
        const float tend = __hip_atomic_load(kbrow + 64 * F.lane + 63, __ATOMIC_RELAXED, __HIP_MEMORY_SCOPE_AGENT);
        int* jlo = JLO + task * 16;
        const float q0l = __hip_atomic_load(kbrow + 64 + 256 * (F.lane & 15), __ATOMIC_RELAXED, __HIP_MEMORY_SCOPE_AGENT);
#pragma unroll
        for (int qb = 0; qb < 16; ++qb) {
            const float q0 = __builtin_amdgcn_readlane(q0l, qb);
            const unsigned long long keepm = __ballot(q0 - tend < SKIP_TH * ISCALE);
            int j = keepm ? __builtin_ctzll(keepm) : 0; j = (j > 4 * qb ? 4 * qb : j) & ~1;
            if (F.lane == 0) jlo[qb] = j;
        }
    }
}
template <bool PROBE_OUT> __device__ __forceinline__ void phase_diffnorm(Frame& F, KP kp) {
    const float* lq1 = karg<const float>(kp, A_LQ1); const float* lk1 = karg<const float>(kp, A_LK1); const float* lq2 = karg<const float>(kp, A_LQ2); const float* lk2 = karg<const float>(kp, A_LK2);
    const float* g_subln = karg<const float>(kp, A_G_SUBLN); bf16* AO = wsp<bf16>(kp, WS_AO);
    const int gw = F.vcu * NWAVES + F.wave, NGW = F.G * NWAVES;
    const float s1 = wave_sum(lq1[F.lane] * lk1[F.lane] + lq1[F.lane + 64] * lk1[F.lane + 64]);
    const float s2 = wave_sum(lq2[F.lane] * lk2[F.lane] + lq2[F.lane + 64] * lk2[F.lane + 64]);
    const float lam = expf(s1) - expf(s2) + LAMBDA_INIT;
    const int h = F.lane >> 3, sub = F.lane & 7;
    float gsub[32];
#pragma unroll
    for (int i = 0; i < 32; ++i) gsub[i] = g_subln[sub * 32 + i] * (1.0f - LAMBDA_INIT);
    for (int m = gw; m < MR; m += NGW) {
        const GAS v4u* p1 = (const GAS v4u*)(AO + (size_t)m * PAO + 2048 + h * 512 + sub * 32);
        const GAS v4u* p2 = (const GAS v4u*)(AO + (size_t)m * PAO + 2048 + h * 512 + 256 + sub * 32);
        float d[32]; float ss = 0.f;
#pragma unroll
        for (int q = 0; q < 4; ++q) { const v4u a = p1[q], b = p2[q];
            const unsigned aw[4] = {a.x, a.y, a.z, a.w}, bw[4] = {b.x, b.y, b.z, b.w};
#pragma unroll
            for (int i = 0; i < 4; ++i) { const float d0 = bflo(aw[i]) - lam * bflo(bw[i]), d1 = bfhi(aw[i]) - lam * bfhi(bw[i]); d[8 * q + 2 * i] = d0; d[8 * q + 2 * i + 1] = d1; ss += d0 * d0 + d1 * d1; } }
        ss += __shfl_xor(ss, 1); ss += __shfl_xor(ss, 2); ss += __shfl_xor(ss, 4);
        const float rstd = 1.0f / sqrtf(ss * (1.0f / 256.0f) + RMS_EPS);
        asm volatile("s_waitcnt vmcnt(0)" ::: "memory");
        GAS v4u* o = PROBE_OUT ? (GAS v4u*)(wsp<bf16>(kp, WS_MG) + (size_t)m * 4096 + h * 256 + sub * 32) : (GAS v4u*)(AO + (size_t)m * PAO + 2048 + h * 256 + sub * 32);
#pragma unroll
        for (int q = 0; q < 4; ++q) { v4u w;
            w.x = pk2(d[8 * q + 0] * rstd * gsub[8 * q + 0], d[8 * q + 1] * rstd * gsub[8 * q + 1]); w.y = pk2(d[8 * q + 2] * rstd * gsub[8 * q + 2], d[8 * q + 3] * rstd * gsub[8 * q + 3]);
            w.z = pk2(d[8 * q + 4] * rstd * gsub[8 * q + 4], d[8 * q + 5] * rstd * gsub[8 * q + 5]); w.w = pk2(d[8 * q + 6] * rstd * gsub[8 * q + 6], d[8 * q + 7] * rstd * gsub[8 * q + 7]);
            o[q] = w; }
    }
}
constexpr int est_nt(int vh, int qb) {
    const int ntabs = 4 * qb + 5;
    if (vh < 16) return ntabs < 17 ? ntabs : 17;
    const int h = (vh - 16) >> 2, W = 44 << (h + 1);
    int jlo = 64 + 256 * qb - W; jlo = jlo < 0 ? 0 : jlo / 64; jlo &= ~1;
    return ntabs - jlo;
}
struct ItemTab { unsigned short v[3072]; };
constexpr ItemTab make_items() {
    ItemTab t{}; int n = 0;
    for (int key = 65; key >= 1; --key)
        for (int vh = 0; vh < 48; ++vh) for (int qb = 0; qb < 16; ++qb) if (est_nt(vh, qb) == key)
            for (int b = 0; b < 4; ++b) t.v[n++] = (unsigned short)((b << 10) | (vh << 4) | qb);
    return t;
}
__device__ const ItemTab ITEMS = make_items();
template <int PROBE> __device__ __forceinline__ att::BlockRef attn_ref(const bf16* QKV, bf16* AO, const float* KB, const int* JLO, int idx) {
    const unsigned it = ITEMS.v[idx];
    const int b = it >> 10, vh = (it >> 4) & 63, qb = it & 15;
    att::BlockRef r; r.rowb = b * SEQ; r.P0 = 64 + 256 * qb; r.probe = PROBE == 2;
    const bf16* rowq = QKV + (size_t)(b * SEQ + 256 * qb) * PQKV; bf16* rowo = AO + (size_t)(b * SEQ + 256 * qb) * PAO;
    if (vh < 16) { const int h = vh; r.Q = rowq + h * 128; r.K = QKV + 4096 + h * 128; r.V = QKV + 6144 + h * 128; r.O = rowo + h * 128;
        r.kb = KB + (size_t)(b * 16 + h) * EKV; r.sl2 = 0.f; r.jlo = JLO[(b * 16 + h) * 16 + qb]; }
    else { const int dv = vh - 16, h = dv >> 2, c = (dv >> 1) & 1, jv = dv & 1;
        r.Q = rowq + 2048 + h * 256 + c * 128; r.K = QKV + 8192 + h * 256 + c * 128; r.V = QKV + 10240 + h * 256 + jv * 128;
        r.O = rowo + 2048 + h * 512 + c * 256 + jv * 128;
        r.kb = nullptr; r.sl2 = ISCALE * __builtin_amdgcn_exp2f(-(float)(h + 1));
        const int W = (int)SKIP_TH << (h + 1);
        int j = r.P0 - W; j = j < 0 ? 0 : j >> 6; r.jlo = j & ~1; }
    return r;
}
template <int PROBE> __device__ __forceinline__ void phase_attn(Frame& F, KP kp, char* lds) {
    constexpr int TOTAL = 3072;
    const bf16* QKV = wsp<bf16>(kp, WS_BIG); bf16* AO = wsp<bf16>(kp, WS_AO); const float* KB = wsp<float>(kp, WS_KB); const int* JLO = wsp<int>(kp, WS_JLO);
    unsigned* qhead = wsp<unsigned>(kp, WS_CTL) + CW_Q + (PROBE ? 64 : 0);
    volatile int* qs = (volatile int*)(lds + att::OFF_Q);
    if (F.tid == 0) { qs[0] = (int)__hip_atomic_fetch_add(qhead, 1u, __ATOMIC_RELAXED, __HIP_MEMORY_SCOPE_AGENT); qs[1] = (int)__hip_atomic_fetch_add(qhead, 1u, __ATOMIC_RELAXED, __HIP_MEMORY_SCOPE_AGENT); }
    __syncthreads();
    int icur = __builtin_amdgcn_readfirstlane(qs[0]), inxt = __builtin_amdgcn_readfirstlane(qs[1]);
    if (icur >= TOTAL) return;
    att::BlockRef cur = attn_ref<PROBE>(QKV, AO, KB, JLO, icur);
    att::Seam S;
    att::attn_prime(F.tid, cur, lds, S);
    for (;;) {
        unsigned claim = 0u; if (F.tid == 0) claim = __hip_atomic_fetch_add(qhead, 1u, __ATOMIC_RELAXED, __HIP_MEMORY_SCOPE_AGENT);
        const bool last = inxt >= TOTAL;
        const att::BlockRef nxt = last ? cur : attn_ref<PROBE>(QKV, AO, KB, JLO, inxt);
        att::attn_block(F.tid, cur, nxt, lds, S);
        if (last) break;
        if (F.tid == 0) qs[0] = (int)claim;
        __syncthreads();
        cur = nxt; inxt = __builtin_amdgcn_readfirstlane(qs[0]);
    }
}

#ifndef Y_NT
#define Y_NT 1
#endif
#ifndef LATE_WGS
#define LATE_WGS 6
#endif
#ifndef PROBE_NT
#define PROBE_NT 1
#endif
#ifndef PROBE_ROWS
#define PROBE_ROWS 4096
#endif
#ifndef PROBE_DUP
#define PROBE_DUP 0
#endif
#ifndef PH
#define PH 0xFFFFF
#endif
#ifndef DUP
#define DUP 0
#endif
#ifndef DUP_ROWS
#define DUP_ROWS 4096
#endif
#ifndef ATT_PROBE
#define ATT_PROBE 1
#endif
#ifndef WGM_DOWN
#define WGM_DOWN 2
#endif
#ifndef ALIGN_SWIGLU
#define ALIGN_SWIGLU 1
#endif
#ifndef FFN2_F8
#define FFN2_F8 1
#endif
#ifndef TR_BIG
#define TR_BIG 0
#endif
#ifndef WGM_BIG
#define WGM_BIG 8
#endif
struct Args { const float* in[24]; float* out; unsigned char* ws; };
__global__ void __launch_bounds__(NWAVES * 64, 2) mega_fwd(Args args) {
    extern __shared__ __attribute__((aligned(16))) unsigned char lds[];
    Frame F;
    F.lds = (LAS unsigned char*)lds;
    F.wave = __builtin_amdgcn_readfirstlane((int)threadIdx.x >> 6);
    F.G = gridDim.x; { const int bx = blockIdx.x; F.vcu = (F.G % 8 == 0) ? (bx % 8) * (F.G / 8) + bx / 8 : bx; }
    frame_refresh(F);
    for (int u = F.tid; u < (LDS_BYTES - LDSCTL_OFF) / 4; u += NWAVES * 64) ((LAS unsigned*)(F.lds + LDSCTL_OFF))[u] = 0u;
    __syncthreads();
    (void)xcd_barrier_post(wsp<unsigned>(kargs(), WS_CTL) + CW_BAR, (volatile LAS unsigned*)(F.lds + MISC_OFF) + 8, F.tid);
    if (args.ws == nullptr) return;
#define GRID_BAR() do { frame_refresh(F); XcdBarrier b_; b_.bar = wsp<unsigned>(kargs(), WS_CTL) + CW_BAR; b_.x = xb_xcc_id(); b_.st = (volatile LAS unsigned*)(F.lds + MISC_OFF) + 8; xcd_barrier(b_, F.tid); } while (0)
#define GEMM_PHASE(EPI) do { frame_refresh(F); pg8::gemm_phase<EPI, pg8::StaticOrder, true>(F.lds + RING_OFF, F.tid, g, S, E); } while (0)
#define GEMM_PHASE_SW(EPI) do { frame_refresh(F); pg8::gemm_phase<EPI, pg8::StaticOrder, (ALIGN_SWIGLU != 0)>(F.lds + RING_OFF, F.tid, g, S, E); } while (0)

    { KP kp = kargs(); frame_refresh(F);
      convert_ffn<3>(F, kp, A_W_GATE1, A_W_UP1, A_W_DOWN1, A_G_FF1_PRE);
      __syncthreads();
      phase_norm0(F, kp); }
#if PROBE_DUP & 1
    GRID_BAR();
    { KP kp = kargs(); frame_refresh(F);
      convert_ffn<3>(F, kp, A_W_GATE1, A_W_UP1, A_W_DOWN1, A_G_FF1_PRE);
      __syncthreads();
      phase_norm0(F, kp); }
#endif
    GRID_BAR();
    { KP kp = kargs(); frame_refresh(F); SkGateUp T{wsp<bf16>(kp, WS_WGU), wsp<bf16>(kp, WS_U), wsp<bf16>(kp, WS_BIG), wsp<float>(kp, WS_RS0)}; skinny16<2>(F, DM, DFF / 16, T); }
    { KP kp = kargs(); pg8::Gemm g{wsp<bf16>(kp, WS_U), wsp<bf16>(kp, WS_WGU), MR, NGU, DM, PU, DM}; pg8::StaticOrder S; S.init(MR, NGU, F.G, (int)blockIdx.x, WGM_BIG, TR_BIG);
      pg8::EpiSwiGLU E{wsp<bf16>(kp, WS_BIG), HID_PSTR, wsp<float>(kp, WS_RS0)}; GEMM_PHASE_SW(pg8::EpiSwiGLU); }
    { KP kp = kargs(); frame_refresh(F); convert_mixer_queue(F, kp); __syncthreads(); }
    GRID_BAR();
    { KP kp = kargs(); frame_refresh(F); SkDown T{wsp<bf16>(kp, WS_WD), wsp<bf16>(kp, WS_BIG), wsp<bf16>(kp, WS_Y)}; skinny16<1>(F, DFF, DM / 16, T); }
    { KP kp = kargs(); pg8::Gemm g{wsp<bf16>(kp, WS_BIG), wsp<bf16>(kp, WS_WD), MR, DM, DFF, 4096, 4096, 6, 6, HID_PSTR * 2, WD_PSTR * 2}; pg8::StaticOrder S; S.init(MR, DM, F.G, (int)blockIdx.x, WGM_DOWN);
      pg8::EpiPlain E{wsp<bf16>(kp, WS_Y), DM, 1.0f, Y_NT}; GEMM_PHASE(pg8::EpiPlain); }
    GRID_BAR();
    { KP kp = kargs(); frame_refresh(F); phase_post<1>(F, kp); }
    GRID_BAR();
#if PROBE_DUP & 16
    GRID_BAR(); GRID_BAR(); GRID_BAR(); GRID_BAR(); GRID_BAR(); GRID_BAR(); GRID_BAR(); GRID_BAR(); GRID_BAR(); GRID_BAR();
#endif
#if PROBE_DUP & 32
#endif
    { KP kp = kargs(); frame_refresh(F); SkWin T{wsp<bf16>(kp, WS_WIN), wsp<bf16>(kp, WS_U), wsp<bf16>(kp, WS_BIG), wsp<float>(kp, WS_FLOG), wsp<float>(kp, WS_RS1)}; skinny16<1>(F, DM, 1025 + 512, T); }
    { KP kp = kargs(); pg8::Gemm g{wsp<bf16>(kp, WS_U), wsp<bf16>(kp, WS_WIN), MR, 12288, DM, PU, DM}; pg8::StaticOrder S; S.init(MR, 12288, F.G, (int)blockIdx.x, WGM_BIG, TR_BIG);
      pg8::EpiWin E{wsp<bf16>(kp, WS_BIG), wsp<bf16>(kp, WS_GATES), wsp<float>(kp, WS_RS1)}; GEMM_PHASE(pg8::EpiWin); }
    { KP kp = kargs(); pg8::Gemm g{wsp<bf16>(kp, WS_U8), wsp<bf16>(kp, WS_WIN8), MR, 8192, DM / 2, 2048, 2048}; pg8::StaticOrder S; S.init(MR, 8192, F.G, (int)blockIdx.x, WGM_BIG, TR_BIG);
      pg8::EpiPlainRS E{wsp<bf16>(kp, WS_GATES), 8192, 1.0f / (pg8::F8_USCALE * pg8::F8_WINSCALE), wsp<float>(kp, WS_RS1)};
      frame_refresh(F); pg8::gemm_phase<pg8::EpiPlainRS, pg8::StaticOrder, true, pg8::MidNone, true>(F.lds + RING_OFF, F.tid, g, S, E); }
    GRID_BAR();
    { KP kp = kargs(); frame_refresh(F); phase_scan(F, kp); }
    GRID_BAR();
#if PROBE_DUP & 4
    { KP kp = kargs(); frame_refresh(F); phase_attn<1>(F, kp, (char*)lds + RING_OFF); }
    GRID_BAR();
#endif
    if ((F.vcu & 31) < LATE_WGS) { KP kp = kargs(); frame_refresh(F); convert_late_queue(F, kp); __syncthreads(); }
    { KP kp = kargs(); frame_refresh(F); phase_attn<0>(F, kp, (char*)lds + RING_OFF); }
    GRID_BAR();
    { KP kp = kargs(); frame_refresh(F); phase_diffnorm<false>(F, kp); }
    GRID_BAR();
    { KP kp = kargs(); pg8::Gemm g{wsp<bf16>(kp, WS_AO), wsp<bf16>(kp, WS_WO), MR, DM, 4096, PAO, 4096}; pg8::StaticOrder S; S.init(MR, DM, F.G, (int)blockIdx.x);
      pg8::EpiGateOut E{wsp<bf16>(kp, WS_MG), wsp<bf16>(kp, WS_GATES)}; pg8::MidGate MH{32, wsp<bf16>(kp, WS_GATES)};
      frame_refresh(F); pg8::gemm_phase<pg8::EpiGateOut, pg8::StaticOrder, true, pg8::MidGate>(F.lds + RING_OFF, F.tid, g, S, E, MH); }
    GRID_BAR();
    { KP kp = kargs(); pg8::Gemm g{wsp<bf16>(kp, WS_MG), wsp<bf16>(kp, WS_WOUT), MR, DM, DM, DM, DM}; pg8::StaticOrder S; S.init(MR, DM, F.G, (int)blockIdx.x);
      pg8::EpiPlain E{wsp<bf16>(kp, WS_Y), DM, 1.0f, Y_NT}; GEMM_PHASE(pg8::EpiPlain); }
#if PROBE_DUP & 8
    GRID_BAR();
    { KP kp = kargs(); pg8::Gemm g{wsp<bf16>(kp, WS_MG), wsp<bf16>(kp, WS_WOUT), PROBE_ROWS, DM, DM, DM, DM}; pg8::StaticOrder S; S.init(PROBE_ROWS, DM, F.G, (int)blockIdx.x);
      pg8::EpiPlain E{wsp<bf16>(kp, WS_Y), DM, 1.0f, PROBE_NT}; GEMM_PHASE(pg8::EpiPlain); }
#endif
    GRID_BAR();
    { KP kp = kargs(); frame_refresh(F); phase_post<2>(F, kp); }
    GRID_BAR();
    { KP kp = kargs(); pg8::Gemm g{wsp<bf16>(kp, WS_U), wsp<bf16>(kp, WS_WGU), MR, GU8_ROW0, DM, PU, DM}; pg8::StaticOrder S; S.init(MR, GU8_ROW0, F.G, (int)blockIdx.x, WGM_BIG, TR_BIG);
      pg8::EpiSwiGLU8 E{wsp<unsigned char>(kp, WS_BIG), (size_t)MT * 4096, wsp<float>(kp, WS_RS2)}; GEMM_PHASE_SW(pg8::EpiSwiGLU8); }
    { KP kp = kargs(); pg8::Gemm g{wsp<bf16>(kp, WS_U8), wsp<bf16>(kp, WS_WGU8), MR, GU8_TILES * 256, DM / 2, 2048, 2048}; pg8::StaticOrder S; S.init(MR, GU8_TILES * 256, F.G, (int)blockIdx.x, WGM_BIG, TR_BIG);
      pg8::EpiSwiGLU8 E{wsp<unsigned char>(kp, WS_BIG), (size_t)MT * 4096, wsp<float>(kp, WS_RS2), 86 - GU8_TILES, 1.0f / (pg8::F8_USCALE * pg8::F8_WINSCALE)};
      frame_refresh(F); pg8::gemm_phase<pg8::EpiSwiGLU8, pg8::StaticOrder, true, pg8::MidNone, true>(F.lds + RING_OFF, F.tid, g, S, E); }
    { KP kp = kargs(); frame_refresh(F); convert_down_queue8(F, kp, A_W_DOWN2, CW_CQ2); __syncthreads(); }
    GRID_BAR();
    { KP kp = kargs(); pg8::Gemm g{wsp<bf16>(kp, WS_BIG), wsp<bf16>(kp, WS_WD), MR, DM, DFF / 2, 2048, 2048, 5, 5, (size_t)MT * 4096, WD_PSTR}; pg8::StaticOrder S; S.init(MR, DM, F.G, (int)blockIdx.x, WGM_DOWN);
      pg8::EpiPlain E{wsp<bf16>(kp, WS_Y), DM, 1.0f / (pg8::F8_HSCALE * pg8::F8_WSCALE), Y_NT};
      frame_refresh(F); pg8::gemm_phase<pg8::EpiPlain, pg8::StaticOrder, true, pg8::MidNone, true>(F.lds + RING_OFF, F.tid, g, S, E); }
    GRID_BAR();
    { KP kp = kargs(); frame_refresh(F); phase_post<3>(F, kp); }
#if PROBE_DUP & 2
    GRID_BAR();
    { KP kp = kargs(); frame_refresh(F); phase_post<3>(F, kp); }
#endif
#undef GRID_BAR
#undef GEMM_PHASE
#undef GEMM_PHASE_SW
}

extern "C" void kernel_launch(void* const* d_in, const int* in_sizes, int n_in, void* d_out, int out_size, void* d_ws, size_t ws_size, hipStream_t stream) {
    static int grid = 0;
    if (grid == 0) {
        if (n_in != 24 || in_sizes[0] != MR * DM || out_size != MR * DM || ws_size < WS_END) { fprintf(stderr, "kernel_launch: shape/workspace mismatch (n_in %d, in0 %d, out %d, ws %zu, need %zu)\n", n_in, n_in > 0 ? in_sizes[0] : -1, out_size, ws_size, (size_t)WS_END); grid = -1; return; }
        int dev = 0, cus = 0;
        if (hipGetDevice(&dev) != hipSuccess || hipDeviceGetAttribute(&cus, hipDeviceAttributeMultiprocessorCount, dev) != hipSuccess) { grid = -1; return; }
        if (hipFuncSetAttribute((const void*)mega_fwd, hipFuncAttributeMaxDynamicSharedMemorySize, LDS_BYTES) != hipSuccess) { fprintf(stderr, "kernel_launch: hipFuncSetAttribute failed\n"); grid = -1; return; }
        int per_cu = 0;
        if (hipOccupancyMaxActiveBlocksPerMultiprocessor(&per_cu, (const void*)mega_fwd, NWAVES * 64, LDS_BYTES) != hipSuccess || per_cu < 1) { fprintf(stderr, "kernel_launch: occupancy query reports %d\n", per_cu); }
        (void)hipGetLastError();
        grid = cus;
    }
    if (grid < 0) return;
    if (hipMemsetAsync((char*)d_ws + WS_CTL, 0, CTL_ZERO_BYTES, stream) != hipSuccess) return;
    Args a{};
    for (int i = 0; i < 24; ++i) a.in[i] = (const float*)d_in[i];
    a.out = (float*)d_out; a.ws = (unsigned char*)d_ws;
    hipLaunchKernelGGL(mega_fwd, dim3(grid), dim3(NWAVES * 64), LDS_BYTES, stream, a);
}
```
